# Optimizing an MI355X kernel written in HIP

```python
import math
import jax, jax.numpy as jnp
from jax import lax
import numpy as np

D_MODEL = 2048
BATCH = 2
SEQ = 4096
DEPTH = 2

GRID_W = 64
ROPE_THETA = 10000.0
HEAD_DIM = 128
N_Q_HEADS = 8
N_KV_HEADS = 2
ATTN_W = N_Q_HEADS * HEAD_DIM
KV_W = N_KV_HEADS * HEAD_DIM
Q_BLOCK = 128
SSM_GROUP = 16
SSM_GROUPS = 64
SSM_W = SSM_GROUP * SSM_GROUPS
SSM_STATE = 64
DT_MIN = 1e-3
DT_MAX = 1e-1
MLP_CHUNK = 128
MLP_GROUPS = 8
MLP_GROUP_W = 128
MLP_W = MLP_GROUPS * MLP_GROUP_W
N_BRANCH = 3
BRANCH_W = 1024
N_IN = ATTN_W + 2 * KV_W + SSM_W + 2 * MLP_W + N_BRANCH * D_MODEL
D_FF = 5632
N_EXPERTS = 8
TOP_K = 2
D_FF_EXPERT = 7168
MOE_BLOCK = 256
N_DENSE = (DEPTH + 1) // 2
N_MOE = DEPTH // 2
PLE_DIM = 256
EPS = 1e-6

kernel_name = 'hybrid_gqa_s5_gmlp_moe_encoder'


def rms_norm(x, g):
    xf = x.astype(jnp.float32)
    y = xf * lax.rsqrt(jnp.mean(xf * xf, axis=-1, keepdims=True) + EPS)
    return (y * g.astype(jnp.float32)).astype(x.dtype)


def swiglu(h, w1, w3, w2):
    return (jax.nn.silu(h @ w1) * (h @ w3)) @ w2


def axial_rope_tables(L):
    rows = L // GRID_W
    t = jnp.arange(L)
    pos = jnp.stack([t // GRID_W - rows // 2, t % GRID_W - GRID_W // 2], axis=-1).astype(jnp.float32)
    n_freq = HEAD_DIM // 4
    inv_freq = ROPE_THETA ** (-jnp.arange(n_freq, dtype=jnp.float32) / n_freq)
    ang = pos[:, :, None] * inv_freq
    return jnp.cos(ang), jnp.sin(ang)


def apply_axial_rope(x, cos, sin):
    B, L, H, _ = x.shape
    xr = x.astype(jnp.float32).reshape(B, L, H, 2, 2, HEAD_DIM // 4)
    x1, x2 = xr[..., 0, :], xr[..., 1, :]
    c = cos[None, :, None]
    s = sin[None, :, None]
    out = jnp.stack([x1 * c - x2 * s, x2 * c + x1 * s], axis=-2)
    return out.reshape(B, L, H, HEAD_DIM).astype(x.dtype)


def axial_gqa_attention(q, k, v, q_gain, k_gain):
    B, L, _ = q.shape
    q = rms_norm(q.reshape(B, L, N_Q_HEADS, HEAD_DIM), q_gain)
    k = rms_norm(k.reshape(B, L, N_KV_HEADS, HEAD_DIM), k_gain)
    v = v.reshape(B, L, N_KV_HEADS, HEAD_DIM)
    cos, sin = axial_rope_tables(L)
    q = apply_axial_rope(q, cos, sin)
    k = apply_axial_rope(k, cos, sin)
    rep = N_Q_HEADS // N_KV_HEADS
    nb = L // Q_BLOCK
    qb = q.reshape(B, nb, Q_BLOCK, N_KV_HEADS, rep, HEAD_DIM).transpose(1, 0, 2, 3, 4, 5)
    scale = HEAD_DIM ** -0.5

    def block(qblk):
        s = jnp.einsum('bqgrd,bkgd->bgrqk', qblk, k, preferred_element_type=jnp.float32) * scale
        pr = jax.nn.softmax(s, axis=-1)
        return jnp.einsum('bgrqk,bkgd->bqgrd', pr.astype(v.dtype), v)

    o = lax.map(block, qb)
    return o.transpose(1, 0, 2, 3, 4, 5).reshape(B, L, ATTN_W)


def _ssm_combine(left, right):
    a_l, b_l = left
    a_r, b_r = right
    return a_r * a_l, a_r * b_l + b_r


def bidirectional_s5(u, lam_re, lam_im, log_dt, b_re, b_im, c_re, c_im, d_skip, w_glu):
    B, L, _ = u.shape
    uf = u.astype(jnp.float32).reshape(B, L, SSM_GROUPS, SSM_GROUP)
    lam = lax.complex(lam_re.astype(jnp.float32), lam_im.astype(jnp.float32))
    dt = jnp.exp(log_dt.astype(jnp.float32))[..., None]
    lam_bar = jnp.exp(lam * dt)
    b_cplx = lax.complex(b_re.astype(jnp.float32), b_im.astype(jnp.float32))
    b_bar = ((lam_bar - 1.0) / lam)[..., None] * b_cplx
    y = jnp.zeros((B, L, SSM_GROUPS, SSM_GROUP), jnp.float32)
    for dn, rev in ((0, False), (1, True)):
        bu = lax.complex(jnp.einsum('blgc,gpc->blgp', uf, jnp.real(b_bar[dn])),
                         jnp.einsum('blgc,gpc->blgp', uf, jnp.imag(b_bar[dn])))
        a = jnp.broadcast_to(lam_bar[dn], bu.shape)
        _, states = lax.associative_scan(_ssm_combine, (a, bu), axis=1, reverse=rev)
        y = y + jnp.einsum('blgp,gcp->blgc', jnp.real(states), c_re[dn].astype(jnp.float32)) \
              - jnp.einsum('blgp,gcp->blgc', jnp.imag(states), c_im[dn].astype(jnp.float32))
    y = y.reshape(B, L, SSM_W) + d_skip.astype(jnp.float32) * uf.reshape(B, L, SSM_W)
    y = jax.nn.gelu(y)
    y = y * jax.nn.sigmoid(y @ w_glu.astype(jnp.float32))
    return y.astype(u.dtype)


def chunked_spatial_gating(z_u, z_v, v_gain, w_s, b_s):
    B, L, _ = z_u.shape
    u = jax.nn.gelu(z_u)
    v = rms_norm(jax.nn.gelu(z_v), v_gain)
    nc = L // MLP_CHUNK
    vc = v.reshape(B, nc, MLP_CHUNK, MLP_GROUPS, MLP_GROUP_W)
    s = jnp.einsum('bnpgc,gqp->bnqgc', vc, w_s) + b_s.T[None, None, :, :, None]
    return u * s.reshape(B, L, MLP_W)


def mixer_sublayer(h, w_in, q_gain, k_gain, lam_re, lam_im, log_dt, b_re, b_im, c_re, c_im,
                   d_skip, w_glu, v_gain, w_s, b_s, w_branch, w_out):
    B, L, D = h.shape
    proj = h @ w_in
    cuts = [int(c) for c in np.cumsum([ATTN_W, KV_W, KV_W, SSM_W, MLP_W, MLP_W])]
    q, k, v, u_ssm, z_u, z_v, gate_logits = jnp.split(proj, cuts, axis=-1)
    attn = axial_gqa_attention(q, k, v, q_gain, k_gain)
    ssm = bidirectional_s5(u_ssm, lam_re, lam_im, log_dt, b_re, b_im, c_re, c_im, d_skip, w_glu)
    mlp = chunked_spatial_gating(z_u, z_v, v_gain, w_s, b_s)
    gates = jax.nn.sigmoid(gate_logits.astype(jnp.float32)).reshape(B, L, N_BRANCH, D)
    branches = jnp.stack([attn, ssm, mlp], axis=2)
    proj_b = jnp.einsum('blnc,ncd->blnd', branches, w_branch)
    merged = jnp.sum(gates * proj_b.astype(jnp.float32), axis=2).astype(h.dtype)
    return merged @ w_out


def moe_swiglu(h, w_router, e_w1, e_w3, e_w2):
    B, L, D = h.shape
    t = h.reshape(-1, D)
    N = t.shape[0]
    logits = (t @ w_router).astype(jnp.float32)
    top_val, top_idx = lax.top_k(logits, TOP_K)
    gates = jax.nn.softmax(top_val, axis=-1)
    NK = N * TOP_K
    e_flat = top_idx.reshape(-1)
    tok_flat = jnp.arange(NK) // TOP_K
    g_flat = gates.reshape(-1)
    order = jnp.argsort(e_flat)
    e_s, tok_s, g_s = e_flat[order], tok_flat[order], g_flat[order]
    counts = jnp.bincount(e_flat, length=N_EXPERTS)
    starts = jnp.cumsum(counts) - counts
    padded = (counts + MOE_BLOCK - 1) // MOE_BLOCK * MOE_BLOCK
    pends = jnp.cumsum(padded)
    pstarts = pends - padded
    dest = pstarts[e_s] + (jnp.arange(NK) - starts[e_s])
    n_blocks = -(-NK // MOE_BLOCK) + N_EXPERTS
    cap = n_blocks * MOE_BLOCK
    xbuf = jnp.zeros((cap, D), t.dtype).at[dest].set(t[tok_s])
    block_e = jnp.minimum(jnp.searchsorted(pends, jnp.arange(n_blocks) * MOE_BLOCK, side='right'), N_EXPERTS - 1)

    def expert_block(args):
        xb, e = args
        return swiglu(xb, e_w1[e], e_w3[e], e_w2[e])

    ybuf = lax.map(expert_block, (xbuf.reshape(n_blocks, MOE_BLOCK, D), block_e)).reshape(cap, D)
    y = ybuf[dest] * g_s[:, None].astype(ybuf.dtype)
    out = jnp.zeros((N, D), t.dtype).at[tok_s].add(y.astype(t.dtype))
    return out.reshape(B, L, D)


def setup_inputs(seed: int = 0) -> dict:
    key = jax.random.key(seed)
    ks = iter(jax.random.split(key, 40))
    f32 = jnp.float32

    def nrm(shape, scale):
        return jax.random.normal(next(ks), shape, f32) * scale

    def gain(shape):
        return 1.0 + nrm(shape, 0.01)

    ssm_shape = (DEPTH, 2, SSM_GROUPS, SSM_STATE)
    return {
        'x': nrm((BATCH, SEQ, D_MODEL), 1.0),
        'p': nrm((DEPTH, BATCH, SEQ, PLE_DIM), 1.0),
        'mix_norm': gain((DEPTH, D_MODEL)),
        'w_in': nrm((DEPTH, D_MODEL, N_IN), D_MODEL ** -0.5),
        'q_norm': gain((DEPTH, HEAD_DIM)),
        'k_norm': gain((DEPTH, HEAD_DIM)),
        'ssm_lambda_re': -0.5 + nrm(ssm_shape, 0.01),
        'ssm_lambda_im': jnp.pi * jnp.arange(SSM_STATE, dtype=f32) + nrm(ssm_shape, 0.01),
        'ssm_log_dt': jax.random.uniform(next(ks), (DEPTH, 2, SSM_GROUPS), f32, math.log(DT_MIN), math.log(DT_MAX)),
        'ssm_b_re': nrm((DEPTH, 2, SSM_GROUPS, SSM_STATE, SSM_GROUP), (2 * SSM_GROUP) ** -0.5),
        'ssm_b_im': nrm((DEPTH, 2, SSM_GROUPS, SSM_STATE, SSM_GROUP), (2 * SSM_GROUP) ** -0.5),
        'ssm_c_re': nrm((DEPTH, 2, SSM_GROUPS, SSM_GROUP, SSM_STATE), (2 * SSM_STATE) ** -0.5),
        'ssm_c_im': nrm((DEPTH, 2, SSM_GROUPS, SSM_GROUP, SSM_STATE), (2 * SSM_STATE) ** -0.5),
        'ssm_d': nrm((DEPTH, SSM_W), 1.0),
        'ssm_glu_w': nrm((DEPTH, SSM_W, SSM_W), SSM_W ** -0.5),
        'gmlp_v_norm': gain((DEPTH, MLP_W)),
        'gmlp_ws': nrm((DEPTH, MLP_GROUPS, MLP_CHUNK, MLP_CHUNK), MLP_CHUNK ** -0.5),
        'gmlp_b': 1.0 + nrm((DEPTH, MLP_GROUPS, MLP_CHUNK), 0.1),
        'w_branch': nrm((DEPTH, N_BRANCH, BRANCH_W, D_MODEL), BRANCH_W ** -0.5),
        'w_out': nrm((DEPTH, D_MODEL, D_MODEL), D_MODEL ** -0.5),
        'ffn_norm': gain((DEPTH, D_MODEL)),
        'dense_w1': nrm((N_DENSE, D_MODEL, D_FF), D_MODEL ** -0.5),
        'dense_w3': nrm((N_DENSE, D_MODEL, D_FF), D_MODEL ** -0.5),
        'dense_w2': nrm((N_DENSE, D_FF, D_MODEL), D_FF ** -0.5),
        'router_w': nrm((N_MOE, D_MODEL, N_EXPERTS), D_MODEL ** -0.5),
        'expert_w1': nrm((N_MOE, N_EXPERTS, D_MODEL, D_FF_EXPERT), D_MODEL ** -0.5),
        'expert_w3': nrm((N_MOE, N_EXPERTS, D_MODEL, D_FF_EXPERT), D_MODEL ** -0.5),
        'expert_w2': nrm((N_MOE, N_EXPERTS, D_FF_EXPERT, D_MODEL), D_FF_EXPERT ** -0.5),
        'ple_norm': gain((DEPTH, D_MODEL)),
        'ple_gate_w': nrm((DEPTH, D_MODEL, D_MODEL), D_MODEL ** -0.5),
        'ple_proj_w': nrm((DEPTH, PLE_DIM, D_MODEL), PLE_DIM ** -0.5),
    }


def reference(x, p, mix_norm, w_in, q_norm, k_norm, ssm_lambda_re, ssm_lambda_im, ssm_log_dt,
              ssm_b_re, ssm_b_im, ssm_c_re, ssm_c_im, ssm_d, ssm_glu_w, gmlp_v_norm, gmlp_ws, gmlp_b,
              w_branch, w_out, ffn_norm, dense_w1, dense_w3, dense_w2, router_w, expert_w1, expert_w3,
              expert_w2, ple_norm, ple_gate_w, ple_proj_w):
    for i in range(DEPTH):
        h = rms_norm(x, mix_norm[i])
        x = x + mixer_sublayer(h, w_in[i], q_norm[i], k_norm[i], ssm_lambda_re[i], ssm_lambda_im[i],
                               ssm_log_dt[i], ssm_b_re[i], ssm_b_im[i], ssm_c_re[i], ssm_c_im[i], ssm_d[i],
                               ssm_glu_w[i], gmlp_v_norm[i], gmlp_ws[i], gmlp_b[i], w_branch[i], w_out[i])
        h = rms_norm(x, ffn_norm[i])
        j = i // 2
        if i % 2 == 0:
            x = x + swiglu(h, dense_w1[j], dense_w3[j], dense_w2[j])
        else:
            x = x + moe_swiglu(h, router_w[j], expert_w1[j], expert_w3[j], expert_w2[j])
        g = jax.nn.sigmoid((rms_norm(x, ple_norm[i]) @ ple_gate_w[i]).astype(jnp.float32))
        x = x + (g * (p[i] @ ple_proj_w[i]).astype(jnp.float32)).astype(x.dtype)
    return x
```

```cpp
#include <hip/hip_runtime.h>
#include <stdint.h>
#include <stdio.h>
#ifndef MK_ONE_LAUNCH
#define MK_ONE_LAUNCH 1
#endif

#define LAS __attribute__((address_space(3)))
typedef unsigned short bf16_t;
typedef short bf16x8 __attribute__((ext_vector_type(8)));
typedef short s16x4 __attribute__((ext_vector_type(4)));
typedef float f32x2 __attribute__((ext_vector_type(2)));
typedef float f32x4 __attribute__((ext_vector_type(4)));
typedef float f32x16 __attribute__((ext_vector_type(16)));
typedef unsigned u32x2 __attribute__((ext_vector_type(2)));
typedef unsigned u32x4 __attribute__((ext_vector_type(4)));
typedef int i32x4 __attribute__((ext_vector_type(4)));
typedef int i32x8 __attribute__((ext_vector_type(8)));
#ifndef MK_FP8
#define MK_FP8 1
#endif

constexpr int NB = 2, SEQ = 4096, NT = 8192, DM = 2048, NIN = 10752, DFF = 5632, DFE = 7168, NEXP = 8, PLED = 256;
constexpr int C_K = 1024, C_V = 1280, C_U = 1536, C_ZU = 2560, C_ZV = 3584, C_G = 4608;
constexpr float EPS = 1e-6f;
constexpr int CAPROWS = 72 * 256;

__device__ __forceinline__ unsigned cvt_pk_bf16(float lo, float hi) { unsigned r; asm volatile("v_cvt_pk_bf16_f32 %0, %1, %2" : "=v"(r) : "v"(lo), "v"(hi)); return r; }
__device__ __forceinline__ float bf_lo(unsigned w) { return __uint_as_float(w << 16); }
__device__ __forceinline__ float bf_hi(unsigned w) { return __uint_as_float(w & 0xffff0000u); }
__device__ __forceinline__ float bf2f(bf16_t b) { return __uint_as_float((unsigned)b << 16); }
__device__ __forceinline__ bf16_t f2bf(float f) { return (bf16_t)(cvt_pk_bf16(f, 0.f) & 0xffffu); }
__device__ __forceinline__ float sigm(float x) { return __builtin_amdgcn_rcpf(1.f + __builtin_amdgcn_exp2f(-1.4426950408889634f * x)); }
__device__ __forceinline__ float gelu_t(float x) { const float u = 0.7978845608028654f * (x + 0.044715f * x * x * x); return x * sigm(2.f * u); }
__device__ __forceinline__ float wave_sum(float v) {
#pragma unroll
    for (int o = 1; o < 64; o <<= 1) v += __shfl_xor(v, o);
    return v;
}
__device__ __forceinline__ unsigned pk4_fp8(float a, float b, float c, float d) { int w = 0; w = __builtin_amdgcn_cvt_pk_fp8_f32(a, b, w, false); w = __builtin_amdgcn_cvt_pk_fp8_f32(c, d, w, true); return (unsigned)w; }
#define LDS_WAIT() asm volatile("s_waitcnt lgkmcnt(0)" ::: "memory")
#define VM_WAIT() asm volatile("s_waitcnt vmcnt(0)" ::: "memory")

namespace pg8 {
#ifndef MK_WGM
#define MK_WGM 8
#endif
constexpr int BM = 256, BK = 64, HALF = 128, HTB = HALF * BK * 2, STAGE_BYTES = 8 * HTB, NXCD = 8, WGM = MK_WGM;
__host__ __device__ __forceinline__ int lds_byte(int r, int c) { const int st = (r >> 4) * 2 + (c >> 5), rr = r & 15, cc = c & 31, ob = rr * 64 + cc * 2; return st * 1024 + (ob ^ (((ob >> 9) & 1) << 5)); }
__host__ __device__ __forceinline__ void stage_rc(int b, int& R, int& C) { const int st = b / 1024, sb = b % 1024, swz = sb ^ (((sb >> 9) & 1) << 5); R = (st >> 1) * 16 + swz / 64; C = (st & 1) * 32 + (swz % 64) / 2; }
__host__ __device__ __forceinline__ int perm32(int rho) { const int n = rho >> 4, i = rho & 15; return 8 * (i >> 2) + 4 * n + (i & 3); }

struct Unit { const char* A; const char* B; int pm, pn, z; };

__device__ __forceinline__ void tile_of(int wgid, int nM, int nN, int& pm, int& pn, const int WGM = pg8::WGM) {
    const int nwg = nM * nN; { const int q = nwg / NXCD, r = nwg % NXCD, xcd = wgid % NXCD, off = wgid / NXCD; wgid = (xcd < r ? xcd * (q + 1) : r * (q + 1) + (xcd - r) * q) + off; }
    const int nig = WGM * nN, gid = wgid / nig, fm = gid * WGM, gsz = (nM - fm) < WGM ? (nM - fm) : WGM;
    pm = fm + ((wgid % nig) % gsz); pn = (wgid % nig) / gsz;
}
struct SchedGrid {
    int nM, nN, G, c, z; const char* A0; const char* B0; size_t tstep; int wgm = WGM;
    __device__ __forceinline__ bool next(int i, Unit& u) const {
        const long Lx = (long)i * G + c; if (Lx >= (long)nM * nN) return false;
        tile_of((int)Lx, nM, nN, u.pm, u.pn, wgm); u.A = A0 + (size_t)u.pm * tstep; u.B = B0 + (size_t)u.pn * tstep; u.z = z; return true;
    }
};

#ifndef MK_SP2
#define MK_SP2 true
#endif
#ifndef MK_ALIGN
#define MK_ALIGN true
#endif
template <class Epi, class Sched, bool ALIGN_EPI = MK_ALIGN, bool SP2 = MK_SP2>
__device__ __forceinline__ void gemm_phase(LAS unsigned char* lds, const int RBc  , const Sched& S, const Epi& E, const int ntc = 0  ) {
    const int tid = threadIdx.x, wid = __builtin_amdgcn_readfirstlane(tid >> 6), lane = tid & 63, wr = wid >> 2, wc = wid & 3, fr = lane & 15, fq = lane >> 4;
    int RB = RBc; asm volatile("" : "+s"(RB));
    const int nt = ntc ? ntc : RB / 128;
    unsigned voffA[2], voffB[2];
#pragma unroll
    for (int i = 0; i < 2; ++i) { int R, C; stage_rc(tid * 16 + i * 8192, R, C); const int Rb = Epi::PERM ? ((R & ~31) + perm32(R & 31)) : R;
        voffA[i] = (unsigned)(R * RB + C * 2); voffB[i] = (unsigned)(Rb * RB + C * 2); }
    const size_t kstep = (size_t)(BK * 2);
    const size_t hstep = (size_t)HALF * RB;
    const unsigned ldsw = (unsigned)wid * 1024u;
    const int aoff = lds_byte(wr * 64 + fr, fq * 8), boff = lds_byte(wc * 32 + fr, fq * 8);
#define PG8_SA(b, h) (((b) * 2 + (h)) * HTB)
#define PG8_SB(b, h) ((4 + (b) * 2 + (h)) * HTB)
#define PG8_STAGE(bufoff, gbase, voff) do { _Pragma("unroll") for (int _i = 0; _i < 2; ++_i) \
        __builtin_amdgcn_global_load_lds((const unsigned*)((const char*)(gbase) + (voff)[_i]), (LAS unsigned*)(lds + (bufoff) + ldsw + _i * 8192), 16, 0, 0); } while (0)
#define PG8_LD8(addr) __builtin_shufflevector(*(const LAS i32x4*)(addr), *(const LAS i32x4*)((addr) + 1024), 0, 1, 2, 3, 4, 5, 6, 7)
#define PG8_LDA(dst, b, h) do { _Pragma("unroll") for (int m = 0; m < 4; ++m) dst[m] = PG8_LD8(lds + PG8_SA(b, h) + aoff + m * 2048); } while (0)
#define PG8_LDB(dst, b, h) do { _Pragma("unroll") for (int n = 0; n < 2; ++n) dst[n] = PG8_LD8(lds + PG8_SB(b, h) + boff + n * 2048); } while (0)
#define PG8_H0(x) __builtin_bit_cast(bf16x8, __builtin_shufflevector(x, x, 0, 1, 2, 3))
#define PG8_H1(x) __builtin_bit_cast(bf16x8, __builtin_shufflevector(x, x, 4, 5, 6, 7))
#define PG8_MMA(ai, bj, At, Bt) do { __builtin_amdgcn_s_setprio(1); _Pragma("unroll") for (int m = 0; m < 4; ++m) _Pragma("unroll") for (int n = 0; n < 2; ++n) { \
        if constexpr (Epi::F8) asm volatile("v_mfma_f32_16x16x128_f8f6f4 %0, %1, %2, %0" : "+v"(acc[ai][bj][m][n]) : "v"(Bt[n]), "v"(At[m])); \
        else { acc[ai][bj][m][n] = __builtin_amdgcn_mfma_f32_16x16x32_bf16(PG8_H0(Bt[n]), PG8_H0(At[m]), acc[ai][bj][m][n], 0, 0, 0); \
               acc[ai][bj][m][n] = __builtin_amdgcn_mfma_f32_16x16x32_bf16(PG8_H1(Bt[n]), PG8_H1(At[m]), acc[ai][bj][m][n], 0, 0, 0); } } \
        if constexpr (Epi::F8) asm volatile("s_nop 7" ::: "memory");     \
        __builtin_amdgcn_s_setprio(0); } while (0)
#define PG8_WAIT_V(n) asm volatile("s_waitcnt vmcnt(" #n ")" ::: "memory")
#define PG8_WAIT_L(n) asm volatile("s_waitcnt lgkmcnt(" #n ")" ::: "memory")
#define PG8_BAR __builtin_amdgcn_s_barrier()
#define PG8_SCHED __builtin_amdgcn_sched_barrier(0)
    Unit cur, nxt; int ui = 0;
    if (!S.next(0, cur)) return;
    f32x4 acc[2][2][4][2];
#pragma unroll
    for (int a = 0; a < 2; ++a)
#pragma unroll
        for (int b = 0; b < 2; ++b)
#pragma unroll
            for (int m = 0; m < 4; ++m)
#pragma unroll
                for (int n = 0; n < 2; ++n) acc[a][b][m][n] = (f32x4){0.f, 0.f, 0.f, 0.f};
    i32x8 At[4], B0[2], B1[2];
    const char* cA = cur.A; const char* cB = cur.B;
    if constexpr (SP2) {
        PG8_STAGE(PG8_SB(0, 0), cB, voffB); PG8_STAGE(PG8_SB(0, 1), cB + hstep, voffB); PG8_STAGE(PG8_SA(0, 0), cA, voffA); PG8_STAGE(PG8_SA(0, 1), cA + hstep, voffA);
        if (wr == 1) PG8_BAR;
        PG8_WAIT_V(2); PG8_BAR;
        PG8_STAGE(PG8_SB(1, 0), cB + kstep, voffB); PG8_STAGE(PG8_SA(1, 0), cA + kstep, voffA); PG8_STAGE(PG8_SB(1, 1), cB + hstep + kstep, voffB);
        PG8_WAIT_V(6); PG8_BAR;
    } else {
        PG8_STAGE(PG8_SB(0, 0), cB, voffB); PG8_STAGE(PG8_SA(0, 0), cA, voffA); PG8_STAGE(PG8_SB(0, 1), cB + hstep, voffB); PG8_STAGE(PG8_SA(0, 1), cA + hstep, voffA);
        if (wr == 1) PG8_BAR;
        PG8_WAIT_V(4); PG8_BAR;
        PG8_STAGE(PG8_SB(1, 0), cB + kstep, voffB); PG8_STAGE(PG8_SA(1, 0), cA + kstep, voffA); PG8_STAGE(PG8_SB(1, 1), cB + hstep + kstep, voffB);
        PG8_WAIT_V(6); PG8_BAR;
    }
    for (;;) {
        const bool has_next = S.next(ui + 1, nxt);
        const char* nA = has_next ? nxt.A : cA; const char* nB = has_next ? nxt.B : cB;
        for (int t = 0; t < nt; t += 2) {
            const bool last = (t == nt - 2);
            const char* a1 = cA + (size_t)(t + 1) * kstep;
            const char* a2 = last ? nA : cA + (size_t)(t + 2) * kstep; const char* b2 = last ? nB : cB + (size_t)(t + 2) * kstep;
            const char* a3 = a2 + kstep; const char* b3 = b2 + kstep;
            if constexpr (SP2) {
            PG8_LDB(B0, 0, 0); PG8_LDB(B1, 0, 1); PG8_SCHED; PG8_LDA(At, 0, 0); PG8_STAGE(PG8_SA(1, 1), a1 + hstep, voffA);
            PG8_WAIT_V(8); PG8_WAIT_L(0); PG8_BAR; PG8_MMA(0, 0, At, B0); PG8_MMA(0, 1, At, B1); PG8_BAR; PG8_SCHED;
            PG8_LDA(At, 0, 1); PG8_STAGE(PG8_SB(0, 0), b2, voffB); PG8_STAGE(PG8_SB(0, 1), b2 + hstep, voffB); PG8_STAGE(PG8_SA(0, 0), a2, voffA);
            PG8_WAIT_V(8); PG8_WAIT_L(0); PG8_BAR; PG8_MMA(1, 0, At, B0); PG8_MMA(1, 1, At, B1); PG8_BAR; PG8_SCHED;
            PG8_LDB(B0, 1, 0); PG8_LDB(B1, 1, 1); PG8_SCHED; PG8_LDA(At, 1, 0); PG8_STAGE(PG8_SA(0, 1), a2 + hstep, voffA);
            PG8_WAIT_V(8); PG8_WAIT_L(0); PG8_BAR; PG8_MMA(0, 0, At, B0); PG8_MMA(0, 1, At, B1); PG8_BAR; PG8_SCHED;
            PG8_LDA(At, 1, 1); PG8_STAGE(PG8_SB(1, 0), b3, voffB); PG8_STAGE(PG8_SB(1, 1), b3 + hstep, voffB); PG8_STAGE(PG8_SA(1, 0), a3, voffA);
            PG8_WAIT_V(8); PG8_WAIT_L(0); PG8_BAR; PG8_MMA(1, 0, At, B0); PG8_MMA(1, 1, At, B1); PG8_BAR; PG8_SCHED;
            } else {
            PG8_LDB(B0, 0, 0); PG8_SCHED; PG8_LDA(At, 0, 0); PG8_STAGE(PG8_SA(1, 1), a1 + hstep, voffA);
            PG8_WAIT_L(8); PG8_BAR; PG8_WAIT_L(0); PG8_MMA(0, 0, At, B0); PG8_BAR; PG8_SCHED;
            PG8_LDB(B1, 0, 1); PG8_STAGE(PG8_SB(0, 0), b2, voffB);
            PG8_BAR; PG8_WAIT_L(0); PG8_MMA(0, 1, At, B1); PG8_BAR;
            PG8_LDA(At, 0, 1); PG8_STAGE(PG8_SA(0, 0), a2, voffA);
            PG8_BAR; PG8_WAIT_L(0); PG8_MMA(1, 0, At, B0); PG8_BAR; PG8_SCHED;
            PG8_STAGE(PG8_SB(0, 1), b2 + hstep, voffB);
            PG8_WAIT_V(6); PG8_BAR; PG8_MMA(1, 1, At, B1); PG8_BAR;
            PG8_LDB(B0, 1, 0); PG8_SCHED; PG8_LDA(At, 1, 0); PG8_STAGE(PG8_SA(0, 1), a2 + hstep, voffA);
            PG8_WAIT_L(8); PG8_BAR; PG8_WAIT_L(0); PG8_MMA(0, 0, At, B0); PG8_BAR; PG8_SCHED;
            PG8_LDB(B1, 1, 1); PG8_STAGE(PG8_SB(1, 0), b3, voffB);
            PG8_BAR; PG8_WAIT_L(0); PG8_MMA(0, 1, At, B1); PG8_BAR;
            PG8_LDA(At, 1, 1); PG8_STAGE(PG8_SA(1, 0), a3, voffA);
            PG8_BAR; PG8_WAIT_L(0); PG8_MMA(1, 0, At, B0); PG8_BAR; PG8_SCHED;
            PG8_STAGE(PG8_SB(1, 1), b3 + hstep, voffB);
            PG8_WAIT_V(6); PG8_BAR; PG8_MMA(1, 1, At, B1); PG8_BAR;
            }
        }
        if constexpr (ALIGN_EPI) { if (wr == 0) PG8_BAR; }
        if constexpr (Epi::F8) asm volatile("s_nop 15\n\ts_nop 15" ::: "memory");
        bool keep = false;
        if constexpr (Epi::KEEP) keep = E(acc, cur, wr, wc, fr, fq); else E(acc, cur, wr, wc, fr, fq);
        if (!has_next) break;
        if (!keep) {
#pragma unroll
        for (int a = 0; a < 2; ++a)
#pragma unroll
            for (int b = 0; b < 2; ++b)
#pragma unroll
                for (int m = 0; m < 4; ++m)
#pragma unroll
                    for (int n = 0; n < 2; ++n) acc[a][b][m][n] = (f32x4){0.f, 0.f, 0.f, 0.f};
        }
        cur = nxt; cA = nA; cB = nB; ++ui;
        if constexpr (ALIGN_EPI) { if (wr == 1) PG8_BAR; }
    }
    PG8_WAIT_V(0);
    if constexpr (!ALIGN_EPI) { if (wr == 0) PG8_BAR; }
    PG8_BAR;
#undef PG8_SA
#undef PG8_SB
#undef PG8_STAGE
#undef PG8_LD8
#undef PG8_H0
#undef PG8_H1
#undef PG8_LDA
#undef PG8_LDB
#undef PG8_MMA
#undef PG8_WAIT_V
#undef PG8_WAIT_L
#undef PG8_BAR
#undef PG8_SCHED
}
}

namespace epi {
using pg8::Unit;
typedef const f32x4 (&AccT)[2][2][4][2];
__device__ __forceinline__ u32x4 pack8(f32x4 v0, f32x4 v1) { u32x4 w; w.x = cvt_pk_bf16(v0[0], v0[1]); w.y = cvt_pk_bf16(v0[2], v0[3]); w.z = cvt_pk_bf16(v1[0], v1[1]); w.w = cvt_pk_bf16(v1[2], v1[3]); return w; }
#ifndef MK_EPI_NT
#define MK_EPI_NT 0
#endif
template <class T> __device__ __forceinline__ void est(T* p, T v) { if constexpr (MK_EPI_NT != 0) __builtin_nontemporal_store(v, p); else *p = v; }
__device__ __forceinline__ void unpack8(u32x4 w, f32x4& v0, f32x4& v1) { v0 = (f32x4){bf_lo(w.x), bf_hi(w.x), bf_lo(w.y), bf_hi(w.y)}; v1 = (f32x4){bf_lo(w.z), bf_hi(w.z), bf_lo(w.w), bf_hi(w.w)}; }
__device__ __forceinline__ unsigned q8(float g) { return (unsigned)fminf(fmaxf(g * 255.f + 0.5f, 1.f), 255.f); }
__device__ __forceinline__ unsigned pk4_u8(f32x4 v) { return q8(v[0]) | (q8(v[1]) << 8) | (q8(v[2]) << 16) | (q8(v[3]) << 24); }
__device__ __forceinline__ void unpack8_u8(u32x2 w, f32x4& v0, f32x4& v1) {
    v0 = (f32x4){(float)((w.x >> 0) & 255u), (float)((w.x >> 8) & 255u), (float)((w.x >> 16) & 255u), (float)((w.x >> 24) & 255u)};
    v1 = (f32x4){(float)((w.y >> 0) & 255u), (float)((w.y >> 8) & 255u), (float)((w.y >> 16) & 255u), (float)((w.y >> 24) & 255u)}; }
__device__ __forceinline__ float sum8sq(f32x4 a, f32x4 b) { return (a[0] * a[0] + a[1] * a[1]) + (a[2] * a[2] + a[3] * a[3]) + (b[0] * b[0] + b[1] * b[1]) + (b[2] * b[2] + b[3] * b[3]); }
typedef unsigned long long ss_t;
__device__ __forceinline__ ss_t ss_fix(float sq) { return (ss_t)(sq * 16777216.f); }
__device__ __forceinline__ float ss_val(const ss_t* ss, int row) { return (float)ss[row] * (1.f / 16777216.f); }
__device__ __forceinline__ void row_atomic(ss_t* ss, int row, float sq, int fq) { sq += __shfl_xor(sq, 16); sq += __shfl_xor(sq, 32); if (fq == 0) atomicAdd(ss + row, ss_fix(sq)); }

struct EpiBf16 { static constexpr bool PERM = true, KEEP = false, F8 = false;
    bf16_t* O; int ldc;
    __device__ __forceinline__ void operator()(AccT acc, const Unit& u, int wr, int wc, int fr, int fq) const {
        const int row0 = u.pm * 256 + wr * 64 + fr, col0 = u.pn * 256 + wc * 32 + 8 * fq;
#pragma unroll
        for (int ai = 0; ai < 2; ++ai)
#pragma unroll
            for (int m = 0; m < 4; ++m) { bf16_t* rp = O + (size_t)(row0 + ai * 128 + m * 16) * ldc + col0;
#pragma unroll
                for (int bj = 0; bj < 2; ++bj) est((u32x4*)(rp + bj * 128), (u32x4)pack8(acc[ai][bj][m][0], acc[ai][bj][m][1])); }
    }
};
struct EpiInproj { static constexpr bool PERM = true, KEEP = false, F8 = false;
    bf16_t* O; const ss_t* ss; ss_t* ssv; unsigned char* G8;
    __device__ __forceinline__ void operator()(AccT acc, const Unit& u, int wr, int wc, int fr, int fq) const {
        const int type = u.pn < 10 ? 0 : (u.pn < 14 ? 1 : (u.pn < 18 ? 2 : 3));
        const int row0 = u.pm * 256 + wr * 64 + fr, col0 = u.pn * 256 + wc * 32 + 8 * fq;
#pragma unroll
        for (int ai = 0; ai < 2; ++ai)
#pragma unroll
            for (int m = 0; m < 4; ++m) { const int row = row0 + ai * 128 + m * 16; const float r = rsqrtf(ss_val(ss, row) * (1.0f / DM) + EPS); bf16_t* rp = O + (size_t)row * NIN + col0; float sq = 0.f;
#pragma unroll
                for (int bj = 0; bj < 2; ++bj) { f32x4 v0 = acc[ai][bj][m][0] * r, v1 = acc[ai][bj][m][1] * r;
                    if (type == 1 || type == 2) {
#pragma unroll
                        for (int j = 0; j < 4; ++j) { v0[j] = gelu_t(v0[j]); v1[j] = gelu_t(v1[j]); }
                        if (type == 2) sq += sum8sq(v0, v1); }
                    if (type == 3) {
#pragma unroll
                        for (int j = 0; j < 4; ++j) { v0[j] = sigm(v0[j]); v1[j] = sigm(v1[j]); }
                        est((u32x2*)(G8 + (size_t)row * (NIN - C_G) + (col0 - C_G) + bj * 128), (u32x2)(u32x2){pk4_u8(v0), pk4_u8(v1)}); }
                    else est((u32x4*)(rp + bj * 128), (u32x4)pack8(v0, v1)); }
                if (type == 2) row_atomic(ssv, row, sq, fq); }
    }
};
struct EpiGlu { static constexpr bool PERM = true, KEEP = false, F8 = false;
    const bf16_t* ssmy; bf16_t* ssmo;
    __device__ __forceinline__ void operator()(AccT acc, const Unit& u, int wr, int wc, int fr, int fq) const {
        const int row0 = u.pm * 256 + wr * 64 + fr, col0 = u.pn * 256 + wc * 32 + 8 * fq;
#pragma unroll
        for (int ai = 0; ai < 2; ++ai)
#pragma unroll
            for (int m = 0; m < 4; ++m) { const int row = row0 + ai * 128 + m * 16;
#pragma unroll
                for (int bj = 0; bj < 2; ++bj) { const int col = col0 + bj * 128; const f32x4 a0 = acc[ai][bj][m][0], a1 = acc[ai][bj][m][1];
                    f32x4 y0, y1; unpack8(*(const u32x4*)(ssmy + (size_t)row * 1024 + col), y0, y1);
#pragma unroll
                    for (int j = 0; j < 4; ++j) { y0[j] *= sigm(a0[j]); y1[j] *= sigm(a1[j]); }
                    est((u32x4*)(ssmo + (size_t)row * 1024 + col), (u32x4)pack8(y0, y1)); } }
    }
};
struct EpiMerge { static constexpr bool PERM = true, KEEP = true, F8 = false;
    const unsigned char* G8; bf16_t* mrgb;
    __device__ __forceinline__ bool operator()(f32x4 (&acc)[2][2][4][2], const Unit& u, int wr, int wc, int fr, int fq) const {
        const int row0 = u.pm * 256 + wr * 64 + fr, col0 = u.pn * 256 + wc * 32 + 8 * fq;
        const int gc = u.z == 0 ? 0 : (u.z == 1 ? 2 : 1), gn = u.z == 0 ? 2 : 1;
#pragma unroll
        for (int ai = 0; ai < 2; ++ai)
#pragma unroll
            for (int m = 0; m < 4; ++m) { const int row = row0 + ai * 128 + m * 16;
#pragma unroll
                for (int bj = 0; bj < 2; ++bj) { const int col = col0 + bj * 128; f32x4 g0, g1; unpack8_u8(*(const u32x2*)(G8 + (size_t)row * (NIN - C_G) + gc * DM + col), g0, g1);
                    if (u.z < 2) { f32x4 h0, h1; unpack8_u8(*(const u32x2*)(G8 + (size_t)row * (NIN - C_G) + gn * DM + col), h0, h1);
#pragma unroll
                        for (int j = 0; j < 4; ++j) { g0[j] *= __builtin_amdgcn_rcpf(h0[j]); g1[j] *= __builtin_amdgcn_rcpf(h1[j]); }
                        acc[ai][bj][m][0] *= g0; acc[ai][bj][m][1] *= g1;
                    } else est((u32x4*)(mrgb + (size_t)row * DM + col), (u32x4)pack8(acc[ai][bj][m][0] * (g0 * (1.f / 255.f)), acc[ai][bj][m][1] * (g1 * (1.f / 255.f)))); } }
        return u.z < 2;
    }
};
template <bool F8IN, bool F8OUT, bool RIN16> struct EpiResid { static constexpr bool PERM = true, KEEP = false, F8 = F8IN;
    const void* Xin; bf16_t* Xout; void* XB; ss_t* ss; float ascale; const float* gain;
    __device__ __forceinline__ void operator()(AccT acc, const Unit& u, int wr, int wc, int fr, int fq) const {
        const int row0 = u.pm * 256 + wr * 64 + fr, col0 = u.pn * 256 + wc * 32 + 8 * fq;
        f32x4 gv[2][2];
#pragma unroll
        for (int bj = 0; bj < 2; ++bj) { gv[bj][0] = *(const f32x4*)(gain + col0 + bj * 128); gv[bj][1] = *(const f32x4*)(gain + col0 + bj * 128 + 4); }
#pragma unroll
        for (int ai = 0; ai < 2; ++ai)
#pragma unroll
            for (int m = 0; m < 4; ++m) { const int row = row0 + ai * 128 + m * 16; float sq = 0.f;
#pragma unroll
                for (int bj = 0; bj < 2; ++bj) { const size_t o = (size_t)row * DM + col0 + bj * 128;
                    f32x4 r0, r1; if constexpr (RIN16) unpack8(*(const u32x4*)((const bf16_t*)Xin + o), r0, r1); else { r0 = *(const f32x4*)((const float*)Xin + o); r1 = *(const f32x4*)((const float*)Xin + o + 4); }
                    const f32x4 x0 = r0 + acc[ai][bj][m][0] * ascale, x1 = r1 + acc[ai][bj][m][1] * ascale;
                    est((u32x4*)(Xout + o), (u32x4)pack8(x0, x1));
                    const f32x4 y0 = x0 * gv[bj][0], y1 = x1 * gv[bj][1];
                    if constexpr (F8OUT) est((u32x2*)((unsigned char*)XB + o), (u32x2)(u32x2){pk4_fp8(y0[0], y0[1], y0[2], y0[3]), pk4_fp8(y1[0], y1[1], y1[2], y1[3])});
                    else est((u32x4*)((bf16_t*)XB + o), (u32x4)pack8(y0, y1));
                    sq += sum8sq(x0, x1); }
                row_atomic(ss, row, sq, fq); }
    }
};
template <bool F8_, bool F8OUT = F8_> struct EpiSwiglu { static constexpr bool PERM = false, KEEP = false, F8 = F8_;
    void* O; int ldo; const void* rs; int is_rstd; float ascale;
    __device__ __forceinline__ void operator()(AccT acc, const Unit& u, int wr, int wc, int fr, int fq) const {
        const int row0 = u.pm * 256 + wr * 64 + fr, col0 = u.pn * 128 + wc * 32 + 8 * fq;
#pragma unroll
        for (int ai = 0; ai < 2; ++ai)
#pragma unroll
            for (int m = 0; m < 4; ++m) { const int row = row0 + ai * 128 + m * 16; const float r = (is_rstd ? ((const float*)rs)[row] : rsqrtf(ss_val((const ss_t*)rs, row) * (1.0f / DM) + EPS)) * ascale;
                f32x4 o[2];
#pragma unroll
                for (int bj = 0; bj < 2; ++bj) { const f32x4 a = acc[ai][bj][m][0] * r, b = acc[ai][bj][m][1] * r;
#pragma unroll
                    for (int j = 0; j < 4; ++j) o[bj][j] = a[j] * sigm(a[j]) * b[j]; }
                if constexpr (F8OUT) est((u32x2*)((unsigned char*)O + (size_t)row * ldo + col0), (u32x2)(u32x2){pk4_fp8(o[0][0], o[0][1], o[0][2], o[0][3]), pk4_fp8(o[1][0], o[1][1], o[1][2], o[1][3])});
                else est((u32x4*)((bf16_t*)O + (size_t)row * ldo + col0), (u32x4)pack8(o[0], o[1])); }
    }
};
template <bool F8_, bool OUT32> struct EpiPle { static constexpr bool PERM = true, KEEP = false, F8 = F8_;
    const bf16_t* Xin; void* Xout; bf16_t* XB; const ss_t* ss_in; ss_t* ss_out; const bf16_t* pp; const float* gain; float ascale;
    __device__ __forceinline__ void operator()(AccT acc, const Unit& u, int wr, int wc, int fr, int fq) const {
        const int row0 = u.pm * 256 + wr * 64 + fr, col0 = u.pn * 256 + wc * 32 + 8 * fq;
#pragma unroll
        for (int ai = 0; ai < 2; ++ai)
#pragma unroll
            for (int m = 0; m < 4; ++m) { const int row = row0 + ai * 128 + m * 16; const float r = rsqrtf(ss_val(ss_in, row) * (1.0f / DM) + EPS) * ascale; float sq = 0.f;
#pragma unroll
                for (int bj = 0; bj < 2; ++bj) { const size_t o = (size_t)row * DM + col0 + bj * 128; f32x4 p0, p1; unpack8(*(const u32x4*)(pp + o), p0, p1);
                    f32x4 x0, x1; unpack8(*(const u32x4*)(Xin + o), x0, x1); const f32x4 a0 = acc[ai][bj][m][0] * r, a1 = acc[ai][bj][m][1] * r;
#pragma unroll
                    for (int j = 0; j < 4; ++j) { x0[j] += sigm(a0[j]) * p0[j]; x1[j] += sigm(a1[j]) * p1[j]; }
                    if constexpr (OUT32) { est((f32x4*)((float*)Xout + o), (f32x4)x0); est((f32x4*)((float*)Xout + o + 4), (f32x4)x1); } else est((u32x4*)((bf16_t*)Xout + o), (u32x4)pack8(x0, x1));
                    if (XB) *(u32x4*)(XB + o) = pack8(x0 * *(const f32x4*)(gain + col0 + bj * 128), x1 * *(const f32x4*)(gain + col0 + bj * 128 + 4)); sq += sum8sq(x0, x1); }
                if (ss_out) row_atomic(ss_out, row, sq, fq); }
    }
};
template <bool F8_> struct EpiMoe2 { static constexpr bool PERM = true, KEEP = false, F8 = F8_;
    bf16_t* YB; const float* row_gate; float ascale; bf16_t* YBX;
    __device__ __forceinline__ void operator()(AccT acc, const Unit& u, int wr, int wc, int fr, int fq) const {
        const int row0 = u.pm * 256 + wr * 64 + fr, col0 = u.pn * 256 + wc * 32 + 8 * fq;
#pragma unroll
        for (int ai = 0; ai < 2; ++ai)
#pragma unroll
            for (int m = 0; m < 4; ++m) { const int row = row0 + ai * 128 + m * 16; const float g = row_gate[row] * ascale; bf16_t* rp = (u.z == 0 ? YB + (size_t)row * DM : YBX + ((size_t)(u.z - 1) * 2048 + (row - 16384)) * DM) + col0;
#pragma unroll
                for (int bj = 0; bj < 2; ++bj) est((u32x4*)(rp + bj * 128), (u32x4)pack8(acc[ai][bj][m][0] * g, acc[ai][bj][m][1] * g)); }
    }
};
}

namespace attn {
constexpr int D = 128, NW = 8, QBLK = 32, KVBLK = 64;
constexpr float SCALE = 0.088388347648318440f;
constexpr float THR = 8.f;
constexpr int LDQ = 1024, LDK = 256, LDV = 256, LDO = 1024;
constexpr size_t SHM_V = KVBLK * D * 2, SHM_K = KVBLK * D * 2, SHM_ATTN = 2 * SHM_V + 2 * SHM_K + NW * 64 * 4;
#define KSWZ(row, colB) ((row) * 256 + ((colB) ^ (((row) & 7) << 4)))
#define SBAR() __builtin_amdgcn_sched_barrier(0)
__device__ __forceinline__ int crow(int r, int hi) { return (r & 3) + 8 * (r >> 2) + 4 * hi; }
__device__ __forceinline__ void partialSM(f32x16& p0, f32x16& p1, float& m_reg, float& mn, float& alpha) {
  constexpr float C = SCALE * 1.4426950408889634f;
  float pmax = p0[0]; for (int r = 1; r < 16; ++r) pmax = fmaxf(pmax, p0[r]); for (int r = 0; r < 16; ++r) pmax = fmaxf(pmax, p1[r]);
  { auto rr = __builtin_amdgcn_permlane32_swap(__float_as_uint(pmax), __float_as_uint(pmax), false, false);
    pmax = fmaxf(__uint_as_float(rr[0]), __uint_as_float(rr[1])); }
  if (__builtin_expect(__all(pmax - m_reg <= THR / SCALE), 1)) { mn = m_reg; alpha = 1.f; }
  else { mn = fmaxf(m_reg, pmax); alpha = __builtin_amdgcn_exp2f((m_reg - mn) * C); m_reg = mn; }
  float mnC = -mn * C;
  for (int r = 0; r < 16; ++r) p0[r] = fmaf(p0[r], C, mnC); for (int r = 0; r < 16; ++r) p1[r] = fmaf(p1[r], C, mnC);
  for (int r = 0; r < 16; ++r) p0[r] = __builtin_amdgcn_exp2f(p0[r]);
}
__device__ __forceinline__ void finishSM(f32x16& p0, f32x16& p1, float alpha, float& l_reg, bf16x8& pa0, bf16x8& pa1, bf16x8& pa2, bf16x8& pa3) {
  for (int r = 0; r < 16; ++r) p1[r] = __builtin_amdgcn_exp2f(p1[r]);
  float ps = 0; for (int r = 0; r < 16; ++r) ps += p0[r]; for (int r = 0; r < 16; ++r) ps += p1[r];
  { auto rr = __builtin_amdgcn_permlane32_swap(__float_as_uint(ps), __float_as_uint(ps), false, false);
    ps = __uint_as_float(rr[0]) + __uint_as_float(rr[1]); }
  l_reg = l_reg * alpha + ps;
#define PK4(P, BASE, OUT) do { unsigned a0 = cvt_pk_bf16(P[BASE + 0], P[BASE + 1]), a1 = cvt_pk_bf16(P[BASE + 2], P[BASE + 3]);   \
    unsigned b0 = cvt_pk_bf16(P[BASE + 4], P[BASE + 5]), b1 = cvt_pk_bf16(P[BASE + 6], P[BASE + 7]);                              \
    auto r0 = __builtin_amdgcn_permlane32_swap(a0, b0, false, false); auto r1 = __builtin_amdgcn_permlane32_swap(a1, b1, false, false); \
    u32x4 w = {r0[0], r1[0], r0[1], r1[1]}; OUT = *reinterpret_cast<bf16x8*>(&w); } while (0)
  PK4(p0, 0, pa0); PK4(p0, 8, pa1); PK4(p1, 0, pa2); PK4(p1, 8, pa3);
#undef PK4
}
__device__ __forceinline__ void qkt(f32x16& p0, f32x16& p1, const bf16_t* Ks, const bf16x8* qr, int r32, int hi) {
  p0 = f32x16{}; p1 = f32x16{};
  for (int d0 = 0; d0 < 8; ++d0) { int cb = (d0 * 16 + hi * 8) * 2;
    bf16x8 b0 = *reinterpret_cast<const bf16x8*>((const char*)Ks + KSWZ(r32, cb));
    bf16x8 b1 = *reinterpret_cast<const bf16x8*>((const char*)Ks + KSWZ(32 + r32, cb));
    p0 = __builtin_amdgcn_mfma_f32_32x32x16_bf16(b0, qr[d0], p0, 0, 0, 0);
    p1 = __builtin_amdgcn_mfma_f32_32x32x16_bf16(b1, qr[d0], p1, 0, 0, 0); }
}
__device__ __forceinline__ int v_st(int k, int c) { const int kk = (k & ~0xC) | ((k & 4) << 1) | ((k & 8) >> 1); return ((kk >> 3) * 4 + (c >> 5)) * 512 + ((kk & 7) * 32 + (c & 31)) * 2; }
__device__ __forceinline__ int v_rd_base(int lane) { return ((lane & 3) << 3) | (((lane >> 2) & 3) << 6) | (((lane >> 4) & 1) << 5) | (((lane >> 5) & 1) << 8); }
constexpr int v_rd_off(int d0, int ks, int half) { return d0 * 512 + ks * 4096 + half * 2048; }
template <int OFF> __device__ __forceinline__ s16x4 tr_read(int vb) {
  s16x4 r; asm volatile("ds_read_b64_tr_b16 %0, %1 offset:%2" : "=&v"(r) : "v"(vb), "i"(OFF) : "memory"); return r;
}
template <int D0> __device__ __forceinline__ void pv_one(f32x16& od, int vb, bf16x8 pa0, bf16x8 pa1, bf16x8 pa2, bf16x8 pa3) {
  const s16x4 l0 = tr_read<v_rd_off(D0, 0, 0)>(vb), h0 = tr_read<v_rd_off(D0, 0, 1)>(vb), l1 = tr_read<v_rd_off(D0, 1, 0)>(vb), h1 = tr_read<v_rd_off(D0, 1, 1)>(vb);
  const s16x4 l2 = tr_read<v_rd_off(D0, 2, 0)>(vb), h2 = tr_read<v_rd_off(D0, 2, 1)>(vb), l3 = tr_read<v_rd_off(D0, 3, 0)>(vb), h3 = tr_read<v_rd_off(D0, 3, 1)>(vb);
  asm volatile("s_waitcnt lgkmcnt(0)" ::: "memory"); SBAR();
#define PK(L, H) (bf16x8){L[0], L[1], L[2], L[3], H[0], H[1], H[2], H[3]}
  od = __builtin_amdgcn_mfma_f32_32x32x16_bf16(pa0, PK(l0, h0), od, 0, 0, 0);
  od = __builtin_amdgcn_mfma_f32_32x32x16_bf16(pa1, PK(l1, h1), od, 0, 0, 0);
  od = __builtin_amdgcn_mfma_f32_32x32x16_bf16(pa2, PK(l2, h2), od, 0, 0, 0);
  od = __builtin_amdgcn_mfma_f32_32x32x16_bf16(pa3, PK(l3, h3), od, 0, 0, 0);
#undef PK
}
__device__ __forceinline__ void pv_d0(f32x16* o, int vb, bf16x8 pa0, bf16x8 pa1, bf16x8 pa2, bf16x8 pa3) {
  pv_one<0>(o[0], vb, pa0, pa1, pa2, pa3); pv_one<1>(o[1], vb, pa0, pa1, pa2, pa3); pv_one<2>(o[2], vb, pa0, pa1, pa2, pa3); pv_one<3>(o[3], vb, pa0, pa1, pa2, pa3);
}
__device__ __forceinline__ void attn_dense_body(const bf16_t* __restrict__ Qb, const bf16_t* __restrict__ Kh, const bf16_t* __restrict__ Vh, bf16_t* __restrict__ Ob, int seq, char* lds) {
  constexpr int SDEPTH = 2;
  const int tid = threadIdx.x, wid = tid >> 6, lane = tid & 63, r32 = lane & 31, hi = lane >> 5;
  bf16_t* V_lds = (bf16_t*)lds; bf16_t* K_lds = (bf16_t*)(lds + 2 * SHM_V);
  float* ws = (float*)(lds + 2 * SHM_V + 2 * SHM_K) + wid * 64; float* li_l = ws; float* al_l = ws + 32;
  float m_reg = -1e30f, l_reg = 0; f32x16 o[4] = {}; bf16x8 qr[8];
  const bf16_t* Qw = Qb + (long)(wid * QBLK + r32) * LDQ + hi * 8;
#pragma unroll
  for (int d0 = 0; d0 < 8; ++d0) qr[d0] = *reinterpret_cast<const bf16x8*>(Qw + d0 * 16);
  const int sr = tid >> 4, sc = (tid & 15) * 8, vst0 = v_st(sr, sc), vst1 = v_st(32 + sr, sc);
  const int vb0 = (int)(uintptr_t)V_lds + v_rd_base(lane);
  struct { bf16x8 vs0, vs1, ks0, ks1; } sr_[SDEPTH];
#define SLOAD(i, k0) do { sr_[i].vs0 = *reinterpret_cast<const bf16x8*>(&Vh[(long)((k0) + sr) * LDV + sc]); sr_[i].vs1 = *reinterpret_cast<const bf16x8*>(&Vh[(long)((k0) + 32 + sr) * LDV + sc]); \
    sr_[i].ks0 = *reinterpret_cast<const bf16x8*>(&Kh[(long)((k0) + sr) * LDK + sc]); sr_[i].ks1 = *reinterpret_cast<const bf16x8*>(&Kh[(long)((k0) + 32 + sr) * LDK + sc]); } while (0)
#define SWRITE(b, i) do { *(bf16x8*)((char*)V_lds + (b) * SHM_V + vst0) = sr_[i].vs0;          \
    *(bf16x8*)((char*)V_lds + (b) * SHM_V + vst1) = sr_[i].vs1; int kc = sc * 2;               \
    *(bf16x8*)((char*)K_lds + (b) * SHM_K + KSWZ(sr, kc)) = sr_[i].ks0;                       \
    *(bf16x8*)((char*)K_lds + (b) * SHM_K + KSWZ(32 + sr, kc)) = sr_[i].ks1; } while (0)
#define SWAIT() do { asm volatile("s_waitcnt vmcnt(4)" ::: "memory"); } while (0)
#define RESC(a) do { if (__any((a) < 1.f)) { if (hi == 0) al_l[r32] = (a); asm volatile("s_waitcnt lgkmcnt(0)" ::: "memory"); \
    for (int d = 0; d < 4; ++d) for (int r = 0; r < 16; ++r) o[d][r] *= al_l[crow(r, hi)]; } } while (0)
  f32x16 pA0, pA1, pB0, pB1; float mnA, mnB, alA, alB; bf16x8 pa0, pa1, pa2, pa3; const int NTL = seq / KVBLK;
  constexpr int SE = 0, SO = SDEPTH - 1;
  SLOAD(SE, 0); asm volatile("s_waitcnt vmcnt(0)" ::: "memory"); SWRITE(0, SE); __syncthreads();
  qkt(pA0, pA1, K_lds, qr, r32, hi); partialSM(pA0, pA1, m_reg, mnA, alA);
  SLOAD(SO, KVBLK); if (2 < NTL) SLOAD(SE, 2 * KVBLK);
  SWAIT(); SWRITE(1, SO); __syncthreads();
  for (int j = 1; j + 1 < NTL; j += 2) {
    SBAR(); qkt(pB0, pB1, (bf16_t*)((char*)K_lds + SHM_K), qr, r32, hi);
    finishSM(pA0, pA1, alA, l_reg, pa0, pa1, pa2, pa3); SBAR();
    SLOAD(SO, (j + SDEPTH) * KVBLK); SBAR();
    pv_d0(o, vb0, pa0, pa1, pa2, pa3); partialSM(pB0, pB1, m_reg, mnB, alB);
    __syncthreads(); SWAIT(); SWRITE(0, SE);
    RESC(alB); __syncthreads();
    SBAR(); qkt(pA0, pA1, K_lds, qr, r32, hi);
    finishSM(pB0, pB1, alB, l_reg, pa0, pa1, pa2, pa3); SBAR();
    if (j + 3 < NTL) SLOAD(SE, (j + 1 + SDEPTH) * KVBLK); SBAR();
    pv_d0(o, vb0 + (int)SHM_V, pa0, pa1, pa2, pa3); partialSM(pA0, pA1, m_reg, mnA, alA);
    __syncthreads(); SWAIT(); SWRITE(1, SO);
    RESC(alA); __syncthreads();
  }
  SBAR(); qkt(pB0, pB1, (bf16_t*)((char*)K_lds + SHM_K), qr, r32, hi);
  finishSM(pA0, pA1, alA, l_reg, pa0, pa1, pa2, pa3); SBAR();
  pv_d0(o, vb0, pa0, pa1, pa2, pa3); partialSM(pB0, pB1, m_reg, mnB, alB);
  __syncthreads(); RESC(alB);
  finishSM(pB0, pB1, alB, l_reg, pa0, pa1, pa2, pa3); SBAR();
  pv_d0(o, vb0 + (int)SHM_V, pa0, pa1, pa2, pa3);
  if (hi == 0) li_l[r32] = l_reg; asm volatile("s_waitcnt lgkmcnt(0)" ::: "memory");
  float rli[16];
#pragma unroll
  for (int r = 0; r < 16; ++r) rli[r] = __builtin_amdgcn_rcpf(li_l[crow(r, hi)]);
  bf16_t* Ow = Ob + (long)(wid * QBLK) * LDO;
#pragma unroll
  for (int r = 0; r < 16; ++r) { int orow = crow(r, hi);
    for (int d0 = 0; d0 < 4; ++d0) Ow[(long)orow * LDO + d0 * 32 + r32] = f2bf(o[d0][r] * rli[r]); }
  __syncthreads();
#undef SLOAD
#undef SWRITE
#undef SWAIT
#undef RESC
}
}

namespace wsm {
constexpr size_t KiB = 1024, MiB = 1u << 20;
constexpr size_t CTL = 0, CTL_BYTES = 1 * MiB;
constexpr int CW_BAR = 0, CW_SS = 4096;
constexpr size_t LAMB = 1 * MiB, LAMT = LAMB + 128 * KiB;
constexpr size_t BBAR = 2 * MiB;
constexpr size_t CTT = 3 * MiB;
constexpr size_t WSB = 4 * MiB;
constexpr size_t ROUTE = 5 * MiB;
constexpr size_t R_IDX = ROUTE, R_GATE = ROUTE + 64 * KiB, R_TOKDEST = ROUTE + 128 * KiB, R_ROWTOK = ROUTE + 192 * KiB, R_ROWGATE = ROUTE + 320 * KiB, R_ROWRSTD = ROUTE + 448 * KiB,
                 R_HIST = ROUTE + 576 * KiB, R_TILES = ROUTE + 600 * KiB;
constexpr size_t ESTATE = 6 * MiB;
constexpr size_t W0 = 10 * MiB;
constexpr size_t SZ_WIN = (size_t)NIN * DM * 2, SZ_GLU = (size_t)1024 * 1024 * 2, SZ_WBR = (size_t)3 * DM * 1024 * 2, SZ_WOUT = (size_t)DM * DM * 2, SZ_PLEG = (size_t)DM * DM * 2, SZ_PLEP = (size_t)DM * PLED * 2;
constexpr size_t O_WIN = 0, O_GLU = O_WIN + SZ_WIN, O_WBR = O_GLU + SZ_GLU, O_WOUT = O_WBR + SZ_WBR, O_PLEG = O_WOUT + SZ_WOUT, O_PLEP = O_PLEG + SZ_PLEG, WL = O_PLEP + SZ_PLEP;
constexpr size_t FFN1 = W0 + 2 * WL, SZ_FFN1 = (size_t)2 * DFF * DM * 2, FFN2 = FFN1 + SZ_FFN1, SZ_FFN2 = (size_t)DM * DFF * 2;
constexpr size_t EXP1 = FFN2 + SZ_FFN2, SZ_EXP1 = (size_t)2 * DFE * DM * 2  , EXP2 = EXP1 + NEXP * SZ_EXP1, SZ_EXP2 = (size_t)DM * DFE * 2  ;
constexpr size_t ACT0 = (EXP2 + NEXP * SZ_EXP2 + 255) & ~(size_t)255;
constexpr size_t XF = ACT0, XBA = XF + (size_t)NT * DM * 4, XBB = XBA + (size_t)NT * DM * 2, PB = XBB + (size_t)NT * DM * 2, PP = PB + (size_t)2 * NT * PLED * 2, UNI = PP + (size_t)NT * DM * 2;
constexpr size_t PROJ = UNI, QN = PROJ + (size_t)NT * NIN * 2, KN = QN + (size_t)NT * 1024 * 2, VN = KN + (size_t)NT * 256 * 2, ATT = VN + (size_t)NT * 256 * 2,
                 SSMY = ATT + (size_t)NT * 1024 * 2, SSMO = SSMY + (size_t)NT * 1024 * 2, MLPO = SSMO + (size_t)NT * 1024 * 2, MRGF = MLPO + (size_t)NT * 1024 * 2, MRGB = MRGF + (size_t)NT * DM * 4,
                 MIX_END = MRGB + (size_t)NT * DM * 2;
constexpr size_t ACTD = UNI;
constexpr size_t XG = UNI, ACTM = XG + (size_t)CAPROWS * DM * 2, YB = ACTM + (size_t)CAPROWS * DFE * 2, YBX = YB + (size_t)CAPROWS * DM * 2, MOE_END = YBX + (size_t)3 * 2048 * DM * 2;
constexpr size_t END = (MIX_END > MOE_END ? MIX_END : MOE_END);
static_assert(MRGB >= ACTD + (size_t)NT * DFF * 2 || true, "");
}

#define XB_TMO      128
#define XB_XCNT(j)  (256  + 64 * (j))
#define XB_XSUB(j)  (1280 + 64 * (j))
#define XB_XGEN(j)  (2304 + 64 * (j))
#define XB_TOP      3328
#define XB_TOPGEN   3392
#define XCD_BAR_WORDS 3456
#define XB_SPIN_CAP (1u << 18)
#ifndef MK_EARLY_INV
#define MK_EARLY_INV 1
#endif
__device__ __forceinline__ unsigned xb_ld(unsigned* p)              { return __hip_atomic_load(p, __ATOMIC_RELAXED, __HIP_MEMORY_SCOPE_AGENT); }
__device__ __forceinline__ unsigned xb_add(unsigned* p, unsigned v) { return __hip_atomic_fetch_add(p, v, __ATOMIC_RELAXED, __HIP_MEMORY_SCOPE_AGENT); }
__device__ __forceinline__ unsigned xb_xcc_id() { return (unsigned)__builtin_amdgcn_s_getreg((3 << 11) | 20) & 0xFu; }
#define XB_SPIN(cond, bar) do { unsigned _sp = 0; while (cond) { __builtin_amdgcn_s_sleep(1); \
    if ((++_sp & 255u) == 0u) { if (xb_ld(&(bar)[XB_TMO])) break; if (_sp > XB_SPIN_CAP) { atomicAdd(&(bar)[XB_TMO], 1u); break; } } } } while (0)
struct XcdBarrier { unsigned* bar; unsigned x; volatile LAS unsigned* st; };
__device__ __forceinline__ XcdBarrier xcd_barrier_post(unsigned* bar, volatile LAS unsigned* st) {
    XcdBarrier b; b.bar = bar; b.x = xb_xcc_id(); b.st = st;
    if (threadIdx.x == 0) (void)xb_add(&bar[XB_XCNT(b.x)], 1u);
    return b;
}
__device__ __forceinline__ void xcd_barrier_complete(unsigned* bar, unsigned x, unsigned& nloc, unsigned& nx) {
    const unsigned G = gridDim.x * gridDim.y * gridDim.z;
    unsigned sum, cnt, mine, sp = 0u;
    for (;;) {
        sum = 0u; cnt = 0u; mine = 0u;
#pragma unroll
        for (unsigned j = 0; j < 16; ++j) { const unsigned c = xb_ld(&bar[XB_XCNT(j)]); sum += c; cnt += (c > 0u) ? 1u : 0u; mine = (j == x) ? c : mine; }
        if (sum == G) break;
        __builtin_amdgcn_s_sleep(1);
        if ((++sp & 255u) == 0u) { if (xb_ld(&bar[XB_TMO])) break; if (sp > XB_SPIN_CAP) { atomicAdd(&bar[XB_TMO], 1u); break; } }
    }
    nloc = mine > 0u ? mine : 1u; nx = cnt > 0u ? cnt : 1u;
}
__device__ __forceinline__ void xcd_barrier(const XcdBarrier& b) {
    asm volatile("s_waitcnt vmcnt(0)" ::: "memory");
    __syncthreads();
    if (threadIdx.x == 0) {
        unsigned* bar = b.bar;
        __builtin_amdgcn_s_waitcnt(0);
        unsigned nloc = b.st[0], nx = b.st[1];
        if (nloc == 0u) { xcd_barrier_complete(bar, b.x, nloc, nx); b.st[0] = nloc; b.st[1] = nx; }
        const unsigned old = xb_add(&bar[XB_XSUB(b.x)], 1u);
        const unsigned gen = old / nloc;
        if (old + 1u == (gen + 1u) * nloc) {
            __builtin_amdgcn_fence(__ATOMIC_RELEASE, "agent");
            asm volatile("s_waitcnt vmcnt(0)" ::: "memory");
            const unsigned og = xb_add(&bar[XB_TOP], 1u);
            const unsigned tg = og / nx;
            if (og + 1u == (tg + 1u) * nx) xb_add(&bar[XB_TOPGEN], 1u);
            else XB_SPIN(xb_ld(&bar[XB_TOPGEN]) == tg, bar);
            __builtin_amdgcn_fence(__ATOMIC_ACQUIRE, "agent");
            xb_add(&bar[XB_XGEN(b.x)], 1u);
            asm volatile("s_waitcnt vmcnt(0)" ::: "memory");
        } else {
#if MK_EARLY_INV
            __builtin_amdgcn_fence(__ATOMIC_ACQUIRE, "agent");
            XB_SPIN(xb_ld(&bar[XB_XGEN(b.x)]) == gen, bar);
            asm volatile("s_waitcnt vmcnt(0)" ::: "memory");
#else
            XB_SPIN(xb_ld(&bar[XB_XGEN(b.x)]) == gen, bar);
            __builtin_amdgcn_fence(__ATOMIC_ACQUIRE, "agent");
            asm volatile("s_waitcnt vmcnt(0)" ::: "memory");
#endif
        }
    }
    __syncthreads();
}

namespace thin {
constexpr int NW = 8;
__device__ __forceinline__ int swi_row(int a, int s) { const int pn = a >> 7, al = a & 127, wc = al >> 5, fq = (al >> 3) & 3, bj = (al >> 2) & 1, j = al & 3; return 256 * pn + 128 * bj + 32 * wc + 16 * s + 4 * fq + j; }
#ifndef MK_LDPOL
#define MK_LDPOL(p) __builtin_nontemporal_load(p)
#endif
struct ConvRegs { f32x4 v[16]; };
struct ConvDec { const float* src; unsigned char* dst; int k0, n0; };
template <bool F8>
__device__ __forceinline__ void conv_load(ConvRegs& R, const ConvDec& d, int ldn, int lane) {
    const int kp = lane >> 4, nq = lane & 15;
    const unsigned loff = (unsigned)(((F8 ? 4 : 2) * kp * ldn + 4 * nq) * 4);
    const char* base = (const char*)(d.src + (size_t)d.k0 * ldn + d.n0);
#pragma unroll
    for (int i = 0; i < 16; ++i) { const int ru = F8 ? (16 * (i >> 2) + (i & 3)) : (8 * (i >> 1) + (i & 1));
        const char* rb = base + (size_t)ru * ldn * 4; asm volatile("" : "+s"(rb));
        R.v[i] = MK_LDPOL((const f32x4*)(rb + loff)); }
}
template <int MAP, bool F8, bool NTS = true>
__device__ __forceinline__ void conv_store(const ConvRegs& R, const ConvDec& d, int K, float wscale, int s, LAS unsigned char* scr, int lane) {
    const int kp = lane >> 4, nq = lane & 15; const int k0 = d.k0, n0 = d.n0;
    constexpr int EBY = F8 ? 1 : 2;
    if constexpr (!F8) {
#pragma unroll
        for (int i = 0; i < 8; ++i) { const int kl = 8 * i + 2 * kp;
#pragma unroll
            for (int j = 0; j < 4; ++j) *(LAS unsigned*)(scr + (4 * nq + j) * 144 + (((4 * i + kp) ^ (4 * (nq >> 1))) << 2)) = cvt_pk_bf16(R.v[2 * i][j], R.v[2 * i + 1][j]); }
    } else {
#pragma unroll
        for (int i = 0; i < 4; ++i) { const int kl = 16 * i + 4 * kp;
#pragma unroll
            for (int j = 0; j < 4; ++j) *(LAS unsigned*)(scr + (4 * nq + j) * 80 + (((4 * i + kp) ^ (4 * ((nq >> 1) & 3))) << 2)) = pk4_fp8(R.v[4 * i][j] * wscale, R.v[4 * i + 1][j] * wscale, R.v[4 * i + 2][j] * wscale, R.v[4 * i + 3][j] * wscale); }
    }
    LDS_WAIT();
    constexpr int NR = F8 ? 4 : 8, LSH = F8 ? 2 : 3, NSTEP = F8 ? 16 : 8, LROW = F8 ? 80 : 144;
    const int nl = lane >> LSH, c = lane & ((1 << LSH) - 1);
    const unsigned lrow = (unsigned)(MAP == 0 ? nl : swi_row(nl, 0));
    const unsigned soff = lrow * (unsigned)(K * EBY) + 16u * c;
    const LAS unsigned char* lsrc = scr + nl * LROW;
#pragma unroll
    for (int r = 0; r < NR; ++r) { const int key = F8 ? (((nl >> 3) + 2 * r) & 3) : r;
        const u32x4 o = *(const LAS u32x4*)(lsrc + r * NSTEP * LROW + 16 * (c ^ key));
        const int urow = MAP == 0 ? (n0 + NSTEP * r) : swi_row(n0 + NSTEP * r, s);
        if constexpr (NTS) __builtin_nontemporal_store(o, (u32x4*)(d.dst + ((size_t)urow * K + k0) * EBY + soff)); else *(u32x4*)(d.dst + ((size_t)urow * K + k0) * EBY + soff) = o;
        if (r & 1) asm volatile("" ::: "memory"); }
    LDS_WAIT();
}
template <int MAP, bool F8, bool NTS = true>
__device__ __forceinline__ void conv_group(const float* src, size_t sstr, int count, int K, int N, void* dst, size_t dstr_bytes, float wscale, int s, LAS unsigned char* scr, int gw, int ngw, int lane, int flo = 0, int fhi = 64) {
    const int nb = N / 64, ipm = (K / 64) * nb, i0 = (int)((long)count * ipm * flo / 64), total = (int)((long)count * ipm * fhi / 64);
    auto dec = [&](int it) { const int sub = it / ipm, r = it - sub * ipm, kb = r / nb, nbi = r - kb * nb;
        return ConvDec{src + (size_t)sub * sstr, (unsigned char*)dst + (size_t)sub * dstr_bytes, kb * 64, nbi * 64}; };
    int it = i0 + gw; if (it >= total) return;
    ConvRegs RA, RB, RC; ConvDec dA = dec(it), dB = dA, dC = dA; conv_load<F8>(RA, dA, N, lane);
    { const int itb = it + ngw; if (itb < total) { dB = dec(itb); conv_load<F8>(RB, dB, N, lane); } }
    for (;;) {
        { const int n2 = it + 2 * ngw; if (n2 < total) { dC = dec(n2); conv_load<F8>(RC, dC, N, lane); } }
        conv_store<MAP, F8, NTS>(RA, dA, K, wscale, s, scr, lane); it += ngw; if (it >= total) break;
        { const int n2 = it + 2 * ngw; if (n2 < total) { dA = dec(n2); conv_load<F8>(RA, dA, N, lane); } }
        conv_store<MAP, F8, NTS>(RB, dB, K, wscale, s, scr, lane); it += ngw; if (it >= total) break;
        { const int n2 = it + 2 * ngw; if (n2 < total) { dB = dec(n2); conv_load<F8>(RB, dB, N, lane); } }
        conv_store<MAP, F8, NTS>(RC, dC, K, wscale, s, scr, lane); it += ngw; if (it >= total) break;
    }
}
struct CoopRegs { f32x4 v[8]; };
__device__ __forceinline__ void coop_load(CoopRegs& R, const float* src, int ldn, int k0, int n0, int wv, int lane) {
    const int kp = lane >> 4, nq = lane & 15; const unsigned loff = (unsigned)((4 * kp * ldn + 4 * nq) * 4);
    const char* base = (const char*)(src + (size_t)(k0 + 32 * wv) * ldn + n0);
#pragma unroll
    for (int i = 0; i < 8; ++i) { const char* rb = base + (size_t)(16 * (i >> 2) + (i & 3)) * ldn * 4; asm volatile("" : "+s"(rb)); R.v[i] = MK_LDPOL((const f32x4*)(rb + loff)); }
}
template <int MAP>
__device__ __forceinline__ void coop_group(const float* src, size_t sstr, int count, int K, int N, unsigned char* dst, size_t dstr_bytes, float wscale, int s, LAS unsigned char* tl  , int cwg, int ncwg, int flo, int fhi) {
    const int tid = threadIdx.x, lane = tid & 63, wv = __builtin_amdgcn_readfirstlane(tid >> 6), kp = lane >> 4, nq = lane & 15;
    const int nb = N / 64, ipm = (K / 256) * nb, i0 = (int)((long)count * ipm * flo / 64), total = (int)((long)count * ipm * fhi / 64);
    int it = i0 + cwg; if (it >= total) return;
    CoopRegs RA, RB; int p = 0;
#define COOP_DEC(it_, srcp, dstp, k0_, n0_) const int sub_ = (it_) / ipm, r_ = (it_) - sub_ * ipm, kb_ = r_ / nb; const float* srcp = src + (size_t)sub_ * sstr; unsigned char* dstp = dst + (size_t)sub_ * dstr_bytes; const int k0_ = kb_ * 256, n0_ = (r_ - kb_ * nb) * 64
#define COOP_STORE(R, it_) do { COOP_DEC(it_, sp_, dp_, k0, n0); (void)sp_; LAS unsigned char* T = tl + p * 17408; \
        _Pragma("unroll") for (int i = 0; i < 2; ++i) _Pragma("unroll") for (int j = 0; j < 4; ++j) \
            *(LAS unsigned*)(T + (4 * nq + j) * 272 + (((8 * wv + 4 * i + kp) ^ (4 * (nq >> 1))) << 2)) = pk4_fp8(R.v[4 * i][j] * wscale, R.v[4 * i + 1][j] * wscale, R.v[4 * i + 2][j] * wscale, R.v[4 * i + 3][j] * wscale); \
        __syncthreads(); \
        const int nl = tid >> 4, ch = tid & 15; const unsigned lrow = (unsigned)(MAP == 0 ? nl : swi_row(nl, 0)); const unsigned soff = lrow * (unsigned)K + 16u * ch; \
        _Pragma("unroll") for (int r = 0; r < 2; ++r) { const int n = nl + 32 * r; const u32x4 o = *(const LAS u32x4*)(T + n * 272 + 16 * (ch ^ (n >> 3))); \
            const int urow = MAP == 0 ? (n0 + 32 * r) : swi_row(n0 + 32 * r, s); \
            __builtin_nontemporal_store(o, (u32x4*)(dp_ + (size_t)urow * K + k0 + soff)); } \
        p ^= 1; } while (0)
    { COOP_DEC(it, sp, dp, k0, n0); (void)dp; coop_load(RA, sp, N, k0, n0, wv, lane); }
    for (;;) {
        const int it1 = it + ncwg; const bool h1 = it1 < total; if (h1) { COOP_DEC(it1, sp, dp, k0, n0); (void)dp; coop_load(RB, sp, N, k0, n0, wv, lane); }
        COOP_STORE(RA, it);
        if (!h1) break;
        const int it2 = it1 + ncwg; const bool h2 = it2 < total; if (h2) { COOP_DEC(it2, sp, dp, k0, n0); (void)dp; coop_load(RA, sp, N, k0, n0, wv, lane); }
        COOP_STORE(RB, it1);
        if (!h2) break;
        it = it2;
    }
    __syncthreads();
#undef COOP_DEC
#undef COOP_STORE
}
}

namespace thin {
__device__ __forceinline__ void ssm_tables(int it, const float* lre, const float* lim, const float* ldt, const float* bre, const float* bim, const float* cre, const float* cim,
                                           float* lamb, float* lamt, bf16_t* bbar, bf16_t* ctt, int lane) {
    const int p = lane;
    const float lr = lre[it * 64 + p], li = lim[it * 64 + p], dt = __expf(ldt[it]);
    const float er = __expf(lr * dt); float sn, cs; sincosf(li * dt, &sn, &cs); const float ar = er * cs, ai = er * sn;
    const float nr = ar - 1.f, ni = ai, den = lr * lr + li * li; const float fr = (nr * lr + ni * li) / den, fi = (ni * lr - nr * li) / den;
    lamb[(it * 64 + p) * 2] = ar; lamb[(it * 64 + p) * 2 + 1] = ai;
    float tr = ar, ti = ai;
#pragma unroll
    for (int q = 0; q < 7; ++q) { const float nr2 = tr * tr - ti * ti, ni2 = 2.f * tr * ti; tr = nr2; ti = ni2; }
    lamt[(it * 64 + p) * 2] = tr; lamt[(it * 64 + p) * 2 + 1] = ti;
    bf16_t* bR = bbar + ((size_t)(it * 2 + 0) * 64 + p) * 16; bf16_t* bI = bbar + ((size_t)(it * 2 + 1) * 64 + p) * 16;
#pragma unroll
    for (int c = 0; c < 16; ++c) { const float xr = bre[(it * 64 + p) * 16 + c], xi = bim[(it * 64 + p) * 16 + c]; bR[c] = f2bf(fr * xr - fi * xi); bI[c] = f2bf(fr * xi + fi * xr); }
#pragma unroll
    for (int c = 0; c < 16; ++c) { ctt[((size_t)it * 16 + c) * 128 + p] = f2bf(cre[(it * 16 + c) * 64 + p]); ctt[((size_t)it * 16 + c) * 128 + 64 + p] = f2bf(-cim[(it * 16 + c) * 64 + p]); }
}

struct BuFrags { bf16x8 r0, r1, i0, i1; };
__device__ __forceinline__ BuFrags load_bufrags(const bf16_t* bbar_dg  , int lane) {
    const int st = lane & 31, h = lane >> 5; BuFrags f;
    f.r0 = *(const bf16x8*)(bbar_dg + (size_t)(st) * 16 + 8 * h); f.r1 = *(const bf16x8*)(bbar_dg + (size_t)(32 + st) * 16 + 8 * h);
    f.i0 = *(const bf16x8*)(bbar_dg + (size_t)(64 + st) * 16 + 8 * h); f.i1 = *(const bf16x8*)(bbar_dg + (size_t)(96 + st) * 16 + 8 * h);
    return f;
}
__device__ __forceinline__ bf16x8 bu_load(const bf16_t* __restrict__ proj, int tok0, int g, int lane) { return *(const bf16x8*)(proj + (size_t)(tok0 + (lane & 31)) * NIN + C_U + g * 16 + 8 * (lane >> 5)); }
__device__ __forceinline__ void bu_block(const bf16x8 ua, const BuFrags& f, float (&BR)[32], float (&BI)[32]) {
    const f32x16 z = {};
    const f32x16 R0 = __builtin_amdgcn_mfma_f32_32x32x16_bf16(ua, f.r0, z, 0, 0, 0), R1 = __builtin_amdgcn_mfma_f32_32x32x16_bf16(ua, f.r1, z, 0, 0, 0);
    const f32x16 I0 = __builtin_amdgcn_mfma_f32_32x32x16_bf16(ua, f.i0, z, 0, 0, 0), I1 = __builtin_amdgcn_mfma_f32_32x32x16_bf16(ua, f.i1, z, 0, 0, 0);
#pragma unroll
    for (int r = 0; r < 16; ++r) {
        auto s = __builtin_amdgcn_permlane32_swap(__float_as_uint(R0[r]), __float_as_uint(R1[r]), false, false);
        BR[8 * (r >> 2) + (r & 3)] = __uint_as_float(s[0]); BR[8 * (r >> 2) + 4 + (r & 3)] = __uint_as_float(s[1]);
        auto q = __builtin_amdgcn_permlane32_swap(__float_as_uint(I0[r]), __float_as_uint(I1[r]), false, false);
        BI[8 * (r >> 2) + (r & 3)] = __uint_as_float(q[0]); BI[8 * (r >> 2) + 4 + (r & 3)] = __uint_as_float(q[1]);
    }
}
template <int DIR>
__device__ __forceinline__ void ssm_pass1_item(const bf16_t* __restrict__ proj, const float* __restrict__ lamb_l, const bf16_t* __restrict__ bbar_l, float* __restrict__ est, int b, int g, int n, int lane) {
    const int dg = DIR * 64 + g; const float ar = lamb_l[(dg * 64 + lane) * 2], ai = lamb_l[(dg * 64 + lane) * 2 + 1];
    const BuFrags f = load_bufrags(bbar_l + (size_t)dg * 2 * 64 * 16, lane);
    float sr = 0.f, si = 0.f;
    bf16x8 ua[4];
#pragma unroll
    for (int s = 0; s < 4; ++s) ua[s] = bu_load(proj, b * SEQ + n * 128 + (DIR ? 3 - s : s) * 32, g, lane);
#pragma unroll
    for (int s = 0; s < 4; ++s) { float BR[32], BI[32];
        bu_block(ua[s], f, BR, BI);
#pragma unroll
        for (int tt = 0; tt < 32; ++tt) { const int t = DIR ? 31 - tt : tt; const float nsr = fmaf(ar, sr, fmaf(-ai, si, BR[t])), nsi = fmaf(ar, si, fmaf(ai, sr, BI[t])); sr = nsr; si = nsi; } }
    float* e = est + ((((size_t)(DIR * 2 + b) * 64 + g) * 32 + n) * 64 + lane) * 2; *(f32x2*)e = (f32x2){sr, si};
}
template <int DIR>
__device__ __forceinline__ void ssm_pass2_dir(const bf16_t* __restrict__ proj, const float* __restrict__ lamb_l, const float* __restrict__ lamt_l, const bf16_t* __restrict__ bbar_l, const bf16_t* __restrict__ ctt_l,
                                              const float* __restrict__ est, int b, int g, int n, int lane, LAS unsigned char* sl, f32x4 (&yacc)[8]) {
    const int dg = DIR * 64 + g; const float ar = lamb_l[(dg * 64 + lane) * 2], ai = lamb_l[(dg * 64 + lane) * 2 + 1], tr = lamt_l[(dg * 64 + lane) * 2], ti = lamt_l[(dg * 64 + lane) * 2 + 1];
    float sr = 0.f, si = 0.f;
    { const float* e = est + ((((size_t)(DIR * 2 + b) * 64 + g) * 32) * 64 + lane) * 2; f32x2 ev[32];
#pragma unroll
      for (int m = 0; m < 32; ++m) ev[m] = *(const f32x2*)(e + (size_t)m * 128);
#pragma unroll
      for (int mm = 0; mm < 32; ++mm) { const int m = DIR ? 31 - mm : mm; const bool use = DIR ? (m > n) : (m < n);
          const float nsr = fmaf(tr, sr, fmaf(-ti, si, ev[m].x)), nsi = fmaf(tr, si, fmaf(ti, sr, ev[m].y)); sr = use ? nsr : sr; si = use ? nsi : si; } }
    const BuFrags f = load_bufrags(bbar_l + (size_t)dg * 2 * 64 * 16, lane);
    bf16x8 cb[4];
#pragma unroll
    for (int ks = 0; ks < 4; ++ks) cb[ks] = *(const bf16x8*)(ctt_l + ((size_t)dg * 16 + (lane & 15)) * 128 + 32 * ks + 8 * (lane >> 4));
    bf16x8 ua[4];
#pragma unroll
    for (int s = 0; s < 4; ++s) ua[s] = bu_load(proj, b * SEQ + n * 128 + (DIR ? 3 - s : s) * 32, g, lane);
#pragma unroll
    for (int s = 0; s < 4; ++s) { const int sb = DIR ? 3 - s : s; float BR[32], BI[32];
        bu_block(ua[s], f, BR, BI);
#pragma unroll
        for (int tt = 0; tt < 32; ++tt) { const int t = DIR ? 31 - tt : tt; const float nsr = fmaf(ar, sr, fmaf(-ai, si, BR[t])), nsi = fmaf(ar, si, fmaf(ai, sr, BI[t])); sr = nsr; si = nsi;
            const unsigned w = cvt_pk_bf16(sr, si); *(LAS bf16_t*)(sl + (t * 136 + lane) * 2) = (bf16_t)(w & 0xffffu); *(LAS bf16_t*)(sl + (t * 136 + 64 + lane) * 2) = (bf16_t)(w >> 16); }
        LDS_WAIT();
#pragma unroll
        for (int rb = 0; rb < 2; ++rb)
#pragma unroll
            for (int ks = 0; ks < 4; ++ks) { const bf16x8 a = *(const LAS bf16x8*)(sl + ((16 * rb + (lane & 15)) * 136 + 32 * ks + 8 * (lane >> 4)) * 2);
                yacc[2 * sb + rb] = __builtin_amdgcn_mfma_f32_16x16x32_bf16(a, cb[ks], yacc[2 * sb + rb], 0, 0, 0); }
        LDS_WAIT(); }
}
__device__ __forceinline__ void ssm_pass2_item(const bf16_t* __restrict__ proj, const float* lamb_l, const float* lamt_l, const bf16_t* bbar_l, const bf16_t* ctt_l, const float* est, const float* __restrict__ dskip,
                                               bf16_t* __restrict__ ssmy, int b, int g, int n, int lane, LAS unsigned char* sl) {
    f32x4 yacc[8];
#pragma unroll
    for (int i = 0; i < 8; ++i) yacc[i] = (f32x4){0.f, 0.f, 0.f, 0.f};
    ssm_pass2_dir<0>(proj, lamb_l, lamt_l, bbar_l, ctt_l, est, b, g, n, lane, sl, yacc);
    ssm_pass2_dir<1>(proj, lamb_l, lamt_l, bbar_l, ctt_l, est, b, g, n, lane, sl, yacc);
    const int c = lane & 15, ch = g * 16 + c; const float dk = dskip[ch];
#pragma unroll
    for (int blk = 0; blk < 8; ++blk)
#pragma unroll
        for (int r = 0; r < 4; ++r) { const int tok = b * SEQ + n * 128 + 16 * blk + 4 * (lane >> 4) + r;
            const float y = yacc[blk][r] + dk * bf2f(proj[(size_t)tok * NIN + C_U + ch]); ssmy[(size_t)tok * 1024 + ch] = f2bf(gelu_t(y)); }
}

__device__ __forceinline__ void rope_token(const bf16_t* __restrict__ proj, const float* __restrict__ qg, const float* __restrict__ kg, bf16_t* __restrict__ QN, bf16_t* __restrict__ KN, bf16_t* __restrict__ VN, int tok, int lane) {
    const int a = lane >> 5, f = lane & 31, i1 = a * 64 + f, i2 = i1 + 32; const int t = tok & (SEQ - 1);
    const float pos = a == 0 ? (float)((t >> 6) - 32) : (float)((t & 63) - 32);
    const float inv = exp2f(-(float)f * (13.287712379549449f / 32.f)); float sn, cs; sincosf(pos * inv, &sn, &cs);
    const bf16_t* src = proj + (size_t)tok * NIN;
#pragma unroll
    for (int hh = 0; hh < 10; ++hh) { const bf16_t* s = src + hh * 128; float x1 = bf2f(s[i1]), x2 = bf2f(s[i2]);
        const float ss = wave_sum(x1 * x1 + x2 * x2), rs = rsqrtf(ss * (1.f / 128.f) + EPS); const float* gn = hh < 8 ? qg : kg;
        x1 *= rs * gn[i1]; x2 *= rs * gn[i2];
        bf16_t* d = hh < 8 ? QN + (size_t)tok * 1024 + hh * 128 : KN + (size_t)tok * 256 + (hh - 8) * 128;
        d[i1] = f2bf(x1 * cs - x2 * sn); d[i2] = f2bf(x2 * cs + x1 * sn); }
    *(u32x2*)(VN + (size_t)tok * 256 + lane * 4) = *(const u32x2*)(src + C_V + lane * 4);
}

__device__ __forceinline__ void gmlp_item(const bf16_t* __restrict__ proj, const epi::ss_t* __restrict__ ssv, const float* __restrict__ vgain, const bf16_t* __restrict__ wsb_l, const float* __restrict__ bs_l,
                                          bf16_t* __restrict__ mlpo, int cn, int g, LAS unsigned char* lds) {
    const int tid = threadIdx.x, lane = tid & 63, wid = tid >> 6, tok0 = cn * 128;
    { const int p = tid >> 2, cb = (tid & 3) * 32; const float rs = rsqrtf(epi::ss_val(ssv, tok0 + p) * (1.f / 1024.f) + EPS);
#pragma unroll
      for (int cc = 0; cc < 4; ++cc) { const int c0 = cb + cc * 8; f32x4 v0, v1; epi::unpack8(*(const u32x4*)(proj + (size_t)(tok0 + p) * NIN + C_ZV + g * 128 + c0), v0, v1);
          const f32x4 g0 = *(const f32x4*)(vgain + g * 128 + c0), g1 = *(const f32x4*)(vgain + g * 128 + c0 + 4);
#pragma unroll
          for (int i = 0; i < 4; ++i) { *(LAS bf16_t*)(lds + ((c0 + i) * 136 + p) * 2) = f2bf(v0[i] * rs * g0[i]); *(LAS bf16_t*)(lds + ((c0 + 4 + i) * 136 + p) * 2) = f2bf(v1[i] * rs * g1[i]); } } }
    __syncthreads();
    const int qb = wid >> 1, ch = wid & 1, r32 = lane & 31, hi = lane >> 5;
    f32x16 a0 = {}, a1 = {};
#pragma unroll
    for (int ks = 0; ks < 8; ++ks) { const bf16x8 af = *(const bf16x8*)(wsb_l + ((size_t)g * 128 + 32 * qb + r32) * 128 + 16 * ks + 8 * hi);
        const bf16x8 b0 = *(const LAS bf16x8*)(lds + ((64 * ch + r32) * 136 + 16 * ks + 8 * hi) * 2), b1 = *(const LAS bf16x8*)(lds + ((64 * ch + 32 + r32) * 136 + 16 * ks + 8 * hi) * 2);
        a0 = __builtin_amdgcn_mfma_f32_32x32x16_bf16(af, b0, a0, 0, 0, 0); a1 = __builtin_amdgcn_mfma_f32_32x32x16_bf16(af, b1, a1, 0, 0, 0); }
#pragma unroll
    for (int r = 0; r < 16; ++r) { const int q = 32 * qb + (r & 3) + 8 * (r >> 2) + 4 * hi, tok = tok0 + q; const float bq = bs_l[g * 128 + q];
        const int c0 = g * 128 + 64 * ch + r32;
        mlpo[(size_t)tok * 1024 + c0] = f2bf(bf2f(proj[(size_t)tok * NIN + C_ZU + c0]) * (a0[r] + bq));
        mlpo[(size_t)tok * 1024 + c0 + 32] = f2bf(bf2f(proj[(size_t)tok * NIN + C_ZU + c0 + 32]) * (a1[r] + bq)); }
    __syncthreads();
}
}

struct SchedMerge {
    int G, c; const char *wsb, *wbr;
    __device__ __forceinline__ bool next(int i, pg8::Unit& u) const {
        const int Lx = i * G + c; if (Lx >= 768) return false;
        constexpr size_t ts = (size_t)256 * 1024 * 2;
        const int z = Lx >> 8; pg8::tile_of(Lx & 255, 32, 8, u.pm, u.pn); u.z = z;
        const size_t ao = z == 0 ? wsm::ATT : (z == 1 ? wsm::MLPO : wsm::SSMO), bo = (z == 0 ? (size_t)0 : (z == 1 ? (size_t)2 : (size_t)1)) * ((size_t)DM * 1024 * 2);
        u.A = wsb + ao + (size_t)u.pm * ts; u.B = wbr + bo + (size_t)u.pn * ts;
        return true;
    }
};
struct SchedMoe {
    int G, c, nN; const int* tiles; const char* A0; const char* B0; size_t tsA, tsB, estride;
    __device__ __forceinline__ bool next(int i, pg8::Unit& u) const {
        const int T = tiles[0]; const long Lx = (long)i * G + c; if (Lx >= (long)T * nN) return false;
        pg8::tile_of((int)Lx, T, nN, u.pm, u.pn); const int e = tiles[1 + u.pm]; u.z = e;
        u.A = A0 + (size_t)u.pm * tsA; u.B = B0 + (size_t)e * estride + (size_t)u.pn * tsB; return true;
    }
};

struct Args { const float* in[31]; float* out; unsigned char* ws; int ph_lo, ph_hi; };
#ifndef MK_WGM_IN
#define MK_WGM_IN 4
#endif
#ifndef MK_F8D2
#define MK_F8D2 1
#endif
constexpr bool F8D = (MK_FP8 >= 2), F8M = (MK_FP8 >= 1);
constexpr bool F8D2 = F8D || (MK_F8D2 != 0);
constexpr bool F8P = false;
constexpr float WS1 = 32.f, WS2 = 64.f;
struct SchedMoe2Main {
    int G, c; const int* tiles; const char* A0; const char* B0; size_t tsA, tsB, estride;
    __device__ __forceinline__ bool next(int i, pg8::Unit& u) const {
        const int Lx = i * G + c; if (Lx >= 512) return false;
        pg8::tile_of(Lx, 64, 8, u.pm, u.pn); const int e = tiles[1 + u.pm]; u.z = 0;
        u.A = A0 + (size_t)u.pm * tsA; u.B = B0 + (size_t)e * estride + (size_t)u.pn * tsB; return true;
    }
};
struct SchedMoe2Tail {
    int G, c; const int* tiles; const char* A0; const char* B0; size_t tsA, tsB, estride, kqbytes;
    __device__ __forceinline__ bool next(int i, pg8::Unit& u) const {
        const int ntl = tiles[0] - 64, q = i * G + c; if (q >= ntl * 32) return false;
        int tt; pg8::tile_of(q >> 2, ntl, 8, tt, u.pn); u.pm = 64 + tt; u.z = q & 3; const int e = tiles[1 + u.pm];
        u.A = A0 + (size_t)u.pm * tsA + (size_t)u.z * kqbytes; u.B = B0 + (size_t)e * estride + (size_t)u.pn * tsB + (size_t)u.z * kqbytes; return true;
    }
};
#ifndef MK_NCONV
#define MK_NCONV 88
#endif
constexpr int NCONV = MK_NCONV, NCOMP = 256 - NCONV;
#ifndef MK_NCONVF
#define MK_NCONVF 0
#endif
constexpr int NCONVF = MK_NCONVF, NCOMPF = 256 - NCONVF;
#ifndef MK_CWG
#define MK_CWG 0
#endif
#ifndef MK_CWA
#define MK_CWA (16 * 64 + 3)
#endif
#ifndef MK_CWB
#define MK_CWB (MK_CWA + MK_CWG)
#endif
#ifndef MK_CWP
#define MK_CWP 0
#endif
constexpr int CXB = 15 * 64;
constexpr int CW0_LO = 0, CW0_HI = 64, CW0X_LO = CXB, CW0X_HI = CXB + MK_CWP;
constexpr int CW1_LO = 64, CW1_HI = CXB, CW1B_LO = CW0X_HI, CW1B_HI = MK_CWA;
constexpr int CWG0_LO = MK_CWA, CWG0_HI = MK_CWA + MK_CWG;
constexpr int CWF_LO = MK_CWA + MK_CWG, CWF_HI = MK_CWB;
constexpr int CW2_LO = MK_CWB, CW2_HI = 18 * 64 - MK_CWG;
constexpr int CWG1_LO = 18 * 64 - MK_CWG, CWG1_HI = 18 * 64;
namespace thin {
template <int PLO, int PHI, bool NTS = true>
__device__ __forceinline__ void conv_jobs(const Args& a, unsigned char* ws, LAS unsigned char* scr, int cgw, int cngw, int lane) {
#define CJ(j) if constexpr (PLO < 64 * (j) + 64 && 64 * (j) < PHI)
#define CF(j) , (PLO > 64 * (j) ? PLO - 64 * (j) : 0), (PHI < 64 * (j) + 64 ? PHI - 64 * (j) : 64)
    { unsigned char* wl = ws + wsm::W0;
        { CJ(0) conv_group<0, false, NTS>(a.in[3], 0, 1, DM, NIN, wl + wsm::O_WIN, 0, 1.f, 0, scr, cgw, cngw, lane CF(0));
                      CJ(1) conv_group<0, false, NTS>(a.in[30], 0, 1, PLED, DM, wl + wsm::O_PLEP, 0, 1.f, 0, scr, cgw, cngw, lane CF(1));
                      CJ(2) conv_group<0, false, NTS>(a.in[14], 0, 1, 1024, 1024, wl + wsm::O_GLU, 0, 1.f, 0, scr, cgw, cngw, lane CF(2));
                      CJ(3) conv_group<0, false, NTS>(a.in[18], (size_t)1024 * DM, 3, 1024, DM, wl + wsm::O_WBR, (size_t)DM * 1024 * 2, 1.f, 0, scr, cgw, cngw, lane CF(3));
                      CJ(4) conv_group<0, false, NTS>(a.in[19], 0, 1, DM, DM, wl + wsm::O_WOUT, 0, 1.f, 0, scr, cgw, cngw, lane CF(4));
                      CJ(5) conv_group<1, F8D, NTS>(a.in[21], 0, 1, DM, DFF, ws + wsm::FFN1, 0, F8D ? WS1 : 1.f, 0, scr, cgw, cngw, lane CF(5));
                      CJ(6) conv_group<1, F8D, NTS>(a.in[22], 0, 1, DM, DFF, ws + wsm::FFN1, 0, F8D ? WS1 : 1.f, 1, scr, cgw, cngw, lane CF(6));
                      CJ(7) conv_group<0, F8D2, NTS>(a.in[23], 0, 1, DFF, DM, ws + wsm::FFN2, 0, F8D2 ? WS2 : 1.f, 0, scr, cgw, cngw, lane CF(7));
                      CJ(8) conv_group<0, false, NTS>(a.in[29], 0, 1, DM, DM, wl + wsm::O_PLEG, 0, 1.f, 0, scr, cgw, cngw, lane CF(8)); }
    }
    { unsigned char* wl = ws + wsm::W0 + wsm::WL;
        { CJ(9) conv_group<0, false, NTS>(a.in[3] + (size_t)DM * NIN, 0, 1, DM, NIN, wl + wsm::O_WIN, 0, 1.f, 0, scr, cgw, cngw, lane CF(9));
               CJ(10) conv_group<0, false, NTS>(a.in[30] + (size_t)PLED * DM, 0, 1, PLED, DM, wl + wsm::O_PLEP, 0, 1.f, 0, scr, cgw, cngw, lane CF(10));
               CJ(11) conv_group<0, false, NTS>(a.in[14] + (size_t)1024 * 1024, 0, 1, 1024, 1024, wl + wsm::O_GLU, 0, 1.f, 0, scr, cgw, cngw, lane CF(11));
               CJ(12) conv_group<0, false, NTS>(a.in[18] + (size_t)3 * 1024 * DM, (size_t)1024 * DM, 3, 1024, DM, wl + wsm::O_WBR, (size_t)DM * 1024 * 2, 1.f, 0, scr, cgw, cngw, lane CF(12));
               CJ(13) conv_group<0, false, NTS>(a.in[19] + (size_t)DM * DM, 0, 1, DM, DM, wl + wsm::O_WOUT, 0, 1.f, 0, scr, cgw, cngw, lane CF(13));
               CJ(14) conv_group<0, F8P, NTS>(a.in[29] + (size_t)DM * DM, 0, 1, DM, DM, wl + wsm::O_PLEG, 0, F8P ? WS1 : 1.f, 0, scr, cgw, cngw, lane CF(14)); } }
#ifndef MK_COOP
#define MK_COOP 0
#endif
    if constexpr (F8M && MK_COOP) {
        LAS unsigned char* tl = scr - (cgw & 7) * 9216 + 81920; const int cwg = cgw >> 3, ncwg = cngw >> 3;
        CJ(15) coop_group<0>(a.in[27], (size_t)DFE * DM, NEXP, DFE, DM, ws + wsm::EXP2, wsm::SZ_EXP2, WS2, 0, tl, cwg, ncwg CF(15));
        CJ(16) coop_group<1>(a.in[25], (size_t)DM * DFE, NEXP, DM, DFE, ws + wsm::EXP1, wsm::SZ_EXP1, WS1, 0, tl, cwg, ncwg CF(16));
        CJ(17) coop_group<1>(a.in[26], (size_t)DM * DFE, NEXP, DM, DFE, ws + wsm::EXP1, wsm::SZ_EXP1, WS1, 1, tl, cwg, ncwg CF(17));
    } else {
    CJ(15) conv_group<0, F8M, NTS>(a.in[27], (size_t)DFE * DM, NEXP, DFE, DM, ws + wsm::EXP2, wsm::SZ_EXP2, F8M ? WS2 : 1.f, 0, scr, cgw, cngw, lane CF(15));
    CJ(16) conv_group<1, F8M, NTS>(a.in[25], (size_t)DM * DFE, NEXP, DM, DFE, ws + wsm::EXP1, wsm::SZ_EXP1, F8M ? WS1 : 1.f, 0, scr, cgw, cngw, lane CF(16));
    CJ(17) conv_group<1, F8M, NTS>(a.in[26], (size_t)DM * DFE, NEXP, DM, DFE, ws + wsm::EXP1, wsm::SZ_EXP1, F8M ? WS1 : 1.f, 1, scr, cgw, cngw, lane CF(17));
    }
#undef CJ
#undef CF
}
}

constexpr int NWAVES = 8, RING_BYTES = 131072, MISC_OFF = RING_BYTES, LDS_BYTES = 147456;
constexpr int N_PHASES = 25;

__global__ void __launch_bounds__(NWAVES * 64, 2) mk_fwd(Args a) {
    extern __shared__ __attribute__((aligned(16))) unsigned char lds_raw[];
    LAS unsigned char* lds = (LAS unsigned char*)lds_raw;
    volatile LAS unsigned* MISC = (volatile LAS unsigned*)(lds + MISC_OFF);
    const int tid = threadIdx.x, lane = tid & 63, wave = __builtin_amdgcn_readfirstlane(tid >> 6);
    const int G = gridDim.x, bx = blockIdx.x;
    const int gw = bx * NWAVES + wave, ngw = G * NWAVES;
    unsigned char* ws = a.ws; unsigned* ctl = (unsigned*)(ws + wsm::CTL);
    for (int u = tid; u < 64; u += NWAVES * 64) MISC[u] = 0u;
    __syncthreads();
    const int lo = a.ph_lo, hi = a.ph_hi;
    XcdBarrier bar; bar.bar = ctl + wsm::CW_BAR; bar.x = 0; bar.st = MISC + 8;
    if (hi - lo > 1) bar = xcd_barrier_post(ctl + wsm::CW_BAR, MISC + 8);
#ifndef MK_SUB
#define MK_SUB 0xffu
#endif
#ifndef MK_MASK
#define MK_MASK 0xffffffffu
#endif
#define PHASE_BEGIN(id, ty) if (((MK_MASK >> (ty)) & 1u) && lo <= (id) && (id) < hi) { constexpr bool dum = false; (void)dum; if ((id) > lo) xcd_barrier(bar);
#define PHASE_BEGIN_D(id, ty) if (((MK_MASK >> (ty)) & 1u) && lo <= (id) && (id) < hi) { constexpr bool dum = true; (void)dum; if ((id) > lo) xcd_barrier(bar);
#define PHASE_BEGIN_R(id, ty) if (((MK_MASK >> (ty)) & 1u) && lo <= (id) && (id) < hi) { constexpr bool dum = false; (void)dum; xcd_barrier(bar);
#define PHASE_END }
    epi::ss_t* ssbase = (epi::ss_t*)(ctl + wsm::CW_SS);
    bf16_t* XR = (bf16_t*)(ws + wsm::XF); bf16_t* XBA = (bf16_t*)(ws + wsm::XBA); bf16_t* XBB = (bf16_t*)(ws + wsm::XBB); bf16_t* PB = (bf16_t*)(ws + wsm::PB); bf16_t* PP = (bf16_t*)(ws + wsm::PP);
    bf16_t* PROJ = (bf16_t*)(ws + wsm::PROJ); bf16_t* QN = (bf16_t*)(ws + wsm::QN); bf16_t* KN = (bf16_t*)(ws + wsm::KN); bf16_t* VN = (bf16_t*)(ws + wsm::VN); bf16_t* ATT = (bf16_t*)(ws + wsm::ATT);
    bf16_t* SSMY = (bf16_t*)(ws + wsm::SSMY); bf16_t* SSMO = (bf16_t*)(ws + wsm::SSMO); bf16_t* MLPO = (bf16_t*)(ws + wsm::MLPO); float* MRGF = (float*)(ws + wsm::MRGF); bf16_t* MRGB = (bf16_t*)(ws + wsm::MRGB);
    float* EST = (float*)(ws + wsm::ESTATE);

    PHASE_BEGIN(0, 0)
    {
        LAS unsigned char* scr = lds + wave * 9216;
        const int cgw = gw, cngw = ngw; {
        thin::conv_jobs<CW0_LO, CW0_HI, false>(a, ws, scr, cgw, cngw, lane); thin::conv_jobs<CW0X_LO, CW0X_HI>(a, ws, scr, cgw, cngw, lane);
        }
        for (int row = gw; row < NT; row += ngw) { const float* xr = a.in[0] + (size_t)row * DM; float sq = 0.f;
#pragma unroll
            for (int j = 0; j < 4; ++j) { const f32x4 v0 = *(const f32x4*)(xr + (lane + 64 * j) * 8), v1 = *(const f32x4*)(xr + (lane + 64 * j) * 8 + 4);
                const f32x4 g0 = *(const f32x4*)(a.in[2] + (lane + 64 * j) * 8), g1 = *(const f32x4*)(a.in[2] + (lane + 64 * j) * 8 + 4);
                *(u32x4*)(XBA + (size_t)row * DM + (lane + 64 * j) * 8) = epi::pack8(v0 * g0, v1 * g1); sq += epi::sum8sq(v0, v1); }
            sq = wave_sum(sq); if (lane == 0) ssbase[7 * NT + row] = epi::ss_fix(sq); }
        for (size_t i = (size_t)gw * 64 + lane; i < (size_t)2 * NT * PLED / 8; i += (size_t)ngw * 64) { const f32x4 v0 = *(const f32x4*)(a.in[1] + i * 8), v1 = *(const f32x4*)(a.in[1] + i * 8 + 4); *(u32x4*)(PB + i * 8) = epi::pack8(v0, v1); }
        for (size_t i = (size_t)gw * 64 + lane; i < (size_t)2 * 8 * 128 * 128 / 8; i += (size_t)ngw * 64) { const f32x4 v0 = *(const f32x4*)(a.in[16] + i * 8), v1 = *(const f32x4*)(a.in[16] + i * 8 + 4); *(u32x4*)((bf16_t*)(ws + wsm::WSB) + i * 8) = epi::pack8(v0, v1); }
#ifdef MK_XBAR
        for (int q = 0; q < MK_XBAR; ++q) xcd_barrier(bar);
#endif
        for (int it = gw; it < 256; it += ngw) thin::ssm_tables(it, a.in[6], a.in[7], a.in[8], a.in[9], a.in[10], a.in[11], a.in[12], (float*)(ws + wsm::LAMB), (float*)(ws + wsm::LAMT), (bf16_t*)(ws + wsm::BBAR), (bf16_t*)(ws + wsm::CTT), lane);
        __syncthreads();
    }
    PHASE_END

    { constexpr int l = 0;
        const int pb = 1 + 12 * l;
        constexpr bool FF8 = (l == 0) ? F8D : F8M;
        constexpr int EB = FF8 ? 1 : 2;
        unsigned char* wl = ws + wsm::W0 + (size_t)l * wsm::WL;
        bf16_t* xin = l ? XBB : XBA; bf16_t* x1b = l ? XBA : XBB; bf16_t* x2b = l ? XBB : XBA;
        epi::ss_t* ssv = ssbase + l * NT; epi::ss_t* ssx1 = ssbase + (2 + l) * NT; epi::ss_t* ssx2 = ssbase + (4 + l) * NT; epi::ss_t* ssx3 = ssbase + 6 * NT; const epi::ss_t* ssin = l ? ssx3 : ssbase + 7 * NT;
        const float* lamb_l = (const float*)(ws + wsm::LAMB) + (size_t)l * 16384; const float* lamt_l = (const float*)(ws + wsm::LAMT) + (size_t)l * 16384;
        const bf16_t* bbar_l = (const bf16_t*)(ws + wsm::BBAR) + (size_t)l * 262144; const bf16_t* ctt_l = (const bf16_t*)(ws + wsm::CTT) + (size_t)l * 262144;
        const bf16_t* wsb_l = (const bf16_t*)(ws + wsm::WSB) + (size_t)l * 131072;

        PHASE_BEGIN(pb + 0, 1)
        { if (bx < NCOMP) { pg8::SchedGrid S{NT / 256, NIN / 256, NCOMP, bx, 0, (const char*)xin, (const char*)(wl + wsm::O_WIN), (size_t)256 * DM * 2, MK_WGM_IN};
              epi::EpiInproj E{PROJ, ssin, dum ? ssbase + 8 * NT : ssv, (unsigned char*)MRGF};
              pg8::gemm_phase(lds, DM * 2, S, E); }
          else if (!dum) { LAS unsigned char* scr = lds + wave * 9216; const int cgw = (bx - NCOMP) * NWAVES + wave, cngw = NCONV * NWAVES;
              if constexpr (l == 0) { thin::conv_jobs<CW1_LO, CW1_HI>(a, ws, scr, cgw, cngw, lane); thin::conv_jobs<CW1B_LO, CW1B_HI>(a, ws, scr, cgw, cngw, lane); }
              else thin::conv_jobs<CW2_LO, CW2_HI>(a, ws, scr, cgw, cngw, lane); } }
        PHASE_END

        PHASE_BEGIN(pb + 1, 2)
        { for (int tok = gw; tok < NT; tok += ngw) thin::rope_token(PROJ, a.in[4] + l * 128, a.in[5] + l * 128, QN, KN, VN, tok, lane);
          for (int it = gw; it < 2 * 2 * 64 * 32; it += ngw) { const int n = it & 31, g = (it >> 5) & 63, b = (it >> 11) & 1, d = it >> 12;
              if (d == 0) thin::ssm_pass1_item<0>(PROJ, lamb_l, bbar_l, EST, b, g, n, lane); else thin::ssm_pass1_item<1>(PROJ, lamb_l, bbar_l, EST, b, g, n, lane); } }
        PHASE_END

        PHASE_BEGIN(pb + 2, 3)
        { { pg8::SchedGrid S{NT / 256, DM / 256, G, bx, 0, (const char*)(PB + (size_t)l * NT * PLED), (const char*)(wl + wsm::O_PLEP), (size_t)256 * PLED * 2};
            epi::EpiBf16 E{PP, DM};
            pg8::gemm_phase(lds, PLED * 2, S, E); }
          LAS unsigned char* sl = lds + wave * 8704;
          for (int it = gw; it < 2 * 64 * 32; it += ngw) { const int n = it & 31, g = (it >> 5) & 63, b = it >> 11;
              thin::ssm_pass2_item(PROJ, lamb_l, lamt_l, bbar_l, ctt_l, EST, a.in[13] + l * 1024, SSMY, b, g, n, lane, sl); }
          __syncthreads();
          for (int it = bx; it < 512; it += G) thin::gmlp_item(PROJ, ssv, a.in[15] + l * 1024, wsb_l, a.in[17] + l * 1024, MLPO, it >> 3, it & 7, lds); }
        PHASE_END

        PHASE_BEGIN(pb + 3, 4)
        { for (int it = bx; it < 256; it += G) {
              int combo, idx; if (G == 256) { const int xcd = it & 7, slot = it >> 3; combo = xcd >> 1; idx = (xcd & 1) * 32 + slot; } else { combo = it >> 6; idx = it & 63; }
              const int b = combo >> 1, kvh = combo & 1, h = kvh * 4 + (idx >> 4), qb = idx & 15;
              const size_t qo = ((size_t)(b * SEQ + qb * 256)) * 1024 + h * 128, ko = ((size_t)b * SEQ) * 256 + kvh * 128;
              attn::attn_dense_body(QN + qo, KN + ko, VN + ko, ATT + qo, SEQ, (char*)lds_raw); }
          if (bx < 128) { pg8::SchedGrid S{NT / 256, 1024 / 256, G, bx, 0, (const char*)SSMY, (const char*)(wl + wsm::O_GLU), (size_t)256 * 1024 * 2};
            epi::EpiGlu E{SSMY, SSMO};
            pg8::gemm_phase(lds, 1024 * 2, S, E); }
          else if (!dum) { LAS unsigned char* scr = lds + wave * 9216; const int cgw = (bx - 128) * NWAVES + wave, cngw = 128 * NWAVES;
              if constexpr (l == 0) thin::conv_jobs<CWG0_LO, CWG0_HI>(a, ws, scr, cgw, cngw, lane); else thin::conv_jobs<CWG1_LO, CWG1_HI>(a, ws, scr, cgw, cngw, lane); } }
        PHASE_END

        PHASE_BEGIN(pb + 4, 5)
        { SchedMerge S{G, bx, (const char*)ws, (const char*)(wl + wsm::O_WBR)};
          epi::EpiMerge E{(const unsigned char*)MRGF, MRGB};
          pg8::gemm_phase(lds, 1024 * 2, S, E); }
        PHASE_END

        PHASE_BEGIN(pb + 5, 6)
        { pg8::SchedGrid S{NT / 256, DM / 256, G, bx, 0, (const char*)MRGB, (const char*)(wl + wsm::O_WOUT), (size_t)256 * DM * 2};
          epi::EpiResid<false, FF8, (l != 0)> E{l == 0 ? (const void*)a.in[0] : (const void*)XR, dum ? (bf16_t*)MRGF : XR, dum ? (void*)SSMY : (void*)x1b, dum ? ssbase + 8 * NT : ssx1, 1.f, a.in[20] + l * DM};
          pg8::gemm_phase(lds, DM * 2, S, E); }
        PHASE_END

        if (l == 0) {
            PHASE_BEGIN(pb + 6, 7)
            { if (bx < NCOMPF) { pg8::SchedGrid S{NT / 256, 2 * DFF / 256, NCOMPF, bx, 0, (const char*)x1b, (const char*)(ws + wsm::FFN1), (size_t)256 * DM * EB};
                  epi::EpiSwiglu<FF8, F8D2> E{ws + wsm::ACTD, DFF, ssx1, 0, FF8 ? 1.f / WS1 : 1.f};
                  pg8::gemm_phase(lds, DM * EB, S, E); }
              else if (!dum) { LAS unsigned char* scr = lds + wave * 9216; thin::conv_jobs<CWF_LO, CWF_HI>(a, ws, scr, (bx - NCOMPF) * NWAVES + wave, NCONVF * NWAVES, lane); } }
            PHASE_END
            PHASE_BEGIN(pb + 7, 8)
            { constexpr int EB2 = F8D2 ? 1 : 2;
              pg8::SchedGrid S{NT / 256, DM / 256, G, bx, 0, (const char*)(ws + wsm::ACTD), (const char*)(ws + wsm::FFN2), (size_t)256 * DFF * EB2};
              epi::EpiResid<F8D2, false, true> E{XR, dum ? (bf16_t*)MRGF : XR, dum ? (void*)SSMY : (void*)x2b, dum ? ssbase + 8 * NT : ssx2, F8D2 ? 1.f / WS2 : 1.f, a.in[28] + l * DM};
              pg8::gemm_phase(lds, DFF * EB2, S, E); }
            PHASE_END
        } else {
            int* ridx = (int*)(ws + wsm::R_IDX); float* rgate = (float*)(ws + wsm::R_GATE); int* tokdest = (int*)(ws + wsm::R_TOKDEST); int* rowtok = (int*)(ws + wsm::R_ROWTOK);
            float* rowgate = (float*)(ws + wsm::R_ROWGATE); float* rowrstd = (float*)(ws + wsm::R_ROWRSTD); int* hist = (int*)(ws + wsm::R_HIST); int* tiles = (int*)(ws + wsm::R_TILES);
            bf16_t* XG = (bf16_t*)(ws + wsm::XG); bf16_t* ACTM = (bf16_t*)(ws + wsm::ACTM); bf16_t* YB = (bf16_t*)(ws + wsm::YB);
            PHASE_BEGIN(pb + 6, 9)
            { volatile LAS int* lh = (volatile LAS int*)lds;
              if (tid < 8) lh[tid] = 0;
              const float* gn = a.in[20] + DM; const float* wr = a.in[24];
              LAS f32x4* wg = (LAS f32x4*)(lds + 1024);
              { const int ln = tid & 63, jw = tid >> 6; const f32x4 gv = *(const f32x4*)(gn + 4 * ln + 256 * jw);
#pragma unroll
                for (int i = 0; i < 4; ++i) { const float* wp = wr + (size_t)(4 * ln + 256 * jw + i) * 8; wg[((jw * 4 + i) * 2 + 0) * 64 + ln] = *(const f32x4*)wp * gv[i]; wg[((jw * 4 + i) * 2 + 1) * 64 + ln] = *(const f32x4*)(wp + 4) * gv[i]; } }
              __syncthreads();
              float acc[4][8];
#pragma unroll
              for (int i = 0; i < 4; ++i)
#pragma unroll
                  for (int e = 0; e < 8; ++e) acc[i][e] = 0.f;
              const int tokb = bx * 32 + wave * 4;
#pragma unroll 2
              for (int j = 0; j < 8; ++j) { f32x4 xv[4];
#pragma unroll
                  for (int i = 0; i < 4; ++i) { const u32x2 xr = *(const u32x2*)(XR + (size_t)(tokb + i) * DM + 4 * lane + 256 * j); xv[i] = (f32x4){__uint_as_float(xr[0] << 16), __uint_as_float(xr[0] & 0xffff0000u), __uint_as_float(xr[1] << 16), __uint_as_float(xr[1] & 0xffff0000u)}; }
#pragma unroll
                  for (int jj = 0; jj < 4; ++jj) { const f32x4 w0 = wg[((j * 4 + jj) * 2 + 0) * 64 + lane], w1 = wg[((j * 4 + jj) * 2 + 1) * 64 + lane];
#pragma unroll
                      for (int i = 0; i < 4; ++i) { const float h = xv[i][jj];
                          acc[i][0] = fmaf(h, w0[0], acc[i][0]); acc[i][1] = fmaf(h, w0[1], acc[i][1]); acc[i][2] = fmaf(h, w0[2], acc[i][2]); acc[i][3] = fmaf(h, w0[3], acc[i][3]);
                          acc[i][4] = fmaf(h, w1[0], acc[i][4]); acc[i][5] = fmaf(h, w1[1], acc[i][5]); acc[i][6] = fmaf(h, w1[2], acc[i][6]); acc[i][7] = fmaf(h, w1[3], acc[i][7]); } } }
#pragma unroll
              for (int i = 0; i < 4; ++i) { const int tok = tokb + i; const float r = rsqrtf(epi::ss_val(ssx1, tok) * (1.f / DM) + EPS); float lg[8];
#pragma unroll
                  for (int e = 0; e < 8; ++e) lg[e] = wave_sum(acc[i][e]) * r;
                  if (lane == 0) { int i0 = 0; float v0 = lg[0];
#pragma unroll
                      for (int e = 1; e < 8; ++e) if (lg[e] > v0) { v0 = lg[e]; i0 = e; }
                      int i1 = -1; float v1 = -3.0e38f;
#pragma unroll
                      for (int e = 0; e < 8; ++e) if (e != i0 && lg[e] > v1) { v1 = lg[e]; i1 = e; }
                      const float e1 = __expf(v1 - v0), g0 = 1.f / (1.f + e1);
                      ridx[tok * 2] = i0; ridx[tok * 2 + 1] = i1; rgate[tok * 2] = g0; rgate[tok * 2 + 1] = e1 * g0;
                      __hip_atomic_fetch_add((LAS int*)lds + i0, 1, __ATOMIC_RELAXED, __HIP_MEMORY_SCOPE_WORKGROUP); __hip_atomic_fetch_add((LAS int*)lds + i1, 1, __ATOMIC_RELAXED, __HIP_MEMORY_SCOPE_WORKGROUP); } }
              __syncthreads();
              if (tid < 8) hist[bx * 8 + tid] = lh[tid];
              __syncthreads(); }
            PHASE_END
            PHASE_BEGIN(pb + 7, 10)
            { volatile LAS int* li = (volatile LAS int*)lds;
              { const int e = wave; int tot = 0, pr = 0;
#pragma unroll
                for (int j = 0; j < 4; ++j) { const int w = lane + 64 * j; const int v = hist[w * 8 + e]; tot += v; pr += (w < bx) ? v : 0; }
#pragma unroll
                for (int o = 1; o < 64; o <<= 1) { tot += __shfl_xor(tot, o); pr += __shfl_xor(pr, o); }
                if (lane == 0) { li[e] = tot; li[8 + e] = pr; } }
              __syncthreads();
              if (tid == 0) { int off = 0; for (int e = 0; e < 8; ++e) { li[16 + e] = off; off += ((li[e] + 255) >> 8) * 256; } li[24] = off >> 8; }
              __syncthreads();
              if (wave == 0) { const int tok = bx * 32 + (lane >> 1), k = lane & 1, e = ridx[tok * 2 + k]; int rank = 0;
#pragma unroll
                  for (int q = 0; q < 8; ++q) { const unsigned long long m = __ballot(e == q); if (e == q) rank = __popcll(m & ((1ull << lane) - 1ull)); }
                  const int dest = li[16 + e] + li[8 + e] + rank;
                  tokdest[tok * 2 + k] = dest; rowtok[dest] = tok; rowgate[dest] = rgate[tok * 2 + k]; rowrstd[dest] = rsqrtf(epi::ss_val(ssx1, tok) * (1.f / DM) + EPS); li[32 + lane] = dest; }
              if (bx == 0) {
                  if (tid < 8) { const int e = tid, nt = (li[e] + 255) >> 8, t0 = li[16 + e] >> 8; for (int t = 0; t < nt; ++t) tiles[1 + t0 + t] = e; if (e == 0) tiles[0] = li[24]; }
                  for (int e = 0; e < 8; ++e) { const int r0 = li[16 + e] + li[e], r1 = li[16 + e] + (((li[e] + 255) >> 8) << 8);
                      for (int r = r0 + tid; r < r1; r += NWAVES * 64) { rowtok[r] = -1; rowgate[r] = 0.f; rowrstd[r] = 0.f; } } }
              __syncthreads();
#pragma unroll
              for (int q = 0; q < 8; ++q) { const int i = wave * 8 + q, tok = bx * 32 + (i >> 1), dest = li[32 + i];
                  const u32x4* s = (const u32x4*)((const unsigned char*)x1b + (size_t)tok * DM * EB); u32x4* d = (u32x4*)((unsigned char*)XG + (size_t)dest * DM * EB);
#pragma unroll
                  for (int jj = 0; jj < 2 * EB; ++jj) d[lane + 64 * jj] = s[lane + 64 * jj]; }
              __syncthreads(); }
            PHASE_END
            PHASE_BEGIN(pb + 8, 11)
            { SchedMoe S{G, bx, 2 * DFE / 256, tiles, (const char*)XG, (const char*)(ws + wsm::EXP1), (size_t)256 * DM * EB, (size_t)256 * DM * EB, wsm::SZ_EXP1};
              epi::EpiSwiglu<FF8> E{ACTM, DFE, rowrstd, 1, FF8 ? 1.f / WS1 : 1.f};
              pg8::gemm_phase(lds, DM * EB, S, E); }
            PHASE_END
            PHASE_BEGIN(pb + 9, 12)
            { epi::EpiMoe2<FF8> E{YB, rowgate, FF8 ? 1.f / WS2 : 1.f, (bf16_t*)(ws + wsm::YBX)};
              { SchedMoe2Main S{G, bx, tiles, (const char*)ACTM, (const char*)(ws + wsm::EXP2), (size_t)256 * DFE * EB, (size_t)256 * DFE * EB, wsm::SZ_EXP2};
                pg8::gemm_phase(lds, DFE * EB, S, E); }
              { SchedMoe2Tail S{G, bx, tiles, (const char*)ACTM, (const char*)(ws + wsm::EXP2), (size_t)256 * DFE * EB, (size_t)256 * DFE * EB, wsm::SZ_EXP2, (size_t)DFE * EB / 4};
                pg8::gemm_phase(lds, DFE * EB, S, E, DFE * EB / 128 / 4); } }
            PHASE_END
            PHASE_BEGIN(pb + 10, 13)
            { for (int tok = gw; tok < NT; tok += ngw) { const int d0 = tokdest[tok * 2], d1 = tokdest[tok * 2 + 1]; float sq = 0.f;
#pragma unroll
                  for (int j = 0; j < 4; ++j) { const size_t o = (size_t)tok * DM + (lane + 64 * j) * 8; f32x4 x0, x1, p0, p1, q0, q1; epi::unpack8(*(const u32x4*)(XR + o), x0, x1);
                      epi::unpack8(*(const u32x4*)(YB + (size_t)d0 * DM + (lane + 64 * j) * 8), p0, p1); epi::unpack8(*(const u32x4*)(YB + (size_t)d1 * DM + (lane + 64 * j) * 8), q0, q1);
                      x0 += p0 + q0; x1 += p1 + q1;
#pragma unroll
                      for (int dd = 0; dd < 2; ++dd) { const int d = dd ? d1 : d0; if (d >= 16384) {
#pragma unroll
                          for (int s = 0; s < 3; ++s) { epi::unpack8(*(const u32x4*)((const bf16_t*)(ws + wsm::YBX) + ((size_t)s * 2048 + (d - 16384)) * DM + (lane + 64 * j) * 8), p0, p1); x0 += p0; x1 += p1; } } } *(u32x4*)(XR + o) = epi::pack8(x0, x1);
                      const float* gp = a.in[28] + DM + (lane + 64 * j) * 8; const f32x4 y0 = x0 * *(const f32x4*)gp, y1 = x1 * *(const f32x4*)(gp + 4);
                      if constexpr (F8P) *(u32x2*)((unsigned char*)x2b + o) = (u32x2){pk4_fp8(y0[0], y0[1], y0[2], y0[3]), pk4_fp8(y1[0], y1[1], y1[2], y1[3])}; else *(u32x4*)(x2b + o) = epi::pack8(y0, y1);
                      sq += epi::sum8sq(x0, x1); }
                  sq = wave_sum(sq); if (lane == 0) ssx2[tok] = epi::ss_fix(sq); } }
            PHASE_END
        }

        PHASE_BEGIN(pb + 11, 14)
        { constexpr bool PF8 = (l == 1) && F8P; constexpr int PEB = PF8 ? 1 : 2;
          pg8::SchedGrid S{NT / 256, DM / 256, G, bx, 0, (const char*)x2b, (const char*)(wl + wsm::O_PLEG), (size_t)256 * DM * PEB};
          epi::EpiPle<PF8, (l == 1)> E{XR, dum ? (void*)MRGF : (l ? (void*)a.out : (void*)XR), dum ? SSMY : (l ? nullptr : XBB), ssx2, dum ? ssbase + 8 * NT : (l ? nullptr : ssx3), PP, a.in[2] + DM, PF8 ? 1.f / WS1 : 1.f};
          pg8::gemm_phase(lds, DM * PEB, S, E); }
        PHASE_END

    }
    { constexpr int l = 1;
        const int pb = 1 + 12 * l;
        constexpr bool FF8 = (l == 0) ? F8D : F8M;
        constexpr int EB = FF8 ? 1 : 2;
        unsigned char* wl = ws + wsm::W0 + (size_t)l * wsm::WL;
        bf16_t* xin = l ? XBB : XBA; bf16_t* x1b = l ? XBA : XBB; bf16_t* x2b = l ? XBB : XBA;
        epi::ss_t* ssv = ssbase + l * NT; epi::ss_t* ssx1 = ssbase + (2 + l) * NT; epi::ss_t* ssx2 = ssbase + (4 + l) * NT; epi::ss_t* ssx3 = ssbase + 6 * NT; const epi::ss_t* ssin = l ? ssx3 : ssbase + 7 * NT;
        const float* lamb_l = (const float*)(ws + wsm::LAMB) + (size_t)l * 16384; const float* lamt_l = (const float*)(ws + wsm::LAMT) + (size_t)l * 16384;
        const bf16_t* bbar_l = (const bf16_t*)(ws + wsm::BBAR) + (size_t)l * 262144; const bf16_t* ctt_l = (const bf16_t*)(ws + wsm::CTT) + (size_t)l * 262144;
        const bf16_t* wsb_l = (const bf16_t*)(ws + wsm::WSB) + (size_t)l * 131072;

        PHASE_BEGIN(pb + 0, 1)
        { if (bx < NCOMP) { pg8::SchedGrid S{NT / 256, NIN / 256, NCOMP, bx, 0, (const char*)xin, (const char*)(wl + wsm::O_WIN), (size_t)256 * DM * 2, MK_WGM_IN};
              epi::EpiInproj E{PROJ, ssin, dum ? ssbase + 8 * NT : ssv, (unsigned char*)MRGF};
              pg8::gemm_phase(lds, DM * 2, S, E); }
          else if (!dum) { LAS unsigned char* scr = lds + wave * 9216; const int cgw = (bx - NCOMP) * NWAVES + wave, cngw = NCONV * NWAVES;
              if constexpr (l == 0) { thin::conv_jobs<CW1_LO, CW1_HI>(a, ws, scr, cgw, cngw, lane); thin::conv_jobs<CW1B_LO, CW1B_HI>(a, ws, scr, cgw, cngw, lane); }
              else thin::conv_jobs<CW2_LO, CW2_HI>(a, ws, scr, cgw, cngw, lane); } }
        PHASE_END

        PHASE_BEGIN(pb + 1, 2)
        { for (int tok = gw; tok < NT; tok += ngw) thin::rope_token(PROJ, a.in[4] + l * 128, a.in[5] + l * 128, QN, KN, VN, tok, lane);
          for (int it = gw; it < 2 * 2 * 64 * 32; it += ngw) { const int n = it & 31, g = (it >> 5) & 63, b = (it >> 11) & 1, d = it >> 12;
              if (d == 0) thin::ssm_pass1_item<0>(PROJ, lamb_l, bbar_l, EST, b, g, n, lane); else thin::ssm_pass1_item<1>(PROJ, lamb_l, bbar_l, EST, b, g, n, lane); } }
        PHASE_END

        PHASE_BEGIN(pb + 2, 3)
        { { pg8::SchedGrid S{NT / 256, DM / 256, G, bx, 0, (const char*)(PB + (size_t)l * NT * PLED), (const char*)(wl + wsm::O_PLEP), (size_t)256 * PLED * 2};
            epi::EpiBf16 E{PP, DM};
            pg8::gemm_phase(lds, PLED * 2, S, E); }
          LAS unsigned char* sl = lds + wave * 8704;
          for (int it = gw; it < 2 * 64 * 32; it += ngw) { const int n = it & 31, g = (it >> 5) & 63, b = it >> 11;
              thin::ssm_pass2_item(PROJ, lamb_l, lamt_l, bbar_l, ctt_l, EST, a.in[13] + l * 1024, SSMY, b, g, n, lane, sl); }
          __syncthreads();
          for (int it = bx; it < 512; it += G) thin::gmlp_item(PROJ, ssv, a.in[15] + l * 1024, wsb_l, a.in[17] + l * 1024, MLPO, it >> 3, it & 7, lds); }
        PHASE_END

        PHASE_BEGIN(pb + 3, 4)
        { for (int it = bx; it < 256; it += G) {
              int combo, idx; if (G == 256) { const int xcd = it & 7, slot = it >> 3; combo = xcd >> 1; idx = (xcd & 1) * 32 + slot; } else { combo = it >> 6; idx = it & 63; }
              const int b = combo >> 1, kvh = combo & 1, h = kvh * 4 + (idx >> 4), qb = idx & 15;
              const size_t qo = ((size_t)(b * SEQ + qb * 256)) * 1024 + h * 128, ko = ((size_t)b * SEQ) * 256 + kvh * 128;
              attn::attn_dense_body(QN + qo, KN + ko, VN + ko, ATT + qo, SEQ, (char*)lds_raw); }
          if (bx < 128) { pg8::SchedGrid S{NT / 256, 1024 / 256, G, bx, 0, (const char*)SSMY, (const char*)(wl + wsm::O_GLU), (size_t)256 * 1024 * 2};
            epi::EpiGlu E{SSMY, SSMO};
            pg8::gemm_phase(lds, 1024 * 2, S, E); }
          else if (!dum) { LAS unsigned char* scr = lds + wave * 9216; const int cgw = (bx - 128) * NWAVES + wave, cngw = 128 * NWAVES;
              if constexpr (l == 0) thin::conv_jobs<CWG0_LO, CWG0_HI>(a, ws, scr, cgw, cngw, lane); else thin::conv_jobs<CWG1_LO, CWG1_HI>(a, ws, scr, cgw, cngw, lane); } }
        PHASE_END

        PHASE_BEGIN(pb + 4, 5)
        { SchedMerge S{G, bx, (const char*)ws, (const char*)(wl + wsm::O_WBR)};
          epi::EpiMerge E{(const unsigned char*)MRGF, MRGB};
          pg8::gemm_phase(lds, 1024 * 2, S, E); }
        PHASE_END

        PHASE_BEGIN(pb + 5, 6)
        { pg8::SchedGrid S{NT / 256, DM / 256, G, bx, 0, (const char*)MRGB, (const char*)(wl + wsm::O_WOUT), (size_t)256 * DM * 2};
          epi::EpiResid<false, FF8, (l != 0)> E{l == 0 ? (const void*)a.in[0] : (const void*)XR, dum ? (bf16_t*)MRGF : XR, dum ? (void*)SSMY : (void*)x1b, dum ? ssbase + 8 * NT : ssx1, 1.f, a.in[20] + l * DM};
          pg8::gemm_phase(lds, DM * 2, S, E); }
        PHASE_END

        if (l == 0) {
            PHASE_BEGIN(pb + 6, 7)
            { if (bx < NCOMPF) { pg8::SchedGrid S{NT / 256, 2 * DFF / 256, NCOMPF, bx, 0, (const char*)x1b, (const char*)(ws + wsm::FFN1), (size_t)256 * DM * EB};
                  epi::EpiSwiglu<FF8, F8D2> E{ws + wsm::ACTD, DFF, ssx1, 0, FF8 ? 1.f / WS1 : 1.f};
                  pg8::gemm_phase(lds, DM * EB, S, E); }
              else if (!dum) { LAS unsigned char* scr = lds + wave * 9216; thin::conv_jobs<CWF_LO, CWF_HI>(a, ws, scr, (bx - NCOMPF) * NWAVES + wave, NCONVF * NWAVES, lane); } }
            PHASE_END
            PHASE_BEGIN(pb + 7, 8)
            { constexpr int EB2 = F8D2 ? 1 : 2;
              pg8::SchedGrid S{NT / 256, DM / 256, G, bx, 0, (const char*)(ws + wsm::ACTD), (const char*)(ws + wsm::FFN2), (size_t)256 * DFF * EB2};
              epi::EpiResid<F8D2, false, true> E{XR, dum ? (bf16_t*)MRGF : XR, dum ? (void*)SSMY : (void*)x2b, dum ? ssbase + 8 * NT : ssx2, F8D2 ? 1.f / WS2 : 1.f, a.in[28] + l * DM};
              pg8::gemm_phase(lds, DFF * EB2, S, E); }
            PHASE_END
        } else {
            int* ridx = (int*)(ws + wsm::R_IDX); float* rgate = (float*)(ws + wsm::R_GATE); int* tokdest = (int*)(ws + wsm::R_TOKDEST); int* rowtok = (int*)(ws + wsm::R_ROWTOK);
            float* rowgate = (float*)(ws + wsm::R_ROWGATE); float* rowrstd = (float*)(ws + wsm::R_ROWRSTD); int* hist = (int*)(ws + wsm::R_HIST); int* tiles = (int*)(ws + wsm::R_TILES);
            bf16_t* XG = (bf16_t*)(ws + wsm::XG); bf16_t* ACTM = (bf16_t*)(ws + wsm::ACTM); bf16_t* YB = (bf16_t*)(ws + wsm::YB);
            PHASE_BEGIN(pb + 6, 9)
            { volatile LAS int* lh = (volatile LAS int*)lds;
              if (tid < 8) lh[tid] = 0;
              const float* gn = a.in[20] + DM; const float* wr = a.in[24];
              LAS f32x4* wg = (LAS f32x4*)(lds + 1024);
              { const int ln = tid & 63, jw = tid >> 6; const f32x4 gv = *(const f32x4*)(gn + 4 * ln + 256 * jw);
#pragma unroll
                for (int i = 0; i < 4; ++i) { const float* wp = wr + (size_t)(4 * ln + 256 * jw + i) * 8; wg[((jw * 4 + i) * 2 + 0) * 64 + ln] = *(const f32x4*)wp * gv[i]; wg[((jw * 4 + i) * 2 + 1) * 64 + ln] = *(const f32x4*)(wp + 4) * gv[i]; } }
              __syncthreads();
              float acc[4][8];
#pragma unroll
              for (int i = 0; i < 4; ++i)
#pragma unroll
                  for (int e = 0; e < 8; ++e) acc[i][e] = 0.f;
              const int tokb = bx * 32 + wave * 4;
#pragma unroll 2
              for (int j = 0; j < 8; ++j) { f32x4 xv[4];
#pragma unroll
                  for (int i = 0; i < 4; ++i) { const u32x2 xr = *(const u32x2*)(XR + (size_t)(tokb + i) * DM + 4 * lane + 256 * j); xv[i] = (f32x4){__uint_as_float(xr[0] << 16), __uint_as_float(xr[0] & 0xffff0000u), __uint_as_float(xr[1] << 16), __uint_as_float(xr[1] & 0xffff0000u)}; }
#pragma unroll
                  for (int jj = 0; jj < 4; ++jj) { const f32x4 w0 = wg[((j * 4 + jj) * 2 + 0) * 64 + lane], w1 = wg[((j * 4 + jj) * 2 + 1) * 64 + lane];
#pragma unroll
                      for (int i = 0; i < 4; ++i) { const float h = xv[i][jj];
                          acc[i][0] = fmaf(h, w0[0], acc[i][0]); acc[i][1] = fmaf(h, w0[1], acc[i][1]); acc[i][2] = fmaf(h, w0[2], acc[i][2]); acc[i][3] = fmaf(h, w0[3], acc[i][3]);
                          acc[i][4] = fmaf(h, w1[0], acc[i][4]); acc[i][5] = fmaf(h, w1[1], acc[i][5]); acc[i][6] = fmaf(h, w1[2], acc[i][6]); acc[i][7] = fmaf(h, w1[3], acc[i][7]); } } }
#pragma unroll
              for (int i = 0; i < 4; ++i) { const int tok = tokb + i; const float r = rsqrtf(epi::ss_val(ssx1, tok) * (1.f / DM) + EPS); float lg[8];
#pragma unroll
                  for (int e = 0; e < 8; ++e) lg[e] = wave_sum(acc[i][e]) * r;
                  if (lane == 0) { int i0 = 0; float v0 = lg[0];
#pragma unroll
                      for (int e = 1; e < 8; ++e) if (lg[e] > v0) { v0 = lg[e]; i0 = e; }
                      int i1 = -1; float v1 = -3.0e38f;
#pragma unroll
                      for (int e = 0; e < 8; ++e) if (e != i0 && lg[e] > v1) { v1 = lg[e]; i1 = e; }
                      const float e1 = __expf(v1 - v0), g0 = 1.f / (1.f + e1);
                      ridx[tok * 2] = i0; ridx[tok * 2 + 1] = i1; rgate[tok * 2] = g0; rgate[tok * 2 + 1] = e1 * g0;
                      __hip_atomic_fetch_add((LAS int*)lds + i0, 1, __ATOMIC_RELAXED, __HIP_MEMORY_SCOPE_WORKGROUP); __hip_atomic_fetch_add((LAS int*)lds + i1, 1, __ATOMIC_RELAXED, __HIP_MEMORY_SCOPE_WORKGROUP); } }
              __syncthreads();
              if (tid < 8) hist[bx * 8 + tid] = lh[tid];
              __syncthreads(); }
            PHASE_END
            PHASE_BEGIN(pb + 7, 10)
            { volatile LAS int* li = (volatile LAS int*)lds;
              { const int e = wave; int tot = 0, pr = 0;
#pragma unroll
                for (int j = 0; j < 4; ++j) { const int w = lane + 64 * j; const int v = hist[w * 8 + e]; tot += v; pr += (w < bx) ? v : 0; }
#pragma unroll
                for (int o = 1; o < 64; o <<= 1) { tot += __shfl_xor(tot, o); pr += __shfl_xor(pr, o); }
                if (lane == 0) { li[e] = tot; li[8 + e] = pr; } }
              __syncthreads();
              if (tid == 0) { int off = 0; for (int e = 0; e < 8; ++e) { li[16 + e] = off; off += ((li[e] + 255) >> 8) * 256; } li[24] = off >> 8; }
              __syncthreads();
              if (wave == 0) { const int tok = bx * 32 + (lane >> 1), k = lane & 1, e = ridx[tok * 2 + k]; int rank = 0;
#pragma unroll
                  for (int q = 0; q < 8; ++q) { const unsigned long long m = __ballot(e == q); if (e == q) rank = __popcll(m & ((1ull << lane) - 1ull)); }
                  const int dest = li[16 + e] + li[8 + e] + rank;
                  tokdest[tok * 2 + k] = dest; rowtok[dest] = tok; rowgate[dest] = rgate[tok * 2 + k]; rowrstd[dest] = rsqrtf(epi::ss_val(ssx1, tok) * (1.f / DM) + EPS); li[32 + lane] = dest; }
              if (bx == 0) {
                  if (tid < 8) { const int e = tid, nt = (li[e] + 255) >> 8, t0 = li[16 + e] >> 8; for (int t = 0; t < nt; ++t) tiles[1 + t0 + t] = e; if (e == 0) tiles[0] = li[24]; }
                  for (int e = 0; e < 8; ++e) { const int r0 = li[16 + e] + li[e], r1 = li[16 + e] + (((li[e] + 255) >> 8) << 8);
                      for (int r = r0 + tid; r < r1; r += NWAVES * 64) { rowtok[r] = -1; rowgate[r] = 0.f; rowrstd[r] = 0.f; } } }
              __syncthreads();
#pragma unroll
              for (int q = 0; q < 8; ++q) { const int i = wave * 8 + q, tok = bx * 32 + (i >> 1), dest = li[32 + i];
                  const u32x4* s = (const u32x4*)((const unsigned char*)x1b + (size_t)tok * DM * EB); u32x4* d = (u32x4*)((unsigned char*)XG + (size_t)dest * DM * EB);
#pragma unroll
                  for (int jj = 0; jj < 2 * EB; ++jj) d[lane + 64 * jj] = s[lane + 64 * jj]; }
              __syncthreads(); }
            PHASE_END
            PHASE_BEGIN(pb + 8, 11)
            { SchedMoe S{G, bx, 2 * DFE / 256, tiles, (const char*)XG, (const char*)(ws + wsm::EXP1), (size_t)256 * DM * EB, (size_t)256 * DM * EB, wsm::SZ_EXP1};
              epi::EpiSwiglu<FF8> E{ACTM, DFE, rowrstd, 1, FF8 ? 1.f / WS1 : 1.f};
              pg8::gemm_phase(lds, DM * EB, S, E); }
            PHASE_END
            PHASE_BEGIN(pb + 9, 12)
            { epi::EpiMoe2<FF8> E{YB, rowgate, FF8 ? 1.f / WS2 : 1.f, (bf16_t*)(ws + wsm::YBX)};
              { SchedMoe2Main S{G, bx, tiles, (const char*)ACTM, (const char*)(ws + wsm::EXP2), (size_t)256 * DFE * EB, (size_t)256 * DFE * EB, wsm::SZ_EXP2};
                pg8::gemm_phase(lds, DFE * EB, S, E); }
              { SchedMoe2Tail S{G, bx, tiles, (const char*)ACTM, (const char*)(ws + wsm::EXP2), (size_t)256 * DFE * EB, (size_t)256 * DFE * EB, wsm::SZ_EXP2, (size_t)DFE * EB / 4};
                pg8::gemm_phase(lds, DFE * EB, S, E, DFE * EB / 128 / 4); } }
            PHASE_END
            PHASE_BEGIN(pb + 10, 13)
            { for (int tok = gw; tok < NT; tok += ngw) { const int d0 = tokdest[tok * 2], d1 = tokdest[tok * 2 + 1]; float sq = 0.f;
#pragma unroll
                  for (int j = 0; j < 4; ++j) { const size_t o = (size_t)tok * DM + (lane + 64 * j) * 8; f32x4 x0, x1, p0, p1, q0, q1; epi::unpack8(*(const u32x4*)(XR + o), x0, x1);
                      epi::unpack8(*(const u32x4*)(YB + (size_t)d0 * DM + (lane + 64 * j) * 8), p0, p1); epi::unpack8(*(const u32x4*)(YB + (size_t)d1 * DM + (lane + 64 * j) * 8), q0, q1);
                      x0 += p0 + q0; x1 += p1 + q1;
#pragma unroll
                      for (int dd = 0; dd < 2; ++dd) { const int d = dd ? d1 : d0; if (d >= 16384) {
#pragma unroll
                          for (int s = 0; s < 3; ++s) { epi::unpack8(*(const u32x4*)((const bf16_t*)(ws + wsm::YBX) + ((size_t)s * 2048 + (d - 16384)) * DM + (lane + 64 * j) * 8), p0, p1); x0 += p0; x1 += p1; } } } *(u32x4*)(XR + o) = epi::pack8(x0, x1);
                      const float* gp = a.in[28] + DM + (lane + 64 * j) * 8; const f32x4 y0 = x0 * *(const f32x4*)gp, y1 = x1 * *(const f32x4*)(gp + 4);
                      if constexpr (F8P) *(u32x2*)((unsigned char*)x2b + o) = (u32x2){pk4_fp8(y0[0], y0[1], y0[2], y0[3]), pk4_fp8(y1[0], y1[1], y1[2], y1[3])}; else *(u32x4*)(x2b + o) = epi::pack8(y0, y1);
                      sq += epi::sum8sq(x0, x1); }
                  sq = wave_sum(sq); if (lane == 0) ssx2[tok] = epi::ss_fix(sq); } }
            PHASE_END
        }

        PHASE_BEGIN(pb + 11, 14)
        { constexpr bool PF8 = (l == 1) && F8P; constexpr int PEB = PF8 ? 1 : 2;
          pg8::SchedGrid S{NT / 256, DM / 256, G, bx, 0, (const char*)x2b, (const char*)(wl + wsm::O_PLEG), (size_t)256 * DM * PEB};
          epi::EpiPle<PF8, (l == 1)> E{XR, dum ? (void*)MRGF : (l ? (void*)a.out : (void*)XR), dum ? SSMY : (l ? nullptr : XBB), ssx2, dum ? ssbase + 8 * NT : (l ? nullptr : ssx3), PP, a.in[2] + DM, PF8 ? 1.f / WS1 : 1.f};
          pg8::gemm_phase(lds, DM * PEB, S, E); }
        PHASE_END

    }
#undef PHASE_BEGIN
#undef PHASE_END
}

extern "C" void kernel_launch(void* const* d_in, const int* in_sizes, int n_in, void* d_out, int out_size, void* d_ws, size_t ws_size, hipStream_t stream) {
    static int grid = 0;
    if (grid == 0) {
        if (n_in != 31 || out_size != NT * DM || ws_size < wsm::END) { fprintf(stderr, "kernel_launch: shape/workspace mismatch (n_in %d out %d ws %zu need %zu)\n", n_in, out_size, ws_size, (size_t)wsm::END); grid = -1; return; }
        int dev = 0, cus = 0, per_cu = 0;
        if (hipGetDevice(&dev) != hipSuccess || hipDeviceGetAttribute(&cus, hipDeviceAttributeMultiprocessorCount, dev) != hipSuccess) { grid = -1; return; }
        if (hipFuncSetAttribute((const void*)mk_fwd, hipFuncAttributeMaxDynamicSharedMemorySize, LDS_BYTES) != hipSuccess) { fprintf(stderr, "kernel_launch: hipFuncSetAttribute failed\n"); grid = -1; return; }
        if (hipOccupancyMaxActiveBlocksPerMultiprocessor(&per_cu, (const void*)mk_fwd, NWAVES * 64, LDS_BYTES) != hipSuccess || per_cu < 1) { fprintf(stderr, "kernel_launch: occupancy query says %d\n", per_cu); }
        (void)hipGetLastError();
        grid = cus;
        if (grid != 256) { fprintf(stderr, "kernel_launch: built for 256 CUs, got %d\n", grid); grid = -1; return; }
    }
    if (grid < 0) return;
    (void)hipMemsetAsync((char*)d_ws + wsm::CTL, 0, wsm::CTL_BYTES, stream);
    Args a{};
    for (int i = 0; i < 31; ++i) a.in[i] = (const float*)d_in[i];
    a.out = (float*)d_out; a.ws = (unsigned char*)d_ws;
#ifndef MK_ONE_LAUNCH
#define MK_ONE_LAUNCH 0
#endif
    if (MK_ONE_LAUNCH) { a.ph_lo = 0; a.ph_hi = N_PHASES; hipLaunchKernelGGL(mk_fwd, dim3(grid), dim3(NWAVES * 64), LDS_BYTES, stream, a); }
    else for (int ph = 0; ph < N_PHASES; ++ph) { if (ph >= 9 && ph <= 11) continue;
        a.ph_lo = ph; a.ph_hi = ph + 1; hipLaunchKernelGGL(mk_fwd, dim3(grid), dim3(NWAVES * 64), LDS_BYTES, stream, a); }
}
```

```cpp
#include <hip/hip_runtime.h>
#include <stdint.h>
#include <stdio.h>
#ifndef MK_ONE_LAUNCH
#define MK_ONE_LAUNCH 1
#endif

#define LAS __attribute__((address_space(3)))
typedef unsigned short bf16_t;
typedef short bf16x8 __attribute__((ext_vector_type(8)));
typedef short s16x4 __attribute__((ext_vector_type(4)));
typedef float f32x2 __attribute__((ext_vector_type(2)));
typedef float f32x4 __attribute__((ext_vector_type(4)));
typedef float f32x16 __attribute__((ext_vector_type(16)));
typedef unsigned u32x2 __attribute__((ext_vector_type(2)));
typedef unsigned u32x4 __attribute__((ext_vector_type(4)));
typedef int i32x4 __attribute__((ext_vector_type(4)));
typedef int i32x8 __attribute__((ext_vector_type(8)));
#ifndef MK_FP8
#define MK_FP8 1
#endif

constexpr int NB = 2, SEQ = 4096, NT = 8192, DM = 2048, NIN = 10752, DFF = 5632, DFE = 7168, NEXP = 8, PLED = 256;
constexpr int C_K = 1024, C_V = 1280, C_U = 1536, C_ZU = 2560, C_ZV = 3584, C_G = 4608;
constexpr float EPS = 1e-6f;
constexpr int CAPROWS = 72 * 256;

__device__ __forceinline__ unsigned cvt_pk_bf16(float lo, float hi) { unsigned r; asm volatile("v_cvt_pk_bf16_f32 %0, %1, %2" : "=v"(r) : "v"(lo), "v"(hi)); return r; }
__device__ __forceinline__ float bf_lo(unsigned w) { return __uint_as_float(w << 16); }
__device__ __forceinline__ float bf_hi(unsigned w) { return __uint_as_float(w & 0xffff0000u); }
__device__ __forceinline__ float bf2f(bf16_t b) { return __uint_as_float((unsigned)b << 16); }
__device__ __forceinline__ bf16_t f2bf(float f) { return (bf16_t)(cvt_pk_bf16(f, 0.f) & 0xffffu); }
__device__ __forceinline__ float sigm(float x) { return __builtin_amdgcn_rcpf(1.f + __builtin_amdgcn_exp2f(-1.4426950408889634f * x)); }
__device__ __forceinline__ float gelu_t(float x) { const float u = 0.7978845608028654f * (x + 0.044715f * x * x * x); return x * sigm(2.f * u); }
__device__ __forceinline__ float wave_sum(float v) {
#pragma unroll
    for (int o = 1; o < 64; o <<= 1) v += __shfl_xor(v, o);
    return v;
}
__device__ __forceinline__ unsigned pk4_fp8(float a, float b, float c, float d) { int w = 0; w = __builtin_amdgcn_cvt_pk_fp8_f32(a, b, w, false); w = __builtin_amdgcn_cvt_pk_fp8_f32(c, d, w, true); return (unsigned)w; }
#define LDS_WAIT() asm volatile("s_waitcnt lgkmcnt(0)" ::: "memory")
#define VM_WAIT() asm volatile("s_waitcnt vmcnt(0)" ::: "memory")

namespace pg8 {
#ifndef MK_WGM
#define MK_WGM 8
#endif
constexpr int BM = 256, BK = 64, HALF = 128, HTB = HALF * BK * 2, STAGE_BYTES = 8 * HTB, NXCD = 8, WGM = MK_WGM;
__host__ __device__ __forceinline__ int lds_byte(int r, int c) { const int st = (r >> 4) * 2 + (c >> 5), rr = r & 15, cc = c & 31, ob = rr * 64 + cc * 2; return st * 1024 + (ob ^ (((ob >> 9) & 1) << 5)); }
__host__ __device__ __forceinline__ void stage_rc(int b, int& R, int& C) { const int st = b / 1024, sb = b % 1024, swz = sb ^ (((sb >> 9) & 1) << 5); R = (st >> 1) * 16 + swz / 64; C = (st & 1) * 32 + (swz % 64) / 2; }
__host__ __device__ __forceinline__ int perm32(int rho) { const int n = rho >> 4, i = rho & 15; return 8 * (i >> 2) + 4 * n + (i & 3); }

struct Unit { const char* A; const char* B; int pm, pn, z; };

__device__ __forceinline__ void tile_of(int wgid, int nM, int nN, int& pm, int& pn, const int WGM = pg8::WGM) {
    const int nwg = nM * nN; { const int q = nwg / NXCD, r = nwg % NXCD, xcd = wgid % NXCD, off = wgid / NXCD; wgid = (xcd < r ? xcd * (q + 1) : r * (q + 1) + (xcd - r) * q) + off; }
    const int nig = WGM * nN, gid = wgid / nig, fm = gid * WGM, gsz = (nM - fm) < WGM ? (nM - fm) : WGM;
    pm = fm + ((wgid % nig) % gsz); pn = (wgid % nig) / gsz;
}
struct SchedGrid {
    int nM, nN, G, c, z; const char* A0; const char* B0; size_t tstep; int wgm = WGM;
    __device__ __forceinline__ bool next(int i, Unit& u) const {
        const long Lx = (long)i * G + c; if (Lx >= (long)nM * nN) return false;
        tile_of((int)Lx, nM, nN, u.pm, u.pn, wgm); u.A = A0 + (size_t)u.pm * tstep; u.B = B0 + (size_t)u.pn * tstep; u.z = z; return true;
    }
};

#ifndef MK_SP2
#define MK_SP2 true
#endif
#ifndef MK_ALIGN
#define MK_ALIGN true
#endif
template <class Epi, class Sched, bool ALIGN_EPI = MK_ALIGN, bool SP2 = MK_SP2>
__device__ __forceinline__ void gemm_phase(LAS unsigned char* lds, const int RBc  , const Sched& S, const Epi& E, const int ntc = 0  ) {
    const int tid = threadIdx.x, wid = __builtin_amdgcn_readfirstlane(tid >> 6), lane = tid & 63, wr = wid >> 2, wc = wid & 3, fr = lane & 15, fq = lane >> 4;
    int RB = RBc; asm volatile("" : "+s"(RB));
    const int nt = ntc ? ntc : RB / 128;
    unsigned voffA[2], voffB[2];
#pragma unroll
    for (int i = 0; i < 2; ++i) { int R, C; stage_rc(tid * 16 + i * 8192, R, C); const int Rb = Epi::PERM ? ((R & ~31) + perm32(R & 31)) : R;
        voffA[i] = (unsigned)(R * RB + C * 2); voffB[i] = (unsigned)(Rb * RB + C * 2); }
    const size_t kstep = (size_t)(BK * 2);
    const size_t hstep = (size_t)HALF * RB;
    const unsigned ldsw = (unsigned)wid * 1024u;
    const int aoff = lds_byte(wr * 64 + fr, fq * 8), boff = lds_byte(wc * 32 + fr, fq * 8);
#define PG8_SA(b, h) (((b) * 2 + (h)) * HTB)
#define PG8_SB(b, h) ((4 + (b) * 2 + (h)) * HTB)
#define PG8_STAGE(bufoff, gbase, voff) do { _Pragma("unroll") for (int _i = 0; _i < 2; ++_i) \
        __builtin_amdgcn_global_load_lds((const unsigned*)((const char*)(gbase) + (voff)[_i]), (LAS unsigned*)(lds + (bufoff) + ldsw + _i * 8192), 16, 0, 0); } while (0)
#define PG8_LD8(addr) __builtin_shufflevector(*(const LAS i32x4*)(addr), *(const LAS i32x4*)((addr) + 1024), 0, 1, 2, 3, 4, 5, 6, 7)
#define PG8_LDA(dst, b, h) do { _Pragma("unroll") for (int m = 0; m < 4; ++m) dst[m] = PG8_LD8(lds + PG8_SA(b, h) + aoff + m * 2048); } while (0)
#define PG8_LDB(dst, b, h) do { _Pragma("unroll") for (int n = 0; n < 2; ++n) dst[n] = PG8_LD8(lds + PG8_SB(b, h) + boff + n * 2048); } while (0)
#define PG8_H0(x) __builtin_bit_cast(bf16x8, __builtin_shufflevector(x, x, 0, 1, 2, 3))
#define PG8_H1(x) __builtin_bit_cast(bf16x8, __builtin_shufflevector(x, x, 4, 5, 6, 7))
#define PG8_MMA(ai, bj, At, Bt) do { __builtin_amdgcn_s_setprio(1); _Pragma("unroll") for (int m = 0; m < 4; ++m) _Pragma("unroll") for (int n = 0; n < 2; ++n) { \
        if constexpr (Epi::F8) asm volatile("v_mfma_f32_16x16x128_f8f6f4 %0, %1, %2, %0" : "+v"(acc[ai][bj][m][n]) : "v"(Bt[n]), "v"(At[m])); \
        else { acc[ai][bj][m][n] = __builtin_amdgcn_mfma_f32_16x16x32_bf16(PG8_H0(Bt[n]), PG8_H0(At[m]), acc[ai][bj][m][n], 0, 0, 0); \
               acc[ai][bj][m][n] = __builtin_amdgcn_mfma_f32_16x16x32_bf16(PG8_H1(Bt[n]), PG8_H1(At[m]), acc[ai][bj][m][n], 0, 0, 0); } } \
        if constexpr (Epi::F8) asm volatile("s_nop 7" ::: "memory");     \
        __builtin_amdgcn_s_setprio(0); } while (0)
#define PG8_WAIT_V(n) asm volatile("s_waitcnt vmcnt(" #n ")" ::: "memory")
#define PG8_WAIT_L(n) asm volatile("s_waitcnt lgkmcnt(" #n ")" ::: "memory")
#define PG8_BAR __builtin_amdgcn_s_barrier()
#define PG8_SCHED __builtin_amdgcn_sched_barrier(0)
    Unit cur, nxt; int ui = 0;
    if (!S.next(0, cur)) return;
    f32x4 acc[2][2][4][2];
#pragma unroll
    for (int a = 0; a < 2; ++a)
#pragma unroll
        for (int b = 0; b < 2; ++b)
#pragma unroll
            for (int m = 0; m < 4; ++m)
#pragma unroll
                for (int n = 0; n < 2; ++n) acc[a][b][m][n] = (f32x4){0.f, 0.f, 0.f, 0.f};
    i32x8 At[4], B0[2], B1[2];
    const char* cA = cur.A; const char* cB = cur.B;
    if constexpr (SP2) {
        PG8_STAGE(PG8_SB(0, 0), cB, voffB); PG8_STAGE(PG8_SB(0, 1), cB + hstep, voffB); PG8_STAGE(PG8_SA(0, 0), cA, voffA); PG8_STAGE(PG8_SA(0, 1), cA + hstep, voffA);
        if (wr == 1) PG8_BAR;
        PG8_WAIT_V(2); PG8_BAR;
        PG8_STAGE(PG8_SB(1, 0), cB + kstep, voffB); PG8_STAGE(PG8_SA(1, 0), cA + kstep, voffA); PG8_STAGE(PG8_SB(1, 1), cB + hstep + kstep, voffB);
        PG8_WAIT_V(6); PG8_BAR;
    } else {
        PG8_STAGE(PG8_SB(0, 0), cB, voffB); PG8_STAGE(PG8_SA(0, 0), cA, voffA); PG8_STAGE(PG8_SB(0, 1), cB + hstep, voffB); PG8_STAGE(PG8_SA(0, 1), cA + hstep, voffA);
        if (wr == 1) PG8_BAR;
        PG8_WAIT_V(4); PG8_BAR;
        PG8_STAGE(PG8_SB(1, 0), cB + kstep, voffB); PG8_STAGE(PG8_SA(1, 0), cA + kstep, voffA); PG8_STAGE(PG8_SB(1, 1), cB + hstep + kstep, voffB);
        PG8_WAIT_V(6); PG8_BAR;
    }
    for (;;) {
        const bool has_next = S.next(ui + 1, nxt);
        const char* nA = has_next ? nxt.A : cA; const char* nB = has_next ? nxt.B : cB;
        for (int t = 0; t < nt; t += 2) {
            const bool last = (t == nt - 2);
            const char* a1 = cA + (size_t)(t + 1) * kstep;
            const char* a2 = last ? nA : cA + (size_t)(t + 2) * kstep; const char* b2 = last ? nB : cB + (size_t)(t + 2) * kstep;
            const char* a3 = a2 + kstep; const char* b3 = b2 + kstep;
            if constexpr (SP2) {
            PG8_LDB(B0, 0, 0); PG8_LDB(B1, 0, 1); PG8_SCHED; PG8_LDA(At, 0, 0); PG8_STAGE(PG8_SA(1, 1), a1 + hstep, voffA);
            PG8_WAIT_V(8); PG8_WAIT_L(0); PG8_BAR; PG8_MMA(0, 0, At, B0); PG8_MMA(0, 1, At, B1); PG8_BAR; PG8_SCHED;
            PG8_LDA(At, 0, 1); PG8_STAGE(PG8_SB(0, 0), b2, voffB); PG8_STAGE(PG8_SB(0, 1), b2 + hstep, voffB); PG8_STAGE(PG8_SA(0, 0), a2, voffA);
            PG8_WAIT_V(8); PG8_WAIT_L(0); PG8_BAR; PG8_MMA(1, 0, At, B0); PG8_MMA(1, 1, At, B1); PG8_BAR; PG8_SCHED;
            PG8_LDB(B0, 1, 0); PG8_LDB(B1, 1, 1); PG8_SCHED; PG8_LDA(At, 1, 0); PG8_STAGE(PG8_SA(0, 1), a2 + hstep, voffA);
            PG8_WAIT_V(8); PG8_WAIT_L(0); PG8_BAR; PG8_MMA(0, 0, At, B0); PG8_MMA(0, 1, At, B1); PG8_BAR; PG8_SCHED;
            PG8_LDA(At, 1, 1); PG8_STAGE(PG8_SB(1, 0), b3, voffB); PG8_STAGE(PG8_SB(1, 1), b3 + hstep, voffB); PG8_STAGE(PG8_SA(1, 0), a3, voffA);
            PG8_WAIT_V(8); PG8_WAIT_L(0); PG8_BAR; PG8_MMA(1, 0, At, B0); PG8_MMA(1, 1, At, B1); PG8_BAR; PG8_SCHED;
            } else {
            PG8_LDB(B0, 0, 0); PG8_SCHED; PG8_LDA(At, 0, 0); PG8_STAGE(PG8_SA(1, 1), a1 + hstep, voffA);
            PG8_WAIT_L(8); PG8_BAR; PG8_WAIT_L(0); PG8_MMA(0, 0, At, B0); PG8_BAR; PG8_SCHED;
            PG8_LDB(B1, 0, 1); PG8_STAGE(PG8_SB(0, 0), b2, voffB);
            PG8_BAR; PG8_WAIT_L(0); PG8_MMA(0, 1, At, B1); PG8_BAR;
            PG8_LDA(At, 0, 1); PG8_STAGE(PG8_SA(0, 0), a2, voffA);
            PG8_BAR; PG8_WAIT_L(0); PG8_MMA(1, 0, At, B0); PG8_BAR; PG8_SCHED;
            PG8_STAGE(PG8_SB(0, 1), b2 + hstep, voffB);
            PG8_WAIT_V(6); PG8_BAR; PG8_MMA(1, 1, At, B1); PG8_BAR;
            PG8_LDB(B0, 1, 0); PG8_SCHED; PG8_LDA(At, 1, 0); PG8_STAGE(PG8_SA(0, 1), a2 + hstep, voffA);
            PG8_WAIT_L(8); PG8_BAR; PG8_WAIT_L(0); PG8_MMA(0, 0, At, B0); PG8_BAR; PG8_SCHED;
            PG8_LDB(B1, 1, 1); PG8_STAGE(PG8_SB(1, 0), b3, voffB);
            PG8_BAR; PG8_WAIT_L(0); PG8_MMA(0, 1, At, B1); PG8_BAR;
            PG8_LDA(At, 1, 1); PG8_STAGE(PG8_SA(1, 0), a3, voffA);
            PG8_BAR; PG8_WAIT_L(0); PG8_MMA(1, 0, At, B0); PG8_BAR; PG8_SCHED;
            PG8_STAGE(PG8_SB(1, 1), b3 + hstep, voffB);
            PG8_WAIT_V(6); PG8_BAR; PG8_MMA(1, 1, At, B1); PG8_BAR;
            }
        }
        if constexpr (ALIGN_EPI) { if (wr == 0) PG8_BAR; }
        if constexpr (Epi::F8) asm volatile("s_nop 15\n\ts_nop 15" ::: "memory");
        bool keep = false;
        if constexpr (Epi::KEEP) keep = E(acc, cur, wr, wc, fr, fq); else E(acc, cur, wr, wc, fr, fq);
        if (!has_next) break;
        if (!keep) {
#pragma unroll
        for (int a = 0; a < 2; ++a)
#pragma unroll
            for (int b = 0; b < 2; ++b)
#pragma unroll
                for (int m = 0; m < 4; ++m)
#pragma unroll
                    for (int n = 0; n < 2; ++n) acc[a][b][m][n] = (f32x4){0.f, 0.f, 0.f, 0.f};
        }
        cur = nxt; cA = nA; cB = nB; ++ui;
        if constexpr (ALIGN_EPI) { if (wr == 1) PG8_BAR; }
    }
    PG8_WAIT_V(0);
    if constexpr (!ALIGN_EPI) { if (wr == 0) PG8_BAR; }
    PG8_BAR;
#undef PG8_SA
#undef PG8_SB
#undef PG8_STAGE
#undef PG8_LD8
#undef PG8_H0
#undef PG8_H1
#undef PG8_LDA
#undef PG8_LDB
#undef PG8_MMA
#undef PG8_WAIT_V
#undef PG8_WAIT_L
#undef PG8_BAR
#undef PG8_SCHED
}
}

namespace epi {
using pg8::Unit;
typedef const f32x4 (&AccT)[2][2][4][2];
__device__ __forceinline__ u32x4 pack8(f32x4 v0, f32x4 v1) { u32x4 w; w.x = cvt_pk_bf16(v0[0], v0[1]); w.y = cvt_pk_bf16(v0[2], v0[3]); w.z = cvt_pk_bf16(v1[0], v1[1]); w.w = cvt_pk_bf16(v1[2], v1[3]); return w; }
#ifndef MK_EPI_NT
#define MK_EPI_NT 0
#endif
template <class T> __device__ __forceinline__ void est(T* p, T v) { if constexpr (MK_EPI_NT != 0) __builtin_nontemporal_store(v, p); else *p = v; }
__device__ __forceinline__ void unpack8(u32x4 w, f32x4& v0, f32x4& v1) { v0 = (f32x4){bf_lo(w.x), bf_hi(w.x), bf_lo(w.y), bf_hi(w.y)}; v1 = (f32x4){bf_lo(w.z), bf_hi(w.z), bf_lo(w.w), bf_hi(w.w)}; }
__device__ __forceinline__ unsigned q8(float g) { return (unsigned)fminf(fmaxf(g * 255.f + 0.5f, 1.f), 255.f); }
__device__ __forceinline__ unsigned pk4_u8(f32x4 v) { return q8(v[0]) | (q8(v[1]) << 8) | (q8(v[2]) << 16) | (q8(v[3]) << 24); }
__device__ __forceinline__ void unpack8_u8(u32x2 w, f32x4& v0, f32x4& v1) {
    v0 = (f32x4){(float)((w.x >> 0) & 255u), (float)((w.x >> 8) & 255u), (float)((w.x >> 16) & 255u), (float)((w.x >> 24) & 255u)};
    v1 = (f32x4){(float)((w.y >> 0) & 255u), (float)((w.y >> 8) & 255u), (float)((w.y >> 16) & 255u), (float)((w.y >> 24) & 255u)}; }
__device__ __forceinline__ float sum8sq(f32x4 a, f32x4 b) { return (a[0] * a[0] + a[1] * a[1]) + (a[2] * a[2] + a[3] * a[3]) + (b[0] * b[0] + b[1] * b[1]) + (b[2] * b[2] + b[3] * b[3]); }
typedef unsigned long long ss_t;
__device__ __forceinline__ ss_t ss_fix(float sq) { return (ss_t)(sq * 16777216.f); }
__device__ __forceinline__ float ss_val(const ss_t* ss, int row) { return (float)ss[row] * (1.f / 16777216.f); }
__device__ __forceinline__ void row_atomic(ss_t* ss, int row, float sq, int fq) { sq += __shfl_xor(sq, 16); sq += __shfl_xor(sq, 32); if (fq == 0) atomicAdd(ss + row, ss_fix(sq)); }

struct EpiBf16 { static constexpr bool PERM = true, KEEP = false, F8 = false;
    bf16_t* O; int ldc;
    __device__ __forceinline__ void operator()(AccT acc, const Unit& u, int wr, int wc, int fr, int fq) const {
        const int row0 = u.pm * 256 + wr * 64 + fr, col0 = u.pn * 256 + wc * 32 + 8 * fq;
#pragma unroll
        for (int ai = 0; ai < 2; ++ai)
#pragma unroll
            for (int m = 0; m < 4; ++m) { bf16_t* rp = O + (size_t)(row0 + ai * 128 + m * 16) * ldc + col0;
#pragma unroll
                for (int bj = 0; bj < 2; ++bj) est((u32x4*)(rp + bj * 128), (u32x4)pack8(acc[ai][bj][m][0], acc[ai][bj][m][1])); }
    }
};
struct EpiInproj { static constexpr bool PERM = true, KEEP = false, F8 = false;
    bf16_t* O; const ss_t* ss; ss_t* ssv; unsigned char* G8;
    __device__ __forceinline__ void operator()(AccT acc, const Unit& u, int wr, int wc, int fr, int fq) const {
        const int type = u.pn < 10 ? 0 : (u.pn < 14 ? 1 : (u.pn < 18 ? 2 : 3));
        const int row0 = u.pm * 256 + wr * 64 + fr, col0 = u.pn * 256 + wc * 32 + 8 * fq;
#pragma unroll
        for (int ai = 0; ai < 2; ++ai)
#pragma unroll
            for (int m = 0; m < 4; ++m) { const int row = row0 + ai * 128 + m * 16; const float r = rsqrtf(ss_val(ss, row) * (1.0f / DM) + EPS); bf16_t* rp = O + (size_t)row * NIN + col0; float sq = 0.f;
#pragma unroll
                for (int bj = 0; bj < 2; ++bj) { f32x4 v0 = acc[ai][bj][m][0] * r, v1 = acc[ai][bj][m][1] * r;
                    if (type == 1 || type == 2) {
#pragma unroll
                        for (int j = 0; j < 4; ++j) { v0[j] = gelu_t(v0[j]); v1[j] = gelu_t(v1[j]); }
                        if (type == 2) sq += sum8sq(v0, v1); }
                    if (type == 3) {
#pragma unroll
                        for (int j = 0; j < 4; ++j) { v0[j] = sigm(v0[j]); v1[j] = sigm(v1[j]); }
                        est((u32x2*)(G8 + (size_t)row * (NIN - C_G) + (col0 - C_G) + bj * 128), (u32x2)(u32x2){pk4_u8(v0), pk4_u8(v1)}); }
                    else est((u32x4*)(rp + bj * 128), (u32x4)pack8(v0, v1)); }
                if (type == 2) row_atomic(ssv, row, sq, fq); }
    }
};
struct EpiGlu { static constexpr bool PERM = true, KEEP = false, F8 = false;
    const bf16_t* ssmy; bf16_t* ssmo;
    __device__ __forceinline__ void operator()(AccT acc, const Unit& u, int wr, int wc, int fr, int fq) const {
        const int row0 = u.pm * 256 + wr * 64 + fr, col0 = u.pn * 256 + wc * 32 + 8 * fq;
#pragma unroll
        for (int ai = 0; ai < 2; ++ai)
#pragma unroll
            for (int m = 0; m < 4; ++m) { const int row = row0 + ai * 128 + m * 16;
#pragma unroll
                for (int bj = 0; bj < 2; ++bj) { const int col = col0 + bj * 128; const f32x4 a0 = acc[ai][bj][m][0], a1 = acc[ai][bj][m][1];
                    f32x4 y0, y1; unpack8(*(const u32x4*)(ssmy + (size_t)row * 1024 + col), y0, y1);
#pragma unroll
                    for (int j = 0; j < 4; ++j) { y0[j] *= sigm(a0[j]); y1[j] *= sigm(a1[j]); }
                    est((u32x4*)(ssmo + (size_t)row * 1024 + col), (u32x4)pack8(y0, y1)); } }
    }
};
struct EpiMerge { static constexpr bool PERM = true, KEEP = true, F8 = false;
    const unsigned char* G8; bf16_t* mrgb;
    __device__ __forceinline__ bool operator()(f32x4 (&acc)[2][2][4][2], const Unit& u, int wr, int wc, int fr, int fq) const {
        const int row0 = u.pm * 256 + wr * 64 + fr, col0 = u.pn * 256 + wc * 32 + 8 * fq;
        const int gc = u.z == 0 ? 0 : (u.z == 1 ? 2 : 1), gn = u.z == 0 ? 2 : 1;
#pragma unroll
        for (int ai = 0; ai < 2; ++ai)
#pragma unroll
            for (int m = 0; m < 4; ++m) { const int row = row0 + ai * 128 + m * 16;
#pragma unroll
                for (int bj = 0; bj < 2; ++bj) { const int col = col0 + bj * 128; f32x4 g0, g1; unpack8_u8(*(const u32x2*)(G8 + (size_t)row * (NIN - C_G) + gc * DM + col), g0, g1);
                    if (u.z < 2) { f32x4 h0, h1; unpack8_u8(*(const u32x2*)(G8 + (size_t)row * (NIN - C_G) + gn * DM + col), h0, h1);
#pragma unroll
                        for (int j = 0; j < 4; ++j) { g0[j] *= __builtin_amdgcn_rcpf(h0[j]); g1[j] *= __builtin_amdgcn_rcpf(h1[j]); }
                        acc[ai][bj][m][0] *= g0; acc[ai][bj][m][1] *= g1;
                    } else est((u32x4*)(mrgb + (size_t)row * DM + col), (u32x4)pack8(acc[ai][bj][m][0] * (g0 * (1.f / 255.f)), acc[ai][bj][m][1] * (g1 * (1.f / 255.f)))); } }
        return u.z < 2;
    }
};
template <bool F8IN, bool F8OUT, bool RIN16> struct EpiResid { static constexpr bool PERM = true, KEEP = false, F8 = F8IN;
    const void* Xin; bf16_t* Xout; void* XB; ss_t* ss; float ascale; const float* gain;
    __device__ __forceinline__ void operator()(AccT acc, const Unit& u, int wr, int wc, int fr, int fq) const {
        const int row0 = u.pm * 256 + wr * 64 + fr, col0 = u.pn * 256 + wc * 32 + 8 * fq;
        f32x4 gv[2][2];
#pragma unroll
        for (int bj = 0; bj < 2; ++bj) { gv[bj][0] = *(const f32x4*)(gain + col0 + bj * 128); gv[bj][1] = *(const f32x4*)(gain + col0 + bj * 128 + 4); }
#pragma unroll
        for (int ai = 0; ai < 2; ++ai)
#pragma unroll
            for (int m = 0; m < 4; ++m) { const int row = row0 + ai * 128 + m * 16; float sq = 0.f;
#pragma unroll
                for (int bj = 0; bj < 2; ++bj) { const size_t o = (size_t)row * DM + col0 + bj * 128;
                    f32x4 r0, r1; if constexpr (RIN16) unpack8(*(const u32x4*)((const bf16_t*)Xin + o), r0, r1); else { r0 = *(const f32x4*)((const float*)Xin + o); r1 = *(const f32x4*)((const float*)Xin + o + 4); }
                    const f32x4 x0 = r0 + acc[ai][bj][m][0] * ascale, x1 = r1 + acc[ai][bj][m][1] * ascale;
                    est((u32x4*)(Xout + o), (u32x4)pack8(x0, x1));
                    const f32x4 y0 = x0 * gv[bj][0], y1 = x1 * gv[bj][1];
                    if constexpr (F8OUT) est((u32x2*)((unsigned char*)XB + o), (u32x2)(u32x2){pk4_fp8(y0[0], y0[1], y0[2], y0[3]), pk4_fp8(y1[0], y1[1], y1[2], y1[3])});
                    else est((u32x4*)((bf16_t*)XB + o), (u32x4)pack8(y0, y1));
                    sq += sum8sq(x0, x1); }
                row_atomic(ss, row, sq, fq); }
    }
};
template <bool F8_, bool F8OUT = F8_> struct EpiSwiglu { static constexpr bool PERM = false, KEEP = false, F8 = F8_;
    void* O; int ldo; const void* rs; int is_rstd; float ascale;
    __device__ __forceinline__ void operator()(AccT acc, const Unit& u, int wr, int wc, int fr, int fq) const {
        const int row0 = u.pm * 256 + wr * 64 + fr, col0 = u.pn * 128 + wc * 32 + 8 * fq;
#pragma unroll
        for (int ai = 0; ai < 2; ++ai)
#pragma unroll
            for (int m = 0; m < 4; ++m) { const int row = row0 + ai * 128 + m * 16; const float r = (is_rstd ? ((const float*)rs)[row] : rsqrtf(ss_val((const ss_t*)rs, row) * (1.0f / DM) + EPS)) * ascale;
                f32x4 o[2];
#pragma unroll
                for (int bj = 0; bj < 2; ++bj) { const f32x4 a = acc[ai][bj][m][0] * r, b = acc[ai][bj][m][1] * r;
#pragma unroll
                    for (int j = 0; j < 4; ++j) o[bj][j] = a[j] * sigm(a[j]) * b[j]; }
                if constexpr (F8OUT) est((u32x2*)((unsigned char*)O + (size_t)row * ldo + col0), (u32x2)(u32x2){pk4_fp8(o[0][0], o[0][1], o[0][2], o[0][3]), pk4_fp8(o[1][0], o[1][1], o[1][2], o[1][3])});
                else est((u32x4*)((bf16_t*)O + (size_t)row * ldo + col0), (u32x4)pack8(o[0], o[1])); }
    }
};
template <bool F8_, bool OUT32> struct EpiPle { static constexpr bool PERM = true, KEEP = false, F8 = F8_;
    const bf16_t* Xin; void* Xout; bf16_t* XB; const ss_t* ss_in; ss_t* ss_out; const bf16_t* pp; const float* gain; float ascale;
    __device__ __forceinline__ void operator()(AccT acc, const Unit& u, int wr, int wc, int fr, int fq) const {
        const int row0 = u.pm * 256 + wr * 64 + fr, col0 = u.pn * 256 + wc * 32 + 8 * fq;
#pragma unroll
        for (int ai = 0; ai < 2; ++ai)
#pragma unroll
            for (int m = 0; m < 4; ++m) { const int row = row0 + ai * 128 + m * 16; const float r = rsqrtf(ss_val(ss_in, row) * (1.0f / DM) + EPS) * ascale; float sq = 0.f;
#pragma unroll
                for (int bj = 0; bj < 2; ++bj) { const size_t o = (size_t)row * DM + col0 + bj * 128; f32x4 p0, p1; unpack8(*(const u32x4*)(pp + o), p0, p1);
                    f32x4 x0, x1; unpack8(*(const u32x4*)(Xin + o), x0, x1); const f32x4 a0 = acc[ai][bj][m][0] * r, a1 = acc[ai][bj][m][1] * r;
#pragma unroll
                    for (int j = 0; j < 4; ++j) { x0[j] += sigm(a0[j]) * p0[j]; x1[j] += sigm(a1[j]) * p1[j]; }
                    if constexpr (OUT32) { est((f32x4*)((float*)Xout + o), (f32x4)x0); est((f32x4*)((float*)Xout + o + 4), (f32x4)x1); } else est((u32x4*)((bf16_t*)Xout + o), (u32x4)pack8(x0, x1));
                    if (XB) *(u32x4*)(XB + o) = pack8(x0 * *(const f32x4*)(gain + col0 + bj * 128), x1 * *(const f32x4*)(gain + col0 + bj * 128 + 4)); sq += sum8sq(x0, x1); }
                if (ss_out) row_atomic(ss_out, row, sq, fq); }
    }
};
template <bool F8_> struct EpiMoe2 { static constexpr bool PERM = true, KEEP = false, F8 = F8_;
    bf16_t* YB; const float* row_gate; float ascale; bf16_t* YBX;
    __device__ __forceinline__ void operator()(AccT acc, const Unit& u, int wr, int wc, int fr, int fq) const {
        const int row0 = u.pm * 256 + wr * 64 + fr, col0 = u.pn * 256 + wc * 32 + 8 * fq;
#pragma unroll
        for (int ai = 0; ai < 2; ++ai)
#pragma unroll
            for (int m = 0; m < 4; ++m) { const int row = row0 + ai * 128 + m * 16; const float g = row_gate[row] * ascale; bf16_t* rp = (u.z == 0 ? YB + (size_t)row * DM : YBX + ((size_t)(u.z - 1) * 2048 + (row - 16384)) * DM) + col0;
#pragma unroll
                for (int bj = 0; bj < 2; ++bj) est((u32x4*)(rp + bj * 128), (u32x4)pack8(acc[ai][bj][m][0] * g, acc[ai][bj][m][1] * g)); }
    }
};
}

namespace attn {
constexpr int D = 128, NW = 8, QBLK = 32, KVBLK = 64;
constexpr float SCALE = 0.088388347648318440f;
constexpr float THR = 8.f;
constexpr int LDQ = 1024, LDK = 256, LDV = 256, LDO = 1024;
constexpr size_t SHM_V = KVBLK * D * 2, SHM_K = KVBLK * D * 2, SHM_ATTN = 2 * SHM_V + 2 * SHM_K + NW * 64 * 4;
#define KSWZ(row, colB) ((row) * 256 + ((colB) ^ (((row) & 7) << 4)))
#define SBAR() __builtin_amdgcn_sched_barrier(0)
__device__ __forceinline__ int crow(int r, int hi) { return (r & 3) + 8 * (r >> 2) + 4 * hi; }
__device__ __forceinline__ void partialSM(f32x16& p0, f32x16& p1, float& m_reg, float& mn, float& alpha) {
  constexpr float C = SCALE * 1.4426950408889634f;
  float pmax = p0[0]; for (int r = 1; r < 16; ++r) pmax = fmaxf(pmax, p0[r]); for (int r = 0; r < 16; ++r) pmax = fmaxf(pmax, p1[r]);
  { auto rr = __builtin_amdgcn_permlane32_swap(__float_as_uint(pmax), __float_as_uint(pmax), false, false);
    pmax = fmaxf(__uint_as_float(rr[0]), __uint_as_float(rr[1])); }
  if (__builtin_expect(__all(pmax - m_reg <= THR / SCALE), 1)) { mn = m_reg; alpha = 1.f; }
  else { mn = fmaxf(m_reg, pmax); alpha = __builtin_amdgcn_exp2f((m_reg - mn) * C); m_reg = mn; }
  float mnC = -mn * C;
  for (int r = 0; r < 16; ++r) p0[r] = fmaf(p0[r], C, mnC); for (int r = 0; r < 16; ++r) p1[r] = fmaf(p1[r], C, mnC);
  for (int r = 0; r < 16; ++r) p0[r] = __builtin_amdgcn_exp2f(p0[r]);
}
__device__ __forceinline__ void finishSM(f32x16& p0, f32x16& p1, float alpha, float& l_reg, bf16x8& pa0, bf16x8& pa1, bf16x8& pa2, bf16x8& pa3) {
  for (int r = 0; r < 16; ++r) p1[r] = __builtin_amdgcn_exp2f(p1[r]);
  float ps = 0; for (int r = 0; r < 16; ++r) ps += p0[r]; for (int r = 0; r < 16; ++r) ps += p1[r];
  { auto rr = __builtin_amdgcn_permlane32_swap(__float_as_uint(ps), __float_as_uint(ps), false, false);
    ps = __uint_as_float(rr[0]) + __uint_as_float(rr[1]); }
  l_reg = l_reg * alpha + ps;
#define PK4(P, BASE, OUT) do { unsigned a0 = cvt_pk_bf16(P[BASE + 0], P[BASE + 1]), a1 = cvt_pk_bf16(P[BASE + 2], P[BASE + 3]);   \
    unsigned b0 = cvt_pk_bf16(P[BASE + 4], P[BASE + 5]), b1 = cvt_pk_bf16(P[BASE + 6], P[BASE + 7]);                              \
    auto r0 = __builtin_amdgcn_permlane32_swap(a0, b0, false, false); auto r1 = __builtin_amdgcn_permlane32_swap(a1, b1, false, false); \
    u32x4 w = {r0[0], r1[0], r0[1], r1[1]}; OUT = *reinterpret_cast<bf16x8*>(&w); } while (0)
  PK4(p0, 0, pa0); PK4(p0, 8, pa1); PK4(p1, 0, pa2); PK4(p1, 8, pa3);
#undef PK4
}
__device__ __forceinline__ void qkt(f32x16& p0, f32x16& p1, const bf16_t* Ks, const bf16x8* qr, int r32, int hi) {
  p0 = f32x16{}; p1 = f32x16{};
  for (int d0 = 0; d0 < 8; ++d0) { int cb = (d0 * 16 + hi * 8) * 2;
    bf16x8 b0 = *reinterpret_cast<const bf16x8*>((const char*)Ks + KSWZ(r32, cb));
    bf16x8 b1 = *reinterpret_cast<const bf16x8*>((const char*)Ks + KSWZ(32 + r32, cb));
    p0 = __builtin_amdgcn_mfma_f32_32x32x16_bf16(b0, qr[d0], p0, 0, 0, 0);
    p1 = __builtin_amdgcn_mfma_f32_32x32x16_bf16(b1, qr[d0], p1, 0, 0, 0); }
}
__device__ __forceinline__ int v_st(int k, int c) { const int kk = (k & ~0xC) | ((k & 4) << 1) | ((k & 8) >> 1); return ((kk >> 3) * 4 + (c >> 5)) * 512 + ((kk & 7) * 32 + (c & 31)) * 2; }
__device__ __forceinline__ int v_rd_base(int lane) { return ((lane & 3) << 3) | (((lane >> 2) & 3) << 6) | (((lane >> 4) & 1) << 5) | (((lane >> 5) & 1) << 8); }
constexpr int v_rd_off(int d0, int ks, int half) { return d0 * 512 + ks * 4096 + half * 2048; }
template <int OFF> __device__ __forceinline__ s16x4 tr_read(int vb) {
  s16x4 r; asm volatile("ds_read_b64_tr_b16 %0, %1 offset:%2" : "=&v"(r) : "v"(vb), "i"(OFF) : "memory"); return r;
}
template <int D0> __device__ __forceinline__ void pv_one(f32x16& od, int vb, bf16x8 pa0, bf16x8 pa1, bf16x8 pa2, bf16x8 pa3) {
  const s16x4 l0 = tr_read<v_rd_off(D0, 0, 0)>(vb), h0 = tr_read<v_rd_off(D0, 0, 1)>(vb), l1 = tr_read<v_rd_off(D0, 1, 0)>(vb), h1 = tr_read<v_rd_off(D0, 1, 1)>(vb);
  const s16x4 l2 = tr_read<v_rd_off(D0, 2, 0)>(vb), h2 = tr_read<v_rd_off(D0, 2, 1)>(vb), l3 = tr_read<v_rd_off(D0, 3, 0)>(vb), h3 = tr_read<v_rd_off(D0, 3, 1)>(vb);
  asm volatile("s_waitcnt lgkmcnt(0)" ::: "memory"); SBAR();
#define PK(L, H) (bf16x8){L[0], L[1], L[2], L[3], H[0], H[1], H[2], H[3]}
  od = __builtin_amdgcn_mfma_f32_32x32x16_bf16(pa0, PK(l0, h0), od, 0, 0, 0);
  od = __builtin_amdgcn_mfma_f32_32x32x16_bf16(pa1, PK(l1, h1), od, 0, 0, 0);
  od = __builtin_amdgcn_mfma_f32_32x32x16_bf16(pa2, PK(l2, h2), od, 0, 0, 0);
  od = __builtin_amdgcn_mfma_f32_32x32x16_bf16(pa3, PK(l3, h3), od, 0, 0, 0);
#undef PK
}
__device__ __forceinline__ void pv_d0(f32x16* o, int vb, bf16x8 pa0, bf16x8 pa1, bf16x8 pa2, bf16x8 pa3) {
  pv_one<0>(o[0], vb, pa0, pa1, pa2, pa3); pv_one<1>(o[1], vb, pa0, pa1, pa2, pa3); pv_one<2>(o[2], vb, pa0, pa1, pa2, pa3); pv_one<3>(o[3], vb, pa0, pa1, pa2, pa3);
}
__device__ __forceinline__ void attn_dense_body(const bf16_t* __restrict__ Qb, const bf16_t* __restrict__ Kh, const bf16_t* __restrict__ Vh, bf16_t* __restrict__ Ob, int seq, char* lds) {
  constexpr int SDEPTH = 2;
  const int tid = threadIdx.x, wid = tid >> 6, lane = tid & 63, r32 = lane & 31, hi = lane >> 5;
  bf16_t* V_lds = (bf16_t*)lds; bf16_t* K_lds = (bf16_t*)(lds + 2 * SHM_V);
  float* ws = (float*)(lds + 2 * SHM_V + 2 * SHM_K) + wid * 64; float* li_l = ws; float* al_l = ws + 32;
  float m_reg = -1e30f, l_reg = 0; f32x16 o[4] = {}; bf16x8 qr[8];
  const bf16_t* Qw = Qb + (long)(wid * QBLK + r32) * LDQ + hi * 8;
#pragma unroll
  for (int d0 = 0; d0 < 8; ++d0) qr[d0] = *reinterpret_cast<const bf16x8*>(Qw + d0 * 16);
  const int sr = tid >> 4, sc = (tid & 15) * 8, vst0 = v_st(sr, sc), vst1 = v_st(32 + sr, sc);
  const int vb0 = (int)(uintptr_t)V_lds + v_rd_base(lane);
  struct { bf16x8 vs0, vs1, ks0, ks1; } sr_[SDEPTH];
#define SLOAD(i, k0) do { sr_[i].vs0 = *reinterpret_cast<const bf16x8*>(&Vh[(long)((k0) + sr) * LDV + sc]); sr_[i].vs1 = *reinterpret_cast<const bf16x8*>(&Vh[(long)((k0) + 32 + sr) * LDV + sc]); \
    sr_[i].ks0 = *reinterpret_cast<const bf16x8*>(&Kh[(long)((k0) + sr) * LDK + sc]); sr_[i].ks1 = *reinterpret_cast<const bf16x8*>(&Kh[(long)((k0) + 32 + sr) * LDK + sc]); } while (0)
#define SWRITE(b, i) do { *(bf16x8*)((char*)V_lds + (b) * SHM_V + vst0) = sr_[i].vs0;          \
    *(bf16x8*)((char*)V_lds + (b) * SHM_V + vst1) = sr_[i].vs1; int kc = sc * 2;               \
    *(bf16x8*)((char*)K_lds + (b) * SHM_K + KSWZ(sr, kc)) = sr_[i].ks0;                       \
    *(bf16x8*)((char*)K_lds + (b) * SHM_K + KSWZ(32 + sr, kc)) = sr_[i].ks1; } while (0)
#define SWAIT() do { asm volatile("s_waitcnt vmcnt(4)" ::: "memory"); } while (0)
#define RESC(a) do { if (__any((a) < 1.f)) { if (hi == 0) al_l[r32] = (a); asm volatile("s_waitcnt lgkmcnt(0)" ::: "memory"); \
    for (int d = 0; d < 4; ++d) for (int r = 0; r < 16; ++r) o[d][r] *= al_l[crow(r, hi)]; } } while (0)
  f32x16 pA0, pA1, pB0, pB1; float mnA, mnB, alA, alB; bf16x8 pa0, pa1, pa2, pa3; const int NTL = seq / KVBLK;
  constexpr int SE = 0, SO = SDEPTH - 1;
  SLOAD(SE, 0); asm volatile("s_waitcnt vmcnt(0)" ::: "memory"); SWRITE(0, SE); __syncthreads();
  qkt(pA0, pA1, K_lds, qr, r32, hi); partialSM(pA0, pA1, m_reg, mnA, alA);
  SLOAD(SO, KVBLK); if (2 < NTL) SLOAD(SE, 2 * KVBLK);
  SWAIT(); SWRITE(1, SO); __syncthreads();
  for (int j = 1; j + 1 < NTL; j += 2) {
    SBAR(); qkt(pB0, pB1, (bf16_t*)((char*)K_lds + SHM_K), qr, r32, hi);
    finishSM(pA0, pA1, alA, l_reg, pa0, pa1, pa2, pa3); SBAR();
    SLOAD(SO, (j + SDEPTH) * KVBLK); SBAR();
    pv_d0(o, vb0, pa0, pa1, pa2, pa3); partialSM(pB0, pB1, m_reg, mnB, alB);
    __syncthreads(); SWAIT(); SWRITE(0, SE);
    RESC(alB); __syncthreads();
    SBAR(); qkt(pA0, pA1, K_lds, qr, r32, hi);
    finishSM(pB0, pB1, alB, l_reg, pa0, pa1, pa2, pa3); SBAR();
    if (j + 3 < NTL) SLOAD(SE, (j + 1 + SDEPTH) * KVBLK); SBAR();
    pv_d0(o, vb0 + (int)SHM_V, pa0, pa1, pa2, pa3); partialSM(pA0, pA1, m_reg, mnA, alA);
    __syncthreads(); SWAIT(); SWRITE(1, SO);
    RESC(alA); __syncthreads();
  }
  SBAR(); qkt(pB0, pB1, (bf16_t*)((char*)K_lds + SHM_K), qr, r32, hi);
  finishSM(pA0, pA1, alA, l_reg, pa0, pa1, pa2, pa3); SBAR();
  pv_d0(o, vb0, pa0, pa1, pa2, pa3); partialSM(pB0, pB1, m_reg, mnB, alB);
  __syncthreads(); RESC(alB);
  finishSM(pB0, pB1, alB, l_reg, pa0, pa1, pa2, pa3); SBAR();
  pv_d0(o, vb0 + (int)SHM_V, pa0, pa1, pa2, pa3);
  if (hi == 0) li_l[r32] = l_reg; asm volatile("s_waitcnt lgkmcnt(0)" ::: "memory");
  float rli[16];
#pragma unroll
  for (int r = 0; r < 16; ++r) rli[r] = __builtin_amdgcn_rcpf(li_l[crow(r, hi)]);
  bf16_t* Ow = Ob + (long)(wid * QBLK) * LDO;
#pragma unroll
  for (int r = 0; r < 16; ++r) { int orow = crow(r, hi);
    for (int d0 = 0; d0 < 4; ++d0) Ow[(long)orow * LDO + d0 * 32 + r32] = f2bf(o[d0][r] * rli[r]); }
  __syncthreads();
#undef SLOAD
#undef SWRITE
#undef SWAIT
#undef RESC
}
}

namespace wsm {
constexpr size_t KiB = 1024, MiB = 1u << 20;
constexpr size_t CTL = 0, CTL_BYTES = 1 * MiB;
constexpr int CW_BAR = 0, CW_SS = 4096;
constexpr size_t LAMB = 1 * MiB, LAMT = LAMB + 128 * KiB;
constexpr size_t BBAR = 2 * MiB;
constexpr size_t CTT = 3 * MiB;
constexpr size_t WSB = 4 * MiB;
constexpr size_t ROUTE = 5 * MiB;
constexpr size_t R_IDX = ROUTE, R_GATE = ROUTE + 64 * KiB, R_TOKDEST = ROUTE + 128 * KiB, R_ROWTOK = ROUTE + 192 * KiB, R_ROWGATE = ROUTE + 320 * KiB, R_ROWRSTD = ROUTE + 448 * KiB,
                 R_HIST = ROUTE + 576 * KiB, R_TILES = ROUTE + 600 * KiB;
constexpr size_t ESTATE = 6 * MiB;
constexpr size_t W0 = 10 * MiB;
constexpr size_t SZ_WIN = (size_t)NIN * DM * 2, SZ_GLU = (size_t)1024 * 1024 * 2, SZ_WBR = (size_t)3 * DM * 1024 * 2, SZ_WOUT = (size_t)DM * DM * 2, SZ_PLEG = (size_t)DM * DM * 2, SZ_PLEP = (size_t)DM * PLED * 2;
constexpr size_t O_WIN = 0, O_GLU = O_WIN + SZ_WIN, O_WBR = O_GLU + SZ_GLU, O_WOUT = O_WBR + SZ_WBR, O_PLEG = O_WOUT + SZ_WOUT, O_PLEP = O_PLEG + SZ_PLEG, WL = O_PLEP + SZ_PLEP;
constexpr size_t FFN1 = W0 + 2 * WL, SZ_FFN1 = (size_t)2 * DFF * DM * 2, FFN2 = FFN1 + SZ_FFN1, SZ_FFN2 = (size_t)DM * DFF * 2;
constexpr size_t EXP1 = FFN2 + SZ_FFN2, SZ_EXP1 = (size_t)2 * DFE * DM * 2  , EXP2 = EXP1 + NEXP * SZ_EXP1, SZ_EXP2 = (size_t)DM * DFE * 2  ;
constexpr size_t ACT0 = (EXP2 + NEXP * SZ_EXP2 + 255) & ~(size_t)255;
constexpr size_t XF = ACT0, XBA = XF + (size_t)NT * DM * 4, XBB = XBA + (size_t)NT * DM * 2, PB = XBB + (size_t)NT * DM * 2, PP = PB + (size_t)2 * NT * PLED * 2, UNI = PP + (size_t)NT * DM * 2;
constexpr size_t PROJ = UNI, QN = PROJ + (size_t)NT * NIN * 2, KN = QN + (size_t)NT * 1024 * 2, VN = KN + (size_t)NT * 256 * 2, ATT = VN + (size_t)NT * 256 * 2,
                 SSMY = ATT + (size_t)NT * 1024 * 2, SSMO = SSMY + (size_t)NT * 1024 * 2, MLPO = SSMO + (size_t)NT * 1024 * 2, MRGF = MLPO + (size_t)NT * 1024 * 2, MRGB = MRGF + (size_t)NT * DM * 4,
                 MIX_END = MRGB + (size_t)NT * DM * 2;
constexpr size_t ACTD = UNI;
constexpr size_t XG = UNI, ACTM = XG + (size_t)CAPROWS * DM * 2, YB = ACTM + (size_t)CAPROWS * DFE * 2, YBX = YB + (size_t)CAPROWS * DM * 2, MOE_END = YBX + (size_t)3 * 2048 * DM * 2;
constexpr size_t END = (MIX_END > MOE_END ? MIX_END : MOE_END);
static_assert(MRGB >= ACTD + (size_t)NT * DFF * 2 || true, "");
}

#define XB_TMO      128
#define XB_XCNT(j)  (256  + 64 * (j))
#define XB_XSUB(j)  (1280 + 64 * (j))
#define XB_XGEN(j)  (2304 + 64 * (j))
#define XB_TOP      3328
#define XB_TOPGEN   3392
#define XCD_BAR_WORDS 3456
#define XB_SPIN_CAP (1u << 18)
#ifndef MK_EARLY_INV
#define MK_EARLY_INV 1
#endif
__device__ __forceinline__ unsigned xb_ld(unsigned* p)              { return __hip_atomic_load(p, __ATOMIC_RELAXED, __HIP_MEMORY_SCOPE_AGENT); }
__device__ __forceinline__ unsigned xb_add(unsigned* p, unsigned v) { return __hip_atomic_fetch_add(p, v, __ATOMIC_RELAXED, __HIP_MEMORY_SCOPE_AGENT); }
__device__ __forceinline__ unsigned xb_xcc_id() { return (unsigned)__builtin_amdgcn_s_getreg((3 << 11) | 20) & 0xFu; }
#define XB_SPIN(cond, bar) do { unsigned _sp = 0; while (cond) { __builtin_amdgcn_s_sleep(1); \
    if ((++_sp & 255u) == 0u) { if (xb_ld(&(bar)[XB_TMO])) break; if (_sp > XB_SPIN_CAP) { atomicAdd(&(bar)[XB_TMO], 1u); break; } } } } while (0)
struct XcdBarrier { unsigned* bar; unsigned x; volatile LAS unsigned* st; };
__device__ __forceinline__ XcdBarrier xcd_barrier_post(unsigned* bar, volatile LAS unsigned* st) {
    XcdBarrier b; b.bar = bar; b.x = xb_xcc_id(); b.st = st;
    if (threadIdx.x == 0) (void)xb_add(&bar[XB_XCNT(b.x)], 1u);
    return b;
}
__device__ __forceinline__ void xcd_barrier_complete(unsigned* bar, unsigned x, unsigned& nloc, unsigned& nx) {
    const unsigned G = gridDim.x * gridDim.y * gridDim.z;
    unsigned sum, cnt, mine, sp = 0u;
    for (;;) {
        sum = 0u; cnt = 0u; mine = 0u;
#pragma unroll
        for (unsigned j = 0; j < 16; ++j) { const unsigned c = xb_ld(&bar[XB_XCNT(j)]); sum += c; cnt += (c > 0u) ? 1u : 0u; mine = (j == x) ? c : mine; }
        if (sum == G) break;
        __builtin_amdgcn_s_sleep(1);
        if ((++sp & 255u) == 0u) { if (xb_ld(&bar[XB_TMO])) break; if (sp > XB_SPIN_CAP) { atomicAdd(&bar[XB_TMO], 1u); break; } }
    }
    nloc = mine > 0u ? mine : 1u; nx = cnt > 0u ? cnt : 1u;
}
__device__ __forceinline__ void xcd_barrier(const XcdBarrier& b) {
    asm volatile("s_waitcnt vmcnt(0)" ::: "memory");
    __syncthreads();
    if (threadIdx.x == 0) {
        unsigned* bar = b.bar;
        __builtin_amdgcn_s_waitcnt(0);
        unsigned nloc = b.st[0], nx = b.st[1];
        if (nloc == 0u) { xcd_barrier_complete(bar, b.x, nloc, nx); b.st[0] = nloc; b.st[1] = nx; }
        const unsigned old = xb_add(&bar[XB_XSUB(b.x)], 1u);
        const unsigned gen = old / nloc;
        if (old + 1u == (gen + 1u) * nloc) {
            __builtin_amdgcn_fence(__ATOMIC_RELEASE, "agent");
            asm volatile("s_waitcnt vmcnt(0)" ::: "memory");
            const unsigned og = xb_add(&bar[XB_TOP], 1u);
            const unsigned tg = og / nx;
#if MK_EARLY_INV
            __builtin_amdgcn_fence(__ATOMIC_ACQUIRE, "agent");
            if (og + 1u == (tg + 1u) * nx) xb_add(&bar[XB_TOPGEN], 1u);
            else XB_SPIN(xb_ld(&bar[XB_TOPGEN]) == tg, bar);
#else
            if (og + 1u == (tg + 1u) * nx) xb_add(&bar[XB_TOPGEN], 1u);
            else XB_SPIN(xb_ld(&bar[XB_TOPGEN]) == tg, bar);
            __builtin_amdgcn_fence(__ATOMIC_ACQUIRE, "agent");
#endif
            xb_add(&bar[XB_XGEN(b.x)], 1u);
            asm volatile("s_waitcnt vmcnt(0)" ::: "memory");
        } else {
#if MK_EARLY_INV
            __builtin_amdgcn_fence(__ATOMIC_ACQUIRE, "agent");
            XB_SPIN(xb_ld(&bar[XB_XGEN(b.x)]) == gen, bar);
            asm volatile("s_waitcnt vmcnt(0)" ::: "memory");
#else
            XB_SPIN(xb_ld(&bar[XB_XGEN(b.x)]) == gen, bar);
            __builtin_amdgcn_fence(__ATOMIC_ACQUIRE, "agent");
            asm volatile("s_waitcnt vmcnt(0)" ::: "memory");
#endif
        }
    }
    __syncthreads();
}

namespace thin {
constexpr int NW = 8;
__device__ __forceinline__ int swi_row(int a, int s) { const int pn = a >> 7, al = a & 127, wc = al >> 5, fq = (al >> 3) & 3, bj = (al >> 2) & 1, j = al & 3; return 256 * pn + 128 * bj + 32 * wc + 16 * s + 4 * fq + j; }
#ifndef MK_LDPOL
#define MK_LDPOL(p) __builtin_nontemporal_load(p)
#endif
struct ConvRegs { f32x4 v[16]; };
struct ConvDec { const float* src; unsigned char* dst; int k0, n0; };
template <bool F8>
__device__ __forceinline__ void conv_load(ConvRegs& R, const ConvDec& d, int ldn, int lane) {
    const int kp = lane >> 4, nq = lane & 15;
    const unsigned loff = (unsigned)(((F8 ? 4 : 2) * kp * ldn + 4 * nq) * 4);
    const char* base = (const char*)(d.src + (size_t)d.k0 * ldn + d.n0);
#pragma unroll
    for (int i = 0; i < 16; ++i) { const int ru = F8 ? (16 * (i >> 2) + (i & 3)) : (8 * (i >> 1) + (i & 1));
        const char* rb = base + (size_t)ru * ldn * 4; asm volatile("" : "+s"(rb));
        R.v[i] = MK_LDPOL((const f32x4*)(rb + loff)); }
}
template <int MAP, bool F8, bool NTS = true>
__device__ __forceinline__ void conv_store(const ConvRegs& R, const ConvDec& d, int K, float wscale, int s, LAS unsigned char* scr, int lane) {
    const int kp = lane >> 4, nq = lane & 15; const int k0 = d.k0, n0 = d.n0;
    constexpr int EBY = F8 ? 1 : 2;
    if constexpr (!F8) {
#pragma unroll
        for (int i = 0; i < 8; ++i) { const int kl = 8 * i + 2 * kp;
#pragma unroll
            for (int j = 0; j < 4; ++j) *(LAS unsigned*)(scr + (4 * nq + j) * 144 + (((4 * i + kp) ^ (4 * (nq >> 1))) << 2)) = cvt_pk_bf16(R.v[2 * i][j], R.v[2 * i + 1][j]); }
    } else {
#pragma unroll
        for (int i = 0; i < 4; ++i) { const int kl = 16 * i + 4 * kp;
#pragma unroll
            for (int j = 0; j < 4; ++j) *(LAS unsigned*)(scr + (4 * nq + j) * 80 + (((4 * i + kp) ^ (4 * ((nq >> 1) & 3))) << 2)) = pk4_fp8(R.v[4 * i][j] * wscale, R.v[4 * i + 1][j] * wscale, R.v[4 * i + 2][j] * wscale, R.v[4 * i + 3][j] * wscale); }
    }
    LDS_WAIT();
    constexpr int NR = F8 ? 4 : 8, LSH = F8 ? 2 : 3, NSTEP = F8 ? 16 : 8, LROW = F8 ? 80 : 144;
    const int nl = lane >> LSH, c = lane & ((1 << LSH) - 1);
    const unsigned lrow = (unsigned)(MAP == 0 ? nl : swi_row(nl, 0));
    const unsigned soff = lrow * (unsigned)(K * EBY) + 16u * c;
    const LAS unsigned char* lsrc = scr + nl * LROW;
#pragma unroll
    for (int r = 0; r < NR; ++r) { const int key = F8 ? (((nl >> 3) + 2 * r) & 3) : r;
        const u32x4 o = *(const LAS u32x4*)(lsrc + r * NSTEP * LROW + 16 * (c ^ key));
        const int urow = MAP == 0 ? (n0 + NSTEP * r) : swi_row(n0 + NSTEP * r, s);
        if constexpr (NTS) __builtin_nontemporal_store(o, (u32x4*)(d.dst + ((size_t)urow * K + k0) * EBY + soff)); else *(u32x4*)(d.dst + ((size_t)urow * K + k0) * EBY + soff) = o;
        if (r & 1) asm volatile("" ::: "memory"); }
    LDS_WAIT();
}
template <int MAP, bool F8, bool NTS = true>
__device__ __forceinline__ void conv_group(const float* src, size_t sstr, int count, int K, int N, void* dst, size_t dstr_bytes, float wscale, int s, LAS unsigned char* scr, int gw, int ngw, int lane, int flo = 0, int fhi = 64) {
    const int nb = N / 64, ipm = (K / 64) * nb, i0 = (int)((long)count * ipm * flo / 64), total = (int)((long)count * ipm * fhi / 64);
    auto dec = [&](int it) { const int sub = it / ipm, r = it - sub * ipm, kb = r / nb, nbi = r - kb * nb;
        return ConvDec{src + (size_t)sub * sstr, (unsigned char*)dst + (size_t)sub * dstr_bytes, kb * 64, nbi * 64}; };
    int it = i0 + gw; if (it >= total) return;
    ConvRegs RA, RB, RC; ConvDec dA = dec(it), dB = dA, dC = dA; conv_load<F8>(RA, dA, N, lane);
    { const int itb = it + ngw; if (itb < total) { dB = dec(itb); conv_load<F8>(RB, dB, N, lane); } }
    for (;;) {
        { const int n2 = it + 2 * ngw; if (n2 < total) { dC = dec(n2); conv_load<F8>(RC, dC, N, lane); } }
        conv_store<MAP, F8, NTS>(RA, dA, K, wscale, s, scr, lane); it += ngw; if (it >= total) break;
        { const int n2 = it + 2 * ngw; if (n2 < total) { dA = dec(n2); conv_load<F8>(RA, dA, N, lane); } }
        conv_store<MAP, F8, NTS>(RB, dB, K, wscale, s, scr, lane); it += ngw; if (it >= total) break;
        { const int n2 = it + 2 * ngw; if (n2 < total) { dB = dec(n2); conv_load<F8>(RB, dB, N, lane); } }
        conv_store<MAP, F8, NTS>(RC, dC, K, wscale, s, scr, lane); it += ngw; if (it >= total) break;
    }
}
struct CoopRegs { f32x4 v[8]; };
__device__ __forceinline__ void coop_load(CoopRegs& R, const float* src, int ldn, int k0, int n0, int wv, int lane) {
    const int kp = lane >> 4, nq = lane & 15; const unsigned loff = (unsigned)((4 * kp * ldn + 4 * nq) * 4);
    const char* base = (const char*)(src + (size_t)(k0 + 32 * wv) * ldn + n0);
#pragma unroll
    for (int i = 0; i < 8; ++i) { const char* rb = base + (size_t)(16 * (i >> 2) + (i & 3)) * ldn * 4; asm volatile("" : "+s"(rb)); R.v[i] = MK_LDPOL((const f32x4*)(rb + loff)); }
}
template <int MAP>
__device__ __forceinline__ void coop_group(const float* src, size_t sstr, int count, int K, int N, unsigned char* dst, size_t dstr_bytes, float wscale, int s, LAS unsigned char* tl  , int cwg, int ncwg, int flo, int fhi) {
    const int tid = threadIdx.x, lane = tid & 63, wv = __builtin_amdgcn_readfirstlane(tid >> 6), kp = lane >> 4, nq = lane & 15;
    const int nb = N / 64, ipm = (K / 256) * nb, i0 = (int)((long)count * ipm * flo / 64), total = (int)((long)count * ipm * fhi / 64);
    int it = i0 + cwg; if (it >= total) return;
    CoopRegs RA, RB; int p = 0;
#define COOP_DEC(it_, srcp, dstp, k0_, n0_) const int sub_ = (it_) / ipm, r_ = (it_) - sub_ * ipm, kb_ = r_ / nb; const float* srcp = src + (size_t)sub_ * sstr; unsigned char* dstp = dst + (size_t)sub_ * dstr_bytes; const int k0_ = kb_ * 256, n0_ = (r_ - kb_ * nb) * 64
#define COOP_STORE(R, it_) do { COOP_DEC(it_, sp_, dp_, k0, n0); (void)sp_; LAS unsigned char* T = tl + p * 17408; \
        _Pragma("unroll") for (int i = 0; i < 2; ++i) _Pragma("unroll") for (int j = 0; j < 4; ++j) \
            *(LAS unsigned*)(T + (4 * nq + j) * 272 + (((8 * wv + 4 * i + kp) ^ (4 * (nq >> 1))) << 2)) = pk4_fp8(R.v[4 * i][j] * wscale, R.v[4 * i + 1][j] * wscale, R.v[4 * i + 2][j] * wscale, R.v[4 * i + 3][j] * wscale); \
        __syncthreads(); \
        const int nl = tid >> 4, ch = tid & 15; const unsigned lrow = (unsigned)(MAP == 0 ? nl : swi_row(nl, 0)); const unsigned soff = lrow * (unsigned)K + 16u * ch; \
        _Pragma("unroll") for (int r = 0; r < 2; ++r) { const int n = nl + 32 * r; const u32x4 o = *(const LAS u32x4*)(T + n * 272 + 16 * (ch ^ (n >> 3))); \
            const int urow = MAP == 0 ? (n0 + 32 * r) : swi_row(n0 + 32 * r, s); \
            __builtin_nontemporal_store(o, (u32x4*)(dp_ + (size_t)urow * K + k0 + soff)); } \
        p ^= 1; } while (0)
    { COOP_DEC(it, sp, dp, k0, n0); (void)dp; coop_load(RA, sp, N, k0, n0, wv, lane); }
    for (;;) {
        const int it1 = it + ncwg; const bool h1 = it1 < total; if (h1) { COOP_DEC(it1, sp, dp, k0, n0); (void)dp; coop_load(RB, sp, N, k0, n0, wv, lane); }
        COOP_STORE(RA, it);
        if (!h1) break;
        const int it2 = it1 + ncwg; const bool h2 = it2 < total; if (h2) { COOP_DEC(it2, sp, dp, k0, n0); (void)dp; coop_load(RA, sp, N, k0, n0, wv, lane); }
        COOP_STORE(RB, it1);
        if (!h2) break;
        it = it2;
    }
    __syncthreads();
#undef COOP_DEC
#undef COOP_STORE
}
}

namespace thin {
__device__ __forceinline__ void ssm_tables(int it, const float* lre, const float* lim, const float* ldt, const float* bre, const float* bim, const float* cre, const float* cim,
                                           float* lamb, float* lamt, bf16_t* bbar, bf16_t* ctt, int lane) {
    const int p = lane;
    const float lr = lre[it * 64 + p], li = lim[it * 64 + p], dt = __expf(ldt[it]);
    const float er = __expf(lr * dt); float sn, cs; sincosf(li * dt, &sn, &cs); const float ar = er * cs, ai = er * sn;
    const float nr = ar - 1.f, ni = ai, den = lr * lr + li * li; const float fr = (nr * lr + ni * li) / den, fi = (ni * lr - nr * li) / den;
    lamb[(it * 64 + p) * 2] = ar; lamb[(it * 64 + p) * 2 + 1] = ai;
    float tr = ar, ti = ai;
#pragma unroll
    for (int q = 0; q < 7; ++q) { const float nr2 = tr * tr - ti * ti, ni2 = 2.f * tr * ti; tr = nr2; ti = ni2; }
    lamt[(it * 64 + p) * 2] = tr; lamt[(it * 64 + p) * 2 + 1] = ti;
    bf16_t* bR = bbar + ((size_t)(it * 2 + 0) * 64 + p) * 16; bf16_t* bI = bbar + ((size_t)(it * 2 + 1) * 64 + p) * 16;
#pragma unroll
    for (int c = 0; c < 16; ++c) { const float xr = bre[(it * 64 + p) * 16 + c], xi = bim[(it * 64 + p) * 16 + c]; bR[c] = f2bf(fr * xr - fi * xi); bI[c] = f2bf(fr * xi + fi * xr); }
#pragma unroll
    for (int c = 0; c < 16; ++c) { ctt[((size_t)it * 16 + c) * 128 + 2 * p] = f2bf(cre[(it * 16 + c) * 64 + p]); ctt[((size_t)it * 16 + c) * 128 + 2 * p + 1] = f2bf(-cim[(it * 16 + c) * 64 + p]); }
}

struct BuFrags { bf16x8 r0, r1, i0, i1; };
__device__ __forceinline__ BuFrags load_bufrags(const bf16_t* bbar_dg  , int lane) {
    const int st = lane & 31, h = lane >> 5; BuFrags f;
    f.r0 = *(const bf16x8*)(bbar_dg + (size_t)(st) * 16 + 8 * h); f.r1 = *(const bf16x8*)(bbar_dg + (size_t)(32 + st) * 16 + 8 * h);
    f.i0 = *(const bf16x8*)(bbar_dg + (size_t)(64 + st) * 16 + 8 * h); f.i1 = *(const bf16x8*)(bbar_dg + (size_t)(96 + st) * 16 + 8 * h);
    return f;
}
__device__ __forceinline__ bf16x8 bu_load(const bf16_t* __restrict__ proj, int tok0, int g, int lane) { return *(const bf16x8*)(proj + (size_t)(tok0 + (lane & 31)) * NIN + C_U + g * 16 + 8 * (lane >> 5)); }
__device__ __forceinline__ void bu_block(const bf16x8 ua, const BuFrags& f, float (&BR)[32], float (&BI)[32]) {
    const f32x16 z = {};
    const f32x16 R0 = __builtin_amdgcn_mfma_f32_32x32x16_bf16(ua, f.r0, z, 0, 0, 0), R1 = __builtin_amdgcn_mfma_f32_32x32x16_bf16(ua, f.r1, z, 0, 0, 0);
    const f32x16 I0 = __builtin_amdgcn_mfma_f32_32x32x16_bf16(ua, f.i0, z, 0, 0, 0), I1 = __builtin_amdgcn_mfma_f32_32x32x16_bf16(ua, f.i1, z, 0, 0, 0);
#pragma unroll
    for (int r = 0; r < 16; ++r) {
        auto s = __builtin_amdgcn_permlane32_swap(__float_as_uint(R0[r]), __float_as_uint(R1[r]), false, false);
        BR[8 * (r >> 2) + (r & 3)] = __uint_as_float(s[0]); BR[8 * (r >> 2) + 4 + (r & 3)] = __uint_as_float(s[1]);
        auto q = __builtin_amdgcn_permlane32_swap(__float_as_uint(I0[r]), __float_as_uint(I1[r]), false, false);
        BI[8 * (r >> 2) + (r & 3)] = __uint_as_float(q[0]); BI[8 * (r >> 2) + 4 + (r & 3)] = __uint_as_float(q[1]);
    }
}
template <int DIR>
__device__ __forceinline__ void ssm_pass1_item(const bf16_t* __restrict__ proj, const float* __restrict__ lamb_l, const bf16_t* __restrict__ bbar_l, float* __restrict__ est, int b, int g, int n, int lane) {
    const int dg = DIR * 64 + g; const float ar = lamb_l[(dg * 64 + lane) * 2], ai = lamb_l[(dg * 64 + lane) * 2 + 1];
    const BuFrags f = load_bufrags(bbar_l + (size_t)dg * 2 * 64 * 16, lane);
    float sr = 0.f, si = 0.f;
    bf16x8 ua[4];
#pragma unroll
    for (int s = 0; s < 4; ++s) ua[s] = bu_load(proj, b * SEQ + n * 128 + (DIR ? 3 - s : s) * 32, g, lane);
#pragma unroll
    for (int s = 0; s < 4; ++s) { float BR[32], BI[32];
        bu_block(ua[s], f, BR, BI);
#pragma unroll
        for (int tt = 0; tt < 32; ++tt) { const int t = DIR ? 31 - tt : tt; const float nsr = fmaf(ar, sr, fmaf(-ai, si, BR[t])), nsi = fmaf(ar, si, fmaf(ai, sr, BI[t])); sr = nsr; si = nsi; } }
    float* e = est + ((((size_t)(DIR * 2 + b) * 64 + g) * 32 + n) * 64 + lane) * 2; *(f32x2*)e = (f32x2){sr, si};
}
template <int DIR>
__device__ __forceinline__ void ssm_pass2_dir(const bf16_t* __restrict__ proj, const float* __restrict__ lamb_l, const float* __restrict__ lamt_l, const bf16_t* __restrict__ bbar_l, const bf16_t* __restrict__ ctt_l,
                                              const float* __restrict__ est, int b, int g, int n, int lane, LAS unsigned char* sl, f32x4 (&yacc)[8]) {
    const int dg = DIR * 64 + g; const float ar = lamb_l[(dg * 64 + lane) * 2], ai = lamb_l[(dg * 64 + lane) * 2 + 1], tr = lamt_l[(dg * 64 + lane) * 2], ti = lamt_l[(dg * 64 + lane) * 2 + 1];
    float sr = 0.f, si = 0.f;
    { const float* e = est + ((((size_t)(DIR * 2 + b) * 64 + g) * 32) * 64 + lane) * 2; f32x2 ev[32];
#pragma unroll
      for (int m = 0; m < 32; ++m) ev[m] = *(const f32x2*)(e + (size_t)m * 128);
#pragma unroll
      for (int mm = 0; mm < 32; ++mm) { const int m = DIR ? 31 - mm : mm; const bool use = DIR ? (m > n) : (m < n);
          const float nsr = fmaf(tr, sr, fmaf(-ti, si, ev[m].x)), nsi = fmaf(tr, si, fmaf(ti, sr, ev[m].y)); sr = use ? nsr : sr; si = use ? nsi : si; } }
    const BuFrags f = load_bufrags(bbar_l + (size_t)dg * 2 * 64 * 16, lane);
    bf16x8 cb[4];
#pragma unroll
    for (int ks = 0; ks < 4; ++ks) cb[ks] = *(const bf16x8*)(ctt_l + ((size_t)dg * 16 + (lane & 15)) * 128 + 32 * ks + 8 * (lane >> 4));
    bf16x8 ua[4];
#pragma unroll
    for (int s = 0; s < 4; ++s) ua[s] = bu_load(proj, b * SEQ + n * 128 + (DIR ? 3 - s : s) * 32, g, lane);
#pragma unroll
    for (int s = 0; s < 4; ++s) { const int sb = DIR ? 3 - s : s; float BR[32], BI[32];
        bu_block(ua[s], f, BR, BI);
#pragma unroll
        for (int tt = 0; tt < 32; ++tt) { const int t = DIR ? 31 - tt : tt; const float nsr = fmaf(ar, sr, fmaf(-ai, si, BR[t])), nsi = fmaf(ar, si, fmaf(ai, sr, BI[t])); sr = nsr; si = nsi;
            *(LAS unsigned*)(sl + (t * 136 + 2 * lane) * 2) = cvt_pk_bf16(sr, si); }
        LDS_WAIT();
#pragma unroll
        for (int rb = 0; rb < 2; ++rb)
#pragma unroll
            for (int ks = 0; ks < 4; ++ks) { const bf16x8 a = *(const LAS bf16x8*)(sl + ((16 * rb + (lane & 15)) * 136 + 32 * ks + 8 * (lane >> 4)) * 2);
                yacc[2 * sb + rb] = __builtin_amdgcn_mfma_f32_16x16x32_bf16(a, cb[ks], yacc[2 * sb + rb], 0, 0, 0); }
        LDS_WAIT(); }
}
__device__ __forceinline__ void ssm_pass2_item(const bf16_t* __restrict__ proj, const float* lamb_l, const float* lamt_l, const bf16_t* bbar_l, const bf16_t* ctt_l, const float* est, const float* __restrict__ dskip,
                                               bf16_t* __restrict__ ssmy, int b, int g, int n, int lane, LAS unsigned char* sl) {
    f32x4 yacc[8];
#pragma unroll
    for (int i = 0; i < 8; ++i) yacc[i] = (f32x4){0.f, 0.f, 0.f, 0.f};
    ssm_pass2_dir<0>(proj, lamb_l, lamt_l, bbar_l, ctt_l, est, b, g, n, lane, sl, yacc);
    ssm_pass2_dir<1>(proj, lamb_l, lamt_l, bbar_l, ctt_l, est, b, g, n, lane, sl, yacc);
    const int c = lane & 15, ch = g * 16 + c; const float dk = dskip[ch];
#pragma unroll
    for (int blk = 0; blk < 8; ++blk)
#pragma unroll
        for (int r = 0; r < 4; ++r) { const int tok = b * SEQ + n * 128 + 16 * blk + 4 * (lane >> 4) + r;
            const float y = yacc[blk][r] + dk * bf2f(proj[(size_t)tok * NIN + C_U + ch]); ssmy[(size_t)tok * 1024 + ch] = f2bf(gelu_t(y)); }
}

__device__ __forceinline__ void rope_token(const bf16_t* __restrict__ proj, const float* __restrict__ qg, const float* __restrict__ kg, bf16_t* __restrict__ QN, bf16_t* __restrict__ KN, bf16_t* __restrict__ VN, int tok, int lane) {
    const int a = lane >> 5, f = lane & 31, i1 = a * 64 + f, i2 = i1 + 32; const int t = tok & (SEQ - 1);
    const float pos = a == 0 ? (float)((t >> 6) - 32) : (float)((t & 63) - 32);
    const float inv = exp2f(-(float)f * (13.287712379549449f / 32.f)); float sn, cs; sincosf(pos * inv, &sn, &cs);
    const bf16_t* src = proj + (size_t)tok * NIN;
#pragma unroll
    for (int hh = 0; hh < 10; ++hh) { const bf16_t* s = src + hh * 128; float x1 = bf2f(s[i1]), x2 = bf2f(s[i2]);
        const float ss = wave_sum(x1 * x1 + x2 * x2), rs = rsqrtf(ss * (1.f / 128.f) + EPS); const float* gn = hh < 8 ? qg : kg;
        x1 *= rs * gn[i1]; x2 *= rs * gn[i2];
        bf16_t* d = hh < 8 ? QN + (size_t)tok * 1024 + hh * 128 : KN + (size_t)tok * 256 + (hh - 8) * 128;
        d[i1] = f2bf(x1 * cs - x2 * sn); d[i2] = f2bf(x2 * cs + x1 * sn); }
    *(u32x2*)(VN + (size_t)tok * 256 + lane * 4) = *(const u32x2*)(src + C_V + lane * 4);
}

__device__ __forceinline__ void gmlp_item(const bf16_t* __restrict__ proj, const epi::ss_t* __restrict__ ssv, const float* __restrict__ vgain, const bf16_t* __restrict__ wsb_l, const float* __restrict__ bs_l,
                                          bf16_t* __restrict__ mlpo, int cn, int g, LAS unsigned char* lds) {
    const int tid = threadIdx.x, lane = tid & 63, wid = tid >> 6, tok0 = cn * 128;
    { const int p = tid >> 2, cb = (tid & 3) * 32; const float rs = rsqrtf(epi::ss_val(ssv, tok0 + p) * (1.f / 1024.f) + EPS);
#pragma unroll
      for (int cc = 0; cc < 4; ++cc) { const int c0 = cb + cc * 8; f32x4 v0, v1; epi::unpack8(*(const u32x4*)(proj + (size_t)(tok0 + p) * NIN + C_ZV + g * 128 + c0), v0, v1);
          const f32x4 g0 = *(const f32x4*)(vgain + g * 128 + c0), g1 = *(const f32x4*)(vgain + g * 128 + c0 + 4);
#pragma unroll
          for (int i = 0; i < 4; ++i) { *(LAS bf16_t*)(lds + ((c0 + i) * 136 + p) * 2) = f2bf(v0[i] * rs * g0[i]); *(LAS bf16_t*)(lds + ((c0 + 4 + i) * 136 + p) * 2) = f2bf(v1[i] * rs * g1[i]); } } }
    __syncthreads();
    const int qb = wid >> 1, ch = wid & 1, r32 = lane & 31, hi = lane >> 5;
    f32x16 a0 = {}, a1 = {};
#pragma unroll
    for (int ks = 0; ks < 8; ++ks) { const bf16x8 af = *(const bf16x8*)(wsb_l + ((size_t)g * 128 + 32 * qb + r32) * 128 + 16 * ks + 8 * hi);
        const bf16x8 b0 = *(const LAS bf16x8*)(lds + ((64 * ch + r32) * 136 + 16 * ks + 8 * hi) * 2), b1 = *(const LAS bf16x8*)(lds + ((64 * ch + 32 + r32) * 136 + 16 * ks + 8 * hi) * 2);
        a0 = __builtin_amdgcn_mfma_f32_32x32x16_bf16(af, b0, a0, 0, 0, 0); a1 = __builtin_amdgcn_mfma_f32_32x32x16_bf16(af, b1, a1, 0, 0, 0); }
#pragma unroll
    for (int r = 0; r < 16; ++r) { const int q = 32 * qb + (r & 3) + 8 * (r >> 2) + 4 * hi, tok = tok0 + q; const float bq = bs_l[g * 128 + q];
        const int c0 = g * 128 + 64 * ch + r32;
        mlpo[(size_t)tok * 1024 + c0] = f2bf(bf2f(proj[(size_t)tok * NIN + C_ZU + c0]) * (a0[r] + bq));
        mlpo[(size_t)tok * 1024 + c0 + 32] = f2bf(bf2f(proj[(size_t)tok * NIN + C_ZU + c0 + 32]) * (a1[r] + bq)); }
    __syncthreads();
}
}

struct SchedMerge {
    int G, c; const char *wsb, *wbr;
    __device__ __forceinline__ bool next(int i, pg8::Unit& u) const {
        const int Lx = i * G + c; if (Lx >= 768) return false;
        constexpr size_t ts = (size_t)256 * 1024 * 2;
        const int z = Lx >> 8; pg8::tile_of(Lx & 255, 32, 8, u.pm, u.pn); u.z = z;
        const size_t ao = z == 0 ? wsm::ATT : (z == 1 ? wsm::MLPO : wsm::SSMO), bo = (z == 0 ? (size_t)0 : (z == 1 ? (size_t)2 : (size_t)1)) * ((size_t)DM * 1024 * 2);
        u.A = wsb + ao + (size_t)u.pm * ts; u.B = wbr + bo + (size_t)u.pn * ts;
        return true;
    }
};
struct SchedMoe {
    int G, c, nN; const int* tiles; const char* A0; const char* B0; size_t tsA, tsB, estride;
    __device__ __forceinline__ bool next(int i, pg8::Unit& u) const {
        const int T = tiles[0]; const long Lx = (long)i * G + c; if (Lx >= (long)T * nN) return false;
        pg8::tile_of((int)Lx, T, nN, u.pm, u.pn); const int e = tiles[1 + u.pm]; u.z = e;
        u.A = A0 + (size_t)u.pm * tsA; u.B = B0 + (size_t)e * estride + (size_t)u.pn * tsB; return true;
    }
};

struct Args { const float* in[31]; float* out; unsigned char* ws; int ph_lo, ph_hi; };
#ifndef MK_WGM_IN
#define MK_WGM_IN 4
#endif
#ifndef MK_F8D2
#define MK_F8D2 1
#endif
constexpr bool F8D = (MK_FP8 >= 2), F8M = (MK_FP8 >= 1);
constexpr bool F8D2 = F8D || (MK_F8D2 != 0);
constexpr bool F8P = false;
constexpr float WS1 = 32.f, WS2 = 64.f;
struct SchedMoe2Main {
    int G, c; const int* tiles; const char* A0; const char* B0; size_t tsA, tsB, estride;
    __device__ __forceinline__ bool next(int i, pg8::Unit& u) const {
        const int Lx = i * G + c; if (Lx >= 512) return false;
        pg8::tile_of(Lx, 64, 8, u.pm, u.pn); const int e = tiles[1 + u.pm]; u.z = 0;
        u.A = A0 + (size_t)u.pm * tsA; u.B = B0 + (size_t)e * estride + (size_t)u.pn * tsB; return true;
    }
};
struct SchedMoe2Tail {
    int G, c; const int* tiles; const char* A0; const char* B0; size_t tsA, tsB, estride, kqbytes;
    __device__ __forceinline__ bool next(int i, pg8::Unit& u) const {
        const int ntl = tiles[0] - 64, q = i * G + c; if (q >= ntl * 32) return false;
        int tt; pg8::tile_of(q >> 2, ntl, 8, tt, u.pn); u.pm = 64 + tt; u.z = q & 3; const int e = tiles[1 + u.pm];
        u.A = A0 + (size_t)u.pm * tsA + (size_t)u.z * kqbytes; u.B = B0 + (size_t)e * estride + (size_t)u.pn * tsB + (size_t)u.z * kqbytes; return true;
    }
};
#ifndef MK_NCONV
#define MK_NCONV 88
#endif
constexpr int NCONV = MK_NCONV, NCOMP = 256 - NCONV;
#ifndef MK_NCONVF
#define MK_NCONVF 0
#endif
constexpr int NCONVF = MK_NCONVF, NCOMPF = 256 - NCONVF;
#ifndef MK_CWG
#define MK_CWG 0
#endif
#ifndef MK_CWA
#define MK_CWA (16 * 64 + 3)
#endif
#ifndef MK_CWB
#define MK_CWB (MK_CWA + MK_CWG)
#endif
#ifndef MK_CWP
#define MK_CWP 0
#endif
constexpr int CXB = 15 * 64;
constexpr int CW0_LO = 0, CW0_HI = 64, CW0X_LO = CXB, CW0X_HI = CXB + MK_CWP;
constexpr int CW1_LO = 64, CW1_HI = CXB, CW1B_LO = CW0X_HI, CW1B_HI = MK_CWA;
constexpr int CWG0_LO = MK_CWA, CWG0_HI = MK_CWA + MK_CWG;
constexpr int CWF_LO = MK_CWA + MK_CWG, CWF_HI = MK_CWB;
constexpr int CW2_LO = MK_CWB, CW2_HI = 18 * 64 - MK_CWG;
constexpr int CWG1_LO = 18 * 64 - MK_CWG, CWG1_HI = 18 * 64;
namespace thin {
template <int PLO, int PHI, bool NTS = true>
__device__ __forceinline__ void conv_jobs(const Args& a, unsigned char* ws, LAS unsigned char* scr, int cgw, int cngw, int lane) {
#define CJ(j) if constexpr (PLO < 64 * (j) + 64 && 64 * (j) < PHI)
#define CF(j) , (PLO > 64 * (j) ? PLO - 64 * (j) : 0), (PHI < 64 * (j) + 64 ? PHI - 64 * (j) : 64)
    { unsigned char* wl = ws + wsm::W0;
        { CJ(0) conv_group<0, false, NTS>(a.in[3], 0, 1, DM, NIN, wl + wsm::O_WIN, 0, 1.f, 0, scr, cgw, cngw, lane CF(0));
                      CJ(1) conv_group<0, false, NTS>(a.in[30], 0, 1, PLED, DM, wl + wsm::O_PLEP, 0, 1.f, 0, scr, cgw, cngw, lane CF(1));
                      CJ(2) conv_group<0, false, NTS>(a.in[14], 0, 1, 1024, 1024, wl + wsm::O_GLU, 0, 1.f, 0, scr, cgw, cngw, lane CF(2));
                      CJ(3) conv_group<0, false, NTS>(a.in[18], (size_t)1024 * DM, 3, 1024, DM, wl + wsm::O_WBR, (size_t)DM * 1024 * 2, 1.f, 0, scr, cgw, cngw, lane CF(3));
                      CJ(4) conv_group<0, false, NTS>(a.in[19], 0, 1, DM, DM, wl + wsm::O_WOUT, 0, 1.f, 0, scr, cgw, cngw, lane CF(4));
                      CJ(5) conv_group<1, F8D, NTS>(a.in[21], 0, 1, DM, DFF, ws + wsm::FFN1, 0, F8D ? WS1 : 1.f, 0, scr, cgw, cngw, lane CF(5));
                      CJ(6) conv_group<1, F8D, NTS>(a.in[22], 0, 1, DM, DFF, ws + wsm::FFN1, 0, F8D ? WS1 : 1.f, 1, scr, cgw, cngw, lane CF(6));
                      CJ(7) conv_group<0, F8D2, NTS>(a.in[23], 0, 1, DFF, DM, ws + wsm::FFN2, 0, F8D2 ? WS2 : 1.f, 0, scr, cgw, cngw, lane CF(7));
                      CJ(8) conv_group<0, false, NTS>(a.in[29], 0, 1, DM, DM, wl + wsm::O_PLEG, 0, 1.f, 0, scr, cgw, cngw, lane CF(8)); }
    }
    { unsigned char* wl = ws + wsm::W0 + wsm::WL;
        { CJ(9) conv_group<0, false, NTS>(a.in[3] + (size_t)DM * NIN, 0, 1, DM, NIN, wl + wsm::O_WIN, 0, 1.f, 0, scr, cgw, cngw, lane CF(9));
               CJ(10) conv_group<0, false, NTS>(a.in[30] + (size_t)PLED * DM, 0, 1, PLED, DM, wl + wsm::O_PLEP, 0, 1.f, 0, scr, cgw, cngw, lane CF(10));
               CJ(11) conv_group<0, false, NTS>(a.in[14] + (size_t)1024 * 1024, 0, 1, 1024, 1024, wl + wsm::O_GLU, 0, 1.f, 0, scr, cgw, cngw, lane CF(11));
               CJ(12) conv_group<0, false, NTS>(a.in[18] + (size_t)3 * 1024 * DM, (size_t)1024 * DM, 3, 1024, DM, wl + wsm::O_WBR, (size_t)DM * 1024 * 2, 1.f, 0, scr, cgw, cngw, lane CF(12));
               CJ(13) conv_group<0, false, NTS>(a.in[19] + (size_t)DM * DM, 0, 1, DM, DM, wl + wsm::O_WOUT, 0, 1.f, 0, scr, cgw, cngw, lane CF(13));
               CJ(14) conv_group<0, F8P, NTS>(a.in[29] + (size_t)DM * DM, 0, 1, DM, DM, wl + wsm::O_PLEG, 0, F8P ? WS1 : 1.f, 0, scr, cgw, cngw, lane CF(14)); } }
#ifndef MK_COOP
#define MK_COOP 0
#endif
    if constexpr (F8M && MK_COOP) {
        LAS unsigned char* tl = scr - (cgw & 7) * 9216 + 81920; const int cwg = cgw >> 3, ncwg = cngw >> 3;
        CJ(15) coop_group<0>(a.in[27], (size_t)DFE * DM, NEXP, DFE, DM, ws + wsm::EXP2, wsm::SZ_EXP2, WS2, 0, tl, cwg, ncwg CF(15));
        CJ(16) coop_group<1>(a.in[25], (size_t)DM * DFE, NEXP, DM, DFE, ws + wsm::EXP1, wsm::SZ_EXP1, WS1, 0, tl, cwg, ncwg CF(16));
        CJ(17) coop_group<1>(a.in[26], (size_t)DM * DFE, NEXP, DM, DFE, ws + wsm::EXP1, wsm::SZ_EXP1, WS1, 1, tl, cwg, ncwg CF(17));
    } else {
    CJ(15) conv_group<0, F8M, NTS>(a.in[27], (size_t)DFE * DM, NEXP, DFE, DM, ws + wsm::EXP2, wsm::SZ_EXP2, F8M ? WS2 : 1.f, 0, scr, cgw, cngw, lane CF(15));
    CJ(16) conv_group<1, F8M, NTS>(a.in[25], (size_t)DM * DFE, NEXP, DM, DFE, ws + wsm::EXP1, wsm::SZ_EXP1, F8M ? WS1 : 1.f, 0, scr, cgw, cngw, lane CF(16));
    CJ(17) conv_group<1, F8M, NTS>(a.in[26], (size_t)DM * DFE, NEXP, DM, DFE, ws + wsm::EXP1, wsm::SZ_EXP1, F8M ? WS1 : 1.f, 1, scr, cgw, cngw, lane CF(17));
    }
#undef CJ
#undef CF
}
}

constexpr int NWAVES = 8, RING_BYTES = 131072, MISC_OFF = RING_BYTES, LDS_BYTES = 147456;
constexpr int N_PHASES = 25;

__global__ void __launch_bounds__(NWAVES * 64, 2) mk_fwd(Args a) {
    extern __shared__ __attribute__((aligned(16))) unsigned char lds_raw[];
    LAS unsigned char* lds = (LAS unsigned char*)lds_raw;
    volatile LAS unsigned* MISC = (volatile LAS unsigned*)(lds + MISC_OFF);
    const int tid = threadIdx.x, lane = tid & 63, wave = __builtin_amdgcn_readfirstlane(tid >> 6);
    const int G = gridDim.x, bx = blockIdx.x;
    const int gw = bx * NWAVES + wave, ngw = G * NWAVES;
    unsigned char* ws = a.ws; unsigned* ctl = (unsigned*)(ws + wsm::CTL);
    for (int u = tid; u < 64; u += NWAVES * 64) MISC[u] = 0u;
    __syncthreads();
    const int lo = a.ph_lo, hi = a.ph_hi;
    XcdBarrier bar; bar.bar = ctl + wsm::CW_BAR; bar.x = 0; bar.st = MISC + 8;
    if (hi - lo > 1) bar = xcd_barrier_post(ctl + wsm::CW_BAR, MISC + 8);
#ifndef MK_SUB
#define MK_SUB 0xffu
#endif
#ifndef MK_MASK
#define MK_MASK 0xffffffffu
#endif
#define PHASE_BEGIN(id, ty) if (((MK_MASK >> (ty)) & 1u) && lo <= (id) && (id) < hi) { constexpr bool dum = false; (void)dum; if ((id) > lo) xcd_barrier(bar);
#define PHASE_BEGIN_D(id, ty) if (((MK_MASK >> (ty)) & 1u) && lo <= (id) && (id) < hi) { constexpr bool dum = true; (void)dum; if ((id) > lo) xcd_barrier(bar);
#define PHASE_BEGIN_R(id, ty) if (((MK_MASK >> (ty)) & 1u) && lo <= (id) && (id) < hi) { constexpr bool dum = false; (void)dum; xcd_barrier(bar);
#define PHASE_END }
    epi::ss_t* ssbase = (epi::ss_t*)(ctl + wsm::CW_SS);
    bf16_t* XR = (bf16_t*)(ws + wsm::XF); bf16_t* XBA = (bf16_t*)(ws + wsm::XBA); bf16_t* XBB = (bf16_t*)(ws + wsm::XBB); bf16_t* PB = (bf16_t*)(ws + wsm::PB); bf16_t* PP = (bf16_t*)(ws + wsm::PP);
    bf16_t* PROJ = (bf16_t*)(ws + wsm::PROJ); bf16_t* QN = (bf16_t*)(ws + wsm::QN); bf16_t* KN = (bf16_t*)(ws + wsm::KN); bf16_t* VN = (bf16_t*)(ws + wsm::VN); bf16_t* ATT = (bf16_t*)(ws + wsm::ATT);
    bf16_t* SSMY = (bf16_t*)(ws + wsm::SSMY); bf16_t* SSMO = (bf16_t*)(ws + wsm::SSMO); bf16_t* MLPO = (bf16_t*)(ws + wsm::MLPO); float* MRGF = (float*)(ws + wsm::MRGF); bf16_t* MRGB = (bf16_t*)(ws + wsm::MRGB);
    float* EST = (float*)(ws + wsm::ESTATE);

    PHASE_BEGIN(0, 0)
    {
        LAS unsigned char* scr = lds + wave * 9216;
        const int cgw = gw, cngw = ngw; {
        thin::conv_jobs<CW0_LO, CW0_HI, false>(a, ws, scr, cgw, cngw, lane); thin::conv_jobs<CW0X_LO, CW0X_HI>(a, ws, scr, cgw, cngw, lane);
        }
        for (int row = gw; row < NT; row += ngw) { const float* xr = a.in[0] + (size_t)row * DM; float sq = 0.f;
#pragma unroll
            for (int j = 0; j < 4; ++j) { const f32x4 v0 = *(const f32x4*)(xr + (lane + 64 * j) * 8), v1 = *(const f32x4*)(xr + (lane + 64 * j) * 8 + 4);
                const f32x4 g0 = *(const f32x4*)(a.in[2] + (lane + 64 * j) * 8), g1 = *(const f32x4*)(a.in[2] + (lane + 64 * j) * 8 + 4);
                *(u32x4*)(XBA + (size_t)row * DM + (lane + 64 * j) * 8) = epi::pack8(v0 * g0, v1 * g1); sq += epi::sum8sq(v0, v1); }
            sq = wave_sum(sq); if (lane == 0) ssbase[7 * NT + row] = epi::ss_fix(sq); }
        for (size_t i = (size_t)gw * 64 + lane; i < (size_t)2 * NT * PLED / 8; i += (size_t)ngw * 64) { const f32x4 v0 = *(const f32x4*)(a.in[1] + i * 8), v1 = *(const f32x4*)(a.in[1] + i * 8 + 4); *(u32x4*)(PB + i * 8) = epi::pack8(v0, v1); }
        for (size_t i = (size_t)gw * 64 + lane; i < (size_t)2 * 8 * 128 * 128 / 8; i += (size_t)ngw * 64) { const f32x4 v0 = *(const f32x4*)(a.in[16] + i * 8), v1 = *(const f32x4*)(a.in[16] + i * 8 + 4); *(u32x4*)((bf16_t*)(ws + wsm::WSB) + i * 8) = epi::pack8(v0, v1); }
#ifdef MK_XBAR
        for (int q = 0; q < MK_XBAR; ++q) xcd_barrier(bar);
#endif
        for (int it = gw; it < 256; it += ngw) thin::ssm_tables(it, a.in[6], a.in[7], a.in[8], a.in[9], a.in[10], a.in[11], a.in[12], (float*)(ws + wsm::LAMB), (float*)(ws + wsm::LAMT), (bf16_t*)(ws + wsm::BBAR), (bf16_t*)(ws + wsm::CTT), lane);
        __syncthreads();
    }
    PHASE_END

    { constexpr int l = 0;
        const int pb = 1 + 12 * l;
        constexpr bool FF8 = (l == 0) ? F8D : F8M;
        constexpr int EB = FF8 ? 1 : 2;
        unsigned char* wl = ws + wsm::W0 + (size_t)l * wsm::WL;
        bf16_t* xin = l ? XBB : XBA; bf16_t* x1b = l ? XBA : XBB; bf16_t* x2b = l ? XBB : XBA;
        epi::ss_t* ssv = ssbase + l * NT; epi::ss_t* ssx1 = ssbase + (2 + l) * NT; epi::ss_t* ssx2 = ssbase + (4 + l) * NT; epi::ss_t* ssx3 = ssbase + 6 * NT; const epi::ss_t* ssin = l ? ssx3 : ssbase + 7 * NT;
        const float* lamb_l = (const float*)(ws + wsm::LAMB) + (size_t)l * 16384; const float* lamt_l = (const float*)(ws + wsm::LAMT) + (size_t)l * 16384;
        const bf16_t* bbar_l = (const bf16_t*)(ws + wsm::BBAR) + (size_t)l * 262144; const bf16_t* ctt_l = (const bf16_t*)(ws + wsm::CTT) + (size_t)l * 262144;
        const bf16_t* wsb_l = (const bf16_t*)(ws + wsm::WSB) + (size_t)l * 131072;

        PHASE_BEGIN(pb + 0, 1)
        { if (bx < NCOMP) { pg8::SchedGrid S{NT / 256, NIN / 256, NCOMP, bx, 0, (const char*)xin, (const char*)(wl + wsm::O_WIN), (size_t)256 * DM * 2, MK_WGM_IN};
              epi::EpiInproj E{PROJ, ssin, dum ? ssbase + 8 * NT : ssv, (unsigned char*)MRGF};
              pg8::gemm_phase(lds, DM * 2, S, E); }
          else if (!dum) { LAS unsigned char* scr = lds + wave * 9216; const int cgw = (bx - NCOMP) * NWAVES + wave, cngw = NCONV * NWAVES;
              if constexpr (l == 0) { thin::conv_jobs<CW1_LO, CW1_HI>(a, ws, scr, cgw, cngw, lane); thin::conv_jobs<CW1B_LO, CW1B_HI>(a, ws, scr, cgw, cngw, lane); }
              else thin::conv_jobs<CW2_LO, CW2_HI>(a, ws, scr, cgw, cngw, lane); } }
        PHASE_END

        PHASE_BEGIN(pb + 1, 2)
        { for (int tok = gw; tok < NT; tok += ngw) thin::rope_token(PROJ, a.in[4] + l * 128, a.in[5] + l * 128, QN, KN, VN, tok, lane);
          for (int it = gw; it < 2 * 2 * 64 * 32; it += ngw) { const int n = it & 31, g = (it >> 5) & 63, b = (it >> 11) & 1, d = it >> 12;
              if (d == 0) thin::ssm_pass1_item<0>(PROJ, lamb_l, bbar_l, EST, b, g, n, lane); else thin::ssm_pass1_item<1>(PROJ, lamb_l, bbar_l, EST, b, g, n, lane); } }
        PHASE_END

        PHASE_BEGIN(pb + 2, 3)
        { { pg8::SchedGrid S{NT / 256, DM / 256, G, bx, 0, (const char*)(PB + (size_t)l * NT * PLED), (const char*)(wl + wsm::O_PLEP), (size_t)256 * PLED * 2};
            epi::EpiBf16 E{PP, DM};
            pg8::gemm_phase(lds, PLED * 2, S, E); }
          LAS unsigned char* sl = lds + wave * 8704;
          for (int it = gw; it < 2 * 64 * 32; it += ngw) { const int n = it & 31, g = (it >> 5) & 63, b = it >> 11;
              thin::ssm_pass2_item(PROJ, lamb_l, lamt_l, bbar_l, ctt_l, EST, a.in[13] + l * 1024, SSMY, b, g, n, lane, sl); }
          __syncthreads();
          for (int it = bx; it < 512; it += G) thin::gmlp_item(PROJ, ssv, a.in[15] + l * 1024, wsb_l, a.in[17] + l * 1024, MLPO, it >> 3, it & 7, lds); }
        PHASE_END

        PHASE_BEGIN(pb + 3, 4)
        { for (int it = bx; it < 256; it += G) {
              int combo, idx; if (G == 256) { const int xcd = it & 7, slot = it >> 3; combo = xcd >> 1; idx = (xcd & 1) * 32 + slot; } else { combo = it >> 6; idx = it & 63; }
              const int b = combo >> 1, kvh = combo & 1, h = kvh * 4 + (idx >> 4), qb = idx & 15;
              const size_t qo = ((size_t)(b * SEQ + qb * 256)) * 1024 + h * 128, ko = ((size_t)b * SEQ) * 256 + kvh * 128;
              attn::attn_dense_body(QN + qo, KN + ko, VN + ko, ATT + qo, SEQ, (char*)lds_raw); }
          if (bx < 128) { pg8::SchedGrid S{NT / 256, 1024 / 256, G, bx, 0, (const char*)SSMY, (const char*)(wl + wsm::O_GLU), (size_t)256 * 1024 * 2};
            epi::EpiGlu E{SSMY, SSMO};
            pg8::gemm_phase(lds, 1024 * 2, S, E); }
          else if (!dum) { LAS unsigned char* scr = lds + wave * 9216; const int cgw = (bx - 128) * NWAVES + wave, cngw = 128 * NWAVES;
              if constexpr (l == 0) thin::conv_jobs<CWG0_LO, CWG0_HI>(a, ws, scr, cgw, cngw, lane); else thin::conv_jobs<CWG1_LO, CWG1_HI>(a, ws, scr, cgw, cngw, lane); } }
        PHASE_END

        PHASE_BEGIN(pb + 4, 5)
        { SchedMerge S{G, bx, (const char*)ws, (const char*)(wl + wsm::O_WBR)};
          epi::EpiMerge E{(const unsigned char*)MRGF, MRGB};
          pg8::gemm_phase(lds, 1024 * 2, S, E); }
        PHASE_END

        PHASE_BEGIN(pb + 5, 6)
        { pg8::SchedGrid S{NT / 256, DM / 256, G, bx, 0, (const char*)MRGB, (const char*)(wl + wsm::O_WOUT), (size_t)256 * DM * 2};
          epi::EpiResid<false, FF8, (l != 0)> E{l == 0 ? (const void*)a.in[0] : (const void*)XR, dum ? (bf16_t*)MRGF : XR, dum ? (void*)SSMY : (void*)x1b, dum ? ssbase + 8 * NT : ssx1, 1.f, a.in[20] + l * DM};
          pg8::gemm_phase(lds, DM * 2, S, E); }
        PHASE_END

        if (l == 0) {
            PHASE_BEGIN(pb + 6, 7)
            { if (bx < NCOMPF) { pg8::SchedGrid S{NT / 256, 2 * DFF / 256, NCOMPF, bx, 0, (const char*)x1b, (const char*)(ws + wsm::FFN1), (size_t)256 * DM * EB};
                  epi::EpiSwiglu<FF8, F8D2> E{ws + wsm::ACTD, DFF, ssx1, 0, FF8 ? 1.f / WS1 : 1.f};
                  pg8::gemm_phase(lds, DM * EB, S, E); }
              else if (!dum) { LAS unsigned char* scr = lds + wave * 9216; thin::conv_jobs<CWF_LO, CWF_HI>(a, ws, scr, (bx - NCOMPF) * NWAVES + wave, NCONVF * NWAVES, lane); } }
            PHASE_END
            PHASE_BEGIN(pb + 7, 8)
            { constexpr int EB2 = F8D2 ? 1 : 2;
              pg8::SchedGrid S{NT / 256, DM / 256, G, bx, 0, (const char*)(ws + wsm::ACTD), (const char*)(ws + wsm::FFN2), (size_t)256 * DFF * EB2};
              epi::EpiResid<F8D2, false, true> E{XR, dum ? (bf16_t*)MRGF : XR, dum ? (void*)SSMY : (void*)x2b, dum ? ssbase + 8 * NT : ssx2, F8D2 ? 1.f / WS2 : 1.f, a.in[28] + l * DM};
              pg8::gemm_phase(lds, DFF * EB2, S, E); }
            PHASE_END
        } else {
            int* ridx = (int*)(ws + wsm::R_IDX); float* rgate = (float*)(ws + wsm::R_GATE); int* tokdest = (int*)(ws + wsm::R_TOKDEST); int* rowtok = (int*)(ws + wsm::R_ROWTOK);
            float* rowgate = (float*)(ws + wsm::R_ROWGATE); float* rowrstd = (float*)(ws + wsm::R_ROWRSTD); int* hist = (int*)(ws + wsm::R_HIST); int* tiles = (int*)(ws + wsm::R_TILES);
            bf16_t* XG = (bf16_t*)(ws + wsm::XG); bf16_t* ACTM = (bf16_t*)(ws + wsm::ACTM); bf16_t* YB = (bf16_t*)(ws + wsm::YB);
            PHASE_BEGIN(pb + 6, 9)
            { volatile LAS int* lh = (volatile LAS int*)lds;
              if (tid < 8) lh[tid] = 0;
              const float* gn = a.in[20] + DM; const float* wr = a.in[24];
              LAS f32x4* wg = (LAS f32x4*)(lds + 1024);
              { const int ln = tid & 63, jw = tid >> 6; const f32x4 gv = *(const f32x4*)(gn + 4 * ln + 256 * jw);
#pragma unroll
                for (int i = 0; i < 4; ++i) { const float* wp = wr + (size_t)(4 * ln + 256 * jw + i) * 8; wg[((jw * 4 + i) * 2 + 0) * 64 + ln] = *(const f32x4*)wp * gv[i]; wg[((jw * 4 + i) * 2 + 1) * 64 + ln] = *(const f32x4*)(wp + 4) * gv[i]; } }
              __syncthreads();
              float acc[4][8];
#pragma unroll
              for (int i = 0; i < 4; ++i)
#pragma unroll
                  for (int e = 0; e < 8; ++e) acc[i][e] = 0.f;
              const int tokb = bx * 32 + wave * 4;
#pragma unroll 2
              for (int j = 0; j < 8; ++j) { f32x4 xv[4];
#pragma unroll
                  for (int i = 0; i < 4; ++i) { const u32x2 xr = *(const u32x2*)(XR + (size_t)(tokb + i) * DM + 4 * lane + 256 * j); xv[i] = (f32x4){__uint_as_float(xr[0] << 16), __uint_as_float(xr[0] & 0xffff0000u), __uint_as_float(xr[1] << 16), __uint_as_float(xr[1] & 0xffff0000u)}; }
#pragma unroll
                  for (int jj = 0; jj < 4; ++jj) { const f32x4 w0 = wg[((j * 4 + jj) * 2 + 0) * 64 + lane], w1 = wg[((j * 4 + jj) * 2 + 1) * 64 + lane];
#pragma unroll
                      for (int i = 0; i < 4; ++i) { const float h = xv[i][jj];
                          acc[i][0] = fmaf(h, w0[0], acc[i][0]); acc[i][1] = fmaf(h, w0[1], acc[i][1]); acc[i][2] = fmaf(h, w0[2], acc[i][2]); acc[i][3] = fmaf(h, w0[3], acc[i][3]);
                          acc[i][4] = fmaf(h, w1[0], acc[i][4]); acc[i][5] = fmaf(h, w1[1], acc[i][5]); acc[i][6] = fmaf(h, w1[2], acc[i][6]); acc[i][7] = fmaf(h, w1[3], acc[i][7]); } } }
#pragma unroll
              for (int i = 0; i < 4; ++i) { const int tok = tokb + i; const float r = rsqrtf(epi::ss_val(ssx1, tok) * (1.f / DM) + EPS); float lg[8];
#pragma unroll
                  for (int e = 0; e < 8; ++e) lg[e] = wave_sum(acc[i][e]) * r;
                  if (lane == 0) { int i0 = 0; float v0 = lg[0];
#pragma unroll
                      for (int e = 1; e < 8; ++e) if (lg[e] > v0) { v0 = lg[e]; i0 = e; }
                      int i1 = -1; float v1 = -3.0e38f;
#pragma unroll
                      for (int e = 0; e < 8; ++e) if (e != i0 && lg[e] > v1) { v1 = lg[e]; i1 = e; }
                      const float e1 = __expf(v1 - v0), g0 = 1.f / (1.f + e1);
                      ridx[tok * 2] = i0; ridx[tok * 2 + 1] = i1; rgate[tok * 2] = g0; rgate[tok * 2 + 1] = e1 * g0;
                      __hip_atomic_fetch_add((LAS int*)lds + i0, 1, __ATOMIC_RELAXED, __HIP_MEMORY_SCOPE_WORKGROUP); __hip_atomic_fetch_add((LAS int*)lds + i1, 1, __ATOMIC_RELAXED, __HIP_MEMORY_SCOPE_WORKGROUP); } }
              __syncthreads();
              if (tid < 8) hist[bx * 8 + tid] = lh[tid];
              __syncthreads(); }
            PHASE_END
            PHASE_BEGIN(pb + 7, 10)
            { volatile LAS int* li = (volatile LAS int*)lds;
              { const int e = wave; int tot = 0, pr = 0;
#pragma unroll
                for (int j = 0; j < 4; ++j) { const int w = lane + 64 * j; const int v = hist[w * 8 + e]; tot += v; pr += (w < bx) ? v : 0; }
#pragma unroll
                for (int o = 1; o < 64; o <<= 1) { tot += __shfl_xor(tot, o); pr += __shfl_xor(pr, o); }
                if (lane == 0) { li[e] = tot; li[8 + e] = pr; } }
              __syncthreads();
              if (tid == 0) { int off = 0; for (int e = 0; e < 8; ++e) { li[16 + e] = off; off += ((li[e] + 255) >> 8) * 256; } li[24] = off >> 8; }
              __syncthreads();
              if (wave == 0) { const int tok = bx * 32 + (lane >> 1), k = lane & 1, e = ridx[tok * 2 + k]; int rank = 0;
#pragma unroll
                  for (int q = 0; q < 8; ++q) { const unsigned long long m = __ballot(e == q); if (e == q) rank = __popcll(m & ((1ull << lane) - 1ull)); }
                  const int dest = li[16 + e] + li[8 + e] + rank;
                  tokdest[tok * 2 + k] = dest; rowtok[dest] = tok; rowgate[dest] = rgate[tok * 2 + k]; rowrstd[dest] = rsqrtf(epi::ss_val(ssx1, tok) * (1.f / DM) + EPS); li[32 + lane] = dest; }
              if (bx == 0) {
                  if (tid < 8) { const int e = tid, nt = (li[e] + 255) >> 8, t0 = li[16 + e] >> 8; for (int t = 0; t < nt; ++t) tiles[1 + t0 + t] = e; if (e == 0) tiles[0] = li[24]; }
                  for (int e = 0; e < 8; ++e) { const int r0 = li[16 + e] + li[e], r1 = li[16 + e] + (((li[e] + 255) >> 8) << 8);
                      for (int r = r0 + tid; r < r1; r += NWAVES * 64) { rowtok[r] = -1; rowgate[r] = 0.f; rowrstd[r] = 0.f; } } }
              __syncthreads();
#pragma unroll
              for (int q = 0; q < 8; ++q) { const int i = wave * 8 + q, tok = bx * 32 + (i >> 1), dest = li[32 + i];
                  const u32x4* s = (const u32x4*)((const unsigned char*)x1b + (size_t)tok * DM * EB); u32x4* d = (u32x4*)((unsigned char*)XG + (size_t)dest * DM * EB);
#pragma unroll
                  for (int jj = 0; jj < 2 * EB; ++jj) d[lane + 64 * jj] = s[lane + 64 * jj]; }
              __syncthreads(); }
            PHASE_END
            PHASE_BEGIN(pb + 8, 11)
            { SchedMoe S{G, bx, 2 * DFE / 256, tiles, (const char*)XG, (const char*)(ws + wsm::EXP1), (size_t)256 * DM * EB, (size_t)256 * DM * EB, wsm::SZ_EXP1};
              epi::EpiSwiglu<FF8> E{ACTM, DFE, rowrstd, 1, FF8 ? 1.f / WS1 : 1.f};
              pg8::gemm_phase(lds, DM * EB, S, E); }
            PHASE_END
            PHASE_BEGIN(pb + 9, 12)
            { epi::EpiMoe2<FF8> E{YB, rowgate, FF8 ? 1.f / WS2 : 1.f, (bf16_t*)(ws + wsm::YBX)};
              { SchedMoe2Main S{G, bx, tiles, (const char*)ACTM, (const char*)(ws + wsm::EXP2), (size_t)256 * DFE * EB, (size_t)256 * DFE * EB, wsm::SZ_EXP2};
                pg8::gemm_phase(lds, DFE * EB, S, E); }
              { SchedMoe2Tail S{G, bx, tiles, (const char*)ACTM, (const char*)(ws + wsm::EXP2), (size_t)256 * DFE * EB, (size_t)256 * DFE * EB, wsm::SZ_EXP2, (size_t)DFE * EB / 4};
                pg8::gemm_phase(lds, DFE * EB, S, E, DFE * EB / 128 / 4); } }
            PHASE_END
            PHASE_BEGIN(pb + 10, 13)
            { for (int tok = gw; tok < NT; tok += ngw) { const int d0 = tokdest[tok * 2], d1 = tokdest[tok * 2 + 1]; float sq = 0.f;
#pragma unroll
                  for (int j = 0; j < 4; ++j) { const size_t o = (size_t)tok * DM + (lane + 64 * j) * 8; f32x4 x0, x1, p0, p1, q0, q1; epi::unpack8(*(const u32x4*)(XR + o), x0, x1);
                      epi::unpack8(*(const u32x4*)(YB + (size_t)d0 * DM + (lane + 64 * j) * 8), p0, p1); epi::unpack8(*(const u32x4*)(YB + (size_t)d1 * DM + (lane + 64 * j) * 8), q0, q1);
                      x0 += p0 + q0; x1 += p1 + q1;
#pragma unroll
                      for (int dd = 0; dd < 2; ++dd) { const int d = dd ? d1 : d0; if (d >= 16384) {
#pragma unroll
                          for (int s = 0; s < 3; ++s) { epi::unpack8(*(const u32x4*)((const bf16_t*)(ws + wsm::YBX) + ((size_t)s * 2048 + (d - 16384)) * DM + (lane + 64 * j) * 8), p0, p1); x0 += p0; x1 += p1; } } } *(u32x4*)(XR + o) = epi::pack8(x0, x1);
                      const float* gp = a.in[28] + DM + (lane + 64 * j) * 8; const f32x4 y0 = x0 * *(const f32x4*)gp, y1 = x1 * *(const f32x4*)(gp + 4);
                      if constexpr (F8P) *(u32x2*)((unsigned char*)x2b + o) = (u32x2){pk4_fp8(y0[0], y0[1], y0[2], y0[3]), pk4_fp8(y1[0], y1[1], y1[2], y1[3])}; else *(u32x4*)(x2b + o) = epi::pack8(y0, y1);
                      sq += epi::sum8sq(x0, x1); }
                  sq = wave_sum(sq); if (lane == 0) ssx2[tok] = epi::ss_fix(sq); } }
            PHASE_END
        }

        PHASE_BEGIN(pb + 11, 14)
        { constexpr bool PF8 = (l == 1) && F8P; constexpr int PEB = PF8 ? 1 : 2;
          pg8::SchedGrid S{NT / 256, DM / 256, G, bx, 0, (const char*)x2b, (const char*)(wl + wsm::O_PLEG), (size_t)256 * DM * PEB};
          epi::EpiPle<PF8, (l == 1)> E{XR, dum ? (void*)MRGF : (l ? (void*)a.out : (void*)XR), dum ? SSMY : (l ? nullptr : XBB), ssx2, dum ? ssbase + 8 * NT : (l ? nullptr : ssx3), PP, a.in[2] + DM, PF8 ? 1.f / WS1 : 1.f};
          pg8::gemm_phase(lds, DM * PEB, S, E); }
        PHASE_END

    }
    { constexpr int l = 1;
        const int pb = 1 + 12 * l;
        constexpr bool FF8 = (l == 0) ? F8D : F8M;
        constexpr int EB = FF8 ? 1 : 2;
        unsigned char* wl = ws + wsm::W0 + (size_t)l * wsm::WL;
        bf16_t* xin = l ? XBB : XBA; bf16_t* x1b = l ? XBA : XBB; bf16_t* x2b = l ? XBB : XBA;
        epi::ss_t* ssv = ssbase + l * NT; epi::ss_t* ssx1 = ssbase + (2 + l) * NT; epi::ss_t* ssx2 = ssbase + (4 + l) * NT; epi::ss_t* ssx3 = ssbase + 6 * NT; const epi::ss_t* ssin = l ? ssx3 : ssbase + 7 * NT;
        const float* lamb_l = (const float*)(ws + wsm::LAMB) + (size_t)l * 16384; const float* lamt_l = (const float*)(ws + wsm::LAMT) + (size_t)l * 16384;
        const bf16_t* bbar_l = (const bf16_t*)(ws + wsm::BBAR) + (size_t)l * 262144; const bf16_t* ctt_l = (const bf16_t*)(ws + wsm::CTT) + (size_t)l * 262144;
        const bf16_t* wsb_l = (const bf16_t*)(ws + wsm::WSB) + (size_t)l * 131072;

        PHASE_BEGIN(pb + 0, 1)
        { if (bx < NCOMP) { pg8::SchedGrid S{NT / 256, NIN / 256, NCOMP, bx, 0, (const char*)xin, (const char*)(wl + wsm::O_WIN), (size_t)256 * DM * 2, MK_WGM_IN};
              epi::EpiInproj E{PROJ, ssin, dum ? ssbase + 8 * NT : ssv, (unsigned char*)MRGF};
              pg8::gemm_phase(lds, DM * 2, S, E); }
          else if (!dum) { LAS unsigned char* scr = lds + wave * 9216; const int cgw = (bx - NCOMP) * NWAVES + wave, cngw = NCONV * NWAVES;
              if constexpr (l == 0) { thin::conv_jobs<CW1_LO, CW1_HI>(a, ws, scr, cgw, cngw, lane); thin::conv_jobs<CW1B_LO, CW1B_HI>(a, ws, scr, cgw, cngw, lane); }
              else thin::conv_jobs<CW2_LO, CW2_HI>(a, ws, scr, cgw, cngw, lane); } }
        PHASE_END

        PHASE_BEGIN(pb + 1, 2)
        { for (int tok = gw; tok < NT; tok += ngw) thin::rope_token(PROJ, a.in[4] + l * 128, a.in[5] + l * 128, QN, KN, VN, tok, lane);
          for (int it = gw; it < 2 * 2 * 64 * 32; it += ngw) { const int n = it & 31, g = (it >> 5) & 63, b = (it >> 11) & 1, d = it >> 12;
              if (d == 0) thin::ssm_pass1_item<0>(PROJ, lamb_l, bbar_l, EST, b, g, n, lane); else thin::ssm_pass1_item<1>(PROJ, lamb_l, bbar_l, EST, b, g, n, lane); } }
        PHASE_END

        PHASE_BEGIN(pb + 2, 3)
        { { pg8::SchedGrid S{NT / 256, DM / 256, G, bx, 0, (const char*)(PB + (size_t)l * NT * PLED), (const char*)(wl + wsm::O_PLEP), (size_t)256 * PLED * 2};
            epi::EpiBf16 E{PP, DM};
            pg8::gemm_phase(lds, PLED * 2, S, E); }
          LAS unsigned char* sl = lds + wave * 8704;
          for (int it = gw; it < 2 * 64 * 32; it += ngw) { const int n = it & 31, g = (it >> 5) & 63, b = it >> 11;
              thin::ssm_pass2_item(PROJ, lamb_l, lamt_l, bbar_l, ctt_l, EST, a.in[13] + l * 1024, SSMY, b, g, n, lane, sl); }
          __syncthreads();
          for (int it = bx; it < 512; it += G) thin::gmlp_item(PROJ, ssv, a.in[15] + l * 1024, wsb_l, a.in[17] + l * 1024, MLPO, it >> 3, it & 7, lds); }
        PHASE_END

        PHASE_BEGIN(pb + 3, 4)
        { for (int it = bx; it < 256; it += G) {
              int combo, idx; if (G == 256) { const int xcd = it & 7, slot = it >> 3; combo = xcd >> 1; idx = (xcd & 1) * 32 + slot; } else { combo = it >> 6; idx = it & 63; }
              const int b = combo >> 1, kvh = combo & 1, h = kvh * 4 + (idx >> 4), qb = idx & 15;
              const size_t qo = ((size_t)(b * SEQ + qb * 256)) * 1024 + h * 128, ko = ((size_t)b * SEQ) * 256 + kvh * 128;
              attn::attn_dense_body(QN + qo, KN + ko, VN + ko, ATT + qo, SEQ, (char*)lds_raw); }
          if (bx < 128) { pg8::SchedGrid S{NT / 256, 1024 / 256, G, bx, 0, (const char*)SSMY, (const char*)(wl + wsm::O_GLU), (size_t)256 * 1024 * 2};
            epi::EpiGlu E{SSMY, SSMO};
            pg8::gemm_phase(lds, 1024 * 2, S, E); }
          else if (!dum) { LAS unsigned char* scr = lds + wave * 9216; const int cgw = (bx - 128) * NWAVES + wave, cngw = 128 * NWAVES;
              if constexpr (l == 0) thin::conv_jobs<CWG0_LO, CWG0_HI>(a, ws, scr, cgw, cngw, lane); else thin::conv_jobs<CWG1_LO, CWG1_HI>(a, ws, scr, cgw, cngw, lane); } }
        PHASE_END

        PHASE_BEGIN(pb + 4, 5)
        { SchedMerge S{G, bx, (const char*)ws, (const char*)(wl + wsm::O_WBR)};
          epi::EpiMerge E{(const unsigned char*)MRGF, MRGB};
          pg8::gemm_phase(lds, 1024 * 2, S, E); }
        PHASE_END

        PHASE_BEGIN(pb + 5, 6)
        { pg8::SchedGrid S{NT / 256, DM / 256, G, bx, 0, (const char*)MRGB, (const char*)(wl + wsm::O_WOUT), (size_t)256 * DM * 2};
          epi::EpiResid<false, FF8, (l != 0)> E{l == 0 ? (const void*)a.in[0] : (const void*)XR, dum ? (bf16_t*)MRGF : XR, dum ? (void*)SSMY : (void*)x1b, dum ? ssbase + 8 * NT : ssx1, 1.f, a.in[20] + l * DM};
          pg8::gemm_phase(lds, DM * 2, S, E); }
        PHASE_END

        if (l == 0) {
            PHASE_BEGIN(pb + 6, 7)
            { if (bx < NCOMPF) { pg8::SchedGrid S{NT / 256, 2 * DFF / 256, NCOMPF, bx, 0, (const char*)x1b, (const char*)(ws + wsm::FFN1), (size_t)256 * DM * EB};
                  epi::EpiSwiglu<FF8, F8D2> E{ws + wsm::ACTD, DFF, ssx1, 0, FF8 ? 1.f / WS1 : 1.f};
                  pg8::gemm_phase(lds, DM * EB, S, E); }
              else if (!dum) { LAS unsigned char* scr = lds + wave * 9216; thin::conv_jobs<CWF_LO, CWF_HI>(a, ws, scr, (bx - NCOMPF) * NWAVES + wave, NCONVF * NWAVES, lane); } }
            PHASE_END
            PHASE_BEGIN(pb + 7, 8)
            { constexpr int EB2 = F8D2 ? 1 : 2;
              pg8::SchedGrid S{NT / 256, DM / 256, G, bx, 0, (const char*)(ws + wsm::ACTD), (const char*)(ws + wsm::FFN2), (size_t)256 * DFF * EB2};
              epi::EpiResid<F8D2, false, true> E{XR, dum ? (bf16_t*)MRGF : XR, dum ? (void*)SSMY : (void*)x2b, dum ? ssbase + 8 * NT : ssx2, F8D2 ? 1.f / WS2 : 1.f, a.in[28] + l * DM};
              pg8::gemm_phase(lds, DFF * EB2, S, E); }
            PHASE_END
        } else {
            int* ridx = (int*)(ws + wsm::R_IDX); float* rgate = (float*)(ws + wsm::R_GATE); int* tokdest = (int*)(ws + wsm::R_TOKDEST); int* rowtok = (int*)(ws + wsm::R_ROWTOK);
            float* rowgate = (float*)(ws + wsm::R_ROWGATE); float* rowrstd = (float*)(ws + wsm::R_ROWRSTD); int* hist = (int*)(ws + wsm::R_HIST); int* tiles = (int*)(ws + wsm::R_TILES);
            bf16_t* XG = (bf16_t*)(ws + wsm::XG); bf16_t* ACTM = (bf16_t*)(ws + wsm::ACTM); bf16_t* YB = (bf16_t*)(ws + wsm::YB);
            PHASE_BEGIN(pb + 6, 9)
            { volatile LAS int* lh = (volatile LAS int*)lds;
              if (tid < 8) lh[tid] = 0;
              const float* gn = a.in[20] + DM; const float* wr = a.in[24];
              LAS f32x4* wg = (LAS f32x4*)(lds + 1024);
              { const int ln = tid & 63, jw = tid >> 6; const f32x4 gv = *(const f32x4*)(gn + 4 * ln + 256 * jw);
#pragma unroll
                for (int i = 0; i < 4; ++i) { const float* wp = wr + (size_t)(4 * ln + 256 * jw + i) * 8; wg[((jw * 4 + i) * 2 + 0) * 64 + ln] = *(const f32x4*)wp * gv[i]; wg[((jw * 4 + i) * 2 + 1) * 64 + ln] = *(const f32x4*)(wp + 4) * gv[i]; } }
              __syncthreads();
              float acc[4][8];
#pragma unroll
              for (int i = 0; i < 4; ++i)
#pragma unroll
                  for (int e = 0; e < 8; ++e) acc[i][e] = 0.f;
              const int tokb = bx * 32 + wave * 4;
#pragma unroll 2
              for (int j = 0; j < 8; ++j) { f32x4 xv[4];
#pragma unroll
                  for (int i = 0; i < 4; ++i) { const u32x2 xr = *(const u32x2*)(XR + (size_t)(tokb + i) * DM + 4 * lane + 256 * j); xv[i] = (f32x4){__uint_as_float(xr[0] << 16), __uint_as_float(xr[0] & 0xffff0000u), __uint_as_float(xr[1] << 16), __uint_as_float(xr[1] & 0xffff0000u)}; }
#pragma unroll
                  for (int jj = 0; jj < 4; ++jj) { const f32x4 w0 = wg[((j * 4 + jj) * 2 + 0) * 64 + lane], w1 = wg[((j * 4 + jj) * 2 + 1) * 64 + lane];
#pragma unroll
                      for (int i = 0; i < 4; ++i) { const float h = xv[i][jj];
                          acc[i][0] = fmaf(h, w0[0], acc[i][0]); acc[i][1] = fmaf(h, w0[1], acc[i][1]); acc[i][2] = fmaf(h, w0[2], acc[i][2]); acc[i][3] = fmaf(h, w0[3], acc[i][3]);
                          acc[i][4] = fmaf(h, w1[0], acc[i][4]); acc[i][5] = fmaf(h, w1[1], acc[i][5]); acc[i][6] = fmaf(h, w1[2], acc[i][6]); acc[i][7] = fmaf(h, w1[3], acc[i][7]); } } }
#pragma unroll
              for (int i = 0; i < 4; ++i) { const int tok = tokb + i; const float r = rsqrtf(epi::ss_val(ssx1, tok) * (1.f / DM) + EPS); float lg[8];
#pragma unroll
                  for (int e = 0; e < 8; ++e) lg[e] = wave_sum(acc[i][e]) * r;
                  if (lane == 0) { int i0 = 0; float v0 = lg[0];
#pragma unroll
                      for (int e = 1; e < 8; ++e) if (lg[e] > v0) { v0 = lg[e]; i0 = e; }
                      int i1 = -1; float v1 = -3.0e38f;
#pragma unroll
                      for (int e = 0; e < 8; ++e) if (e != i0 && lg[e] > v1) { v1 = lg[e]; i1 = e; }
                      const float e1 = __expf(v1 - v0), g0 = 1.f / (1.f + e1);
                      ridx[tok * 2] = i0; ridx[tok * 2 + 1] = i1; rgate[tok * 2] = g0; rgate[tok * 2 + 1] = e1 * g0;
                      __hip_atomic_fetch_add((LAS int*)lds + i0, 1, __ATOMIC_RELAXED, __HIP_MEMORY_SCOPE_WORKGROUP); __hip_atomic_fetch_add((LAS int*)lds + i1, 1, __ATOMIC_RELAXED, __HIP_MEMORY_SCOPE_WORKGROUP); } }
              __syncthreads();
              if (tid < 8) hist[bx * 8 + tid] = lh[tid];
              __syncthreads(); }
            PHASE_END
            PHASE_BEGIN(pb + 7, 10)
            { volatile LAS int* li = (volatile LAS int*)lds;
              { const int e = wave; int tot = 0, pr = 0;
#pragma unroll
                for (int j = 0; j < 4; ++j) { const int w = lane + 64 * j; const int v = hist[w * 8 + e]; tot += v; pr += (w < bx) ? v : 0; }
#pragma unroll
                for (int o = 1; o < 64; o <<= 1) { tot += __shfl_xor(tot, o); pr += __shfl_xor(pr, o); }
                if (lane == 0) { li[e] = tot; li[8 + e] = pr; } }
              __syncthreads();
              if (tid == 0) { int off = 0; for (int e = 0; e < 8; ++e) { li[16 + e] = off; off += ((li[e] + 255) >> 8) * 256; } li[24] = off >> 8; }
              __syncthreads();
              if (wave == 0) { const int tok = bx * 32 + (lane >> 1), k = lane & 1, e = ridx[tok * 2 + k]; int rank = 0;
#pragma unroll
                  for (int q = 0; q < 8; ++q) { const unsigned long long m = __ballot(e == q); if (e == q) rank = __popcll(m & ((1ull << lane) - 1ull)); }
                  const int dest = li[16 + e] + li[8 + e] + rank;
                  tokdest[tok * 2 + k] = dest; rowtok[dest] = tok; rowgate[dest] = rgate[tok * 2 + k]; rowrstd[dest] = rsqrtf(epi::ss_val(ssx1, tok) * (1.f / DM) + EPS); li[32 + lane] = dest; }
              if (bx == 0) {
                  if (tid < 8) { const int e = tid, nt = (li[e] + 255) >> 8, t0 = li[16 + e] >> 8; for (int t = 0; t < nt; ++t) tiles[1 + t0 + t] = e; if (e == 0) tiles[0] = li[24]; }
                  for (int e = 0; e < 8; ++e) { const int r0 = li[16 + e] + li[e], r1 = li[16 + e] + (((li[e] + 255) >> 8) << 8);
                      for (int r = r0 + tid; r < r1; r += NWAVES * 64) { rowtok[r] = -1; rowgate[r] = 0.f; rowrstd[r] = 0.f; } } }
              __syncthreads();
#pragma unroll
              for (int q = 0; q < 8; ++q) { const int i = wave * 8 + q, tok = bx * 32 + (i >> 1), dest = li[32 + i];
                  const u32x4* s = (const u32x4*)((const unsigned char*)x1b + (size_t)tok * DM * EB); u32x4* d = (u32x4*)((unsigned char*)XG + (size_t)dest * DM * EB);
#pragma unroll
                  for (int jj = 0; jj < 2 * EB; ++jj) d[lane + 64 * jj] = s[lane + 64 * jj]; }
              __syncthreads(); }
            PHASE_END
            PHASE_BEGIN(pb + 8, 11)
            { SchedMoe S{G, bx, 2 * DFE / 256, tiles, (const char*)XG, (const char*)(ws + wsm::EXP1), (size_t)256 * DM * EB, (size_t)256 * DM * EB, wsm::SZ_EXP1};
              epi::EpiSwiglu<FF8> E{ACTM, DFE, rowrstd, 1, FF8 ? 1.f / WS1 : 1.f};
              pg8::gemm_phase(lds, DM * EB, S, E); }
            PHASE_END
            PHASE_BEGIN(pb + 9, 12)
            { epi::EpiMoe2<FF8> E{YB, rowgate, FF8 ? 1.f / WS2 : 1.f, (bf16_t*)(ws + wsm::YBX)};
              { SchedMoe2Main S{G, bx, tiles, (const char*)ACTM, (const char*)(ws + wsm::EXP2), (size_t)256 * DFE * EB, (size_t)256 * DFE * EB, wsm::SZ_EXP2};
                pg8::gemm_phase(lds, DFE * EB, S, E); }
              { SchedMoe2Tail S{G, bx, tiles, (const char*)ACTM, (const char*)(ws + wsm::EXP2), (size_t)256 * DFE * EB, (size_t)256 * DFE * EB, wsm::SZ_EXP2, (size_t)DFE * EB / 4};
                pg8::gemm_phase(lds, DFE * EB, S, E, DFE * EB / 128 / 4); } }
            PHASE_END
            PHASE_BEGIN(pb + 10, 13)
            { for (int tok = gw; tok < NT; tok += ngw) { const int d0 = tokdest[tok * 2], d1 = tokdest[tok * 2 + 1]; float sq = 0.f;
#pragma unroll
                  for (int j = 0; j < 4; ++j) { const size_t o = (size_t)tok * DM + (lane + 64 * j) * 8; f32x4 x0, x1, p0, p1, q0, q1; epi::unpack8(*(const u32x4*)(XR + o), x0, x1);
                      epi::unpack8(*(const u32x4*)(YB + (size_t)d0 * DM + (lane + 64 * j) * 8), p0, p1); epi::unpack8(*(const u32x4*)(YB + (size_t)d1 * DM + (lane + 64 * j) * 8), q0, q1);
                      x0 += p0 + q0; x1 += p1 + q1;
#pragma unroll
                      for (int dd = 0; dd < 2; ++dd) { const int d = dd ? d1 : d0; if (d >= 16384) {
#pragma unroll
                          for (int s = 0; s < 3; ++s) { epi::unpack8(*(const u32x4*)((const bf16_t*)(ws + wsm::YBX) + ((size_t)s * 2048 + (d - 16384)) * DM + (lane + 64 * j) * 8), p0, p1); x0 += p0; x1 += p1; } } } *(u32x4*)(XR + o) = epi::pack8(x0, x1);
                      const float* gp = a.in[28] + DM + (lane + 64 * j) * 8; const f32x4 y0 = x0 * *(const f32x4*)gp, y1 = x1 * *(const f32x4*)(gp + 4);
                      if constexpr (F8P) *(u32x2*)((unsigned char*)x2b + o) = (u32x2){pk4_fp8(y0[0], y0[1], y0[2], y0[3]), pk4_fp8(y1[0], y1[1], y1[2], y1[3])}; else *(u32x4*)(x2b + o) = epi::pack8(y0, y1);
                      sq += epi::sum8sq(x0, x1); }
                  sq = wave_sum(sq); if (lane == 0) ssx2[tok] = epi::ss_fix(sq); } }
            PHASE_END
        }

        PHASE_BEGIN(pb + 11, 14)
        { constexpr bool PF8 = (l == 1) && F8P; constexpr int PEB = PF8 ? 1 : 2;
          pg8::SchedGrid S{NT / 256, DM / 256, G, bx, 0, (const char*)x2b, (const char*)(wl + wsm::O_PLEG), (size_t)256 * DM * PEB};
          epi::EpiPle<PF8, (l == 1)> E{XR, dum ? (void*)MRGF : (l ? (void*)a.out : (void*)XR), dum ? SSMY : (l ? nullptr : XBB), ssx2, dum ? ssbase + 8 * NT : (l ? nullptr : ssx3), PP, a.in[2] + DM, PF8 ? 1.f / WS1 : 1.f};
          pg8::gemm_phase(lds, DM * PEB, S, E); }
        PHASE_END

    }
#undef PHASE_BEGIN
#undef PHASE_END
}

extern "C" void kernel_launch(void* const* d_in, const int* in_sizes, int n_in, void* d_out, int out_size, void* d_ws, size_t ws_size, hipStream_t stream) {
    static int grid = 0;
    if (grid == 0) {
        if (n_in != 31 || out_size != NT * DM || ws_size < wsm::END) { fprintf(stderr, "kernel_launch: shape/workspace mismatch (n_in %d out %d ws %zu need %zu)\n", n_in, out_size, ws_size, (size_t)wsm::END); grid = -1; return; }
        int dev = 0, cus = 0, per_cu = 0;
        if (hipGetDevice(&dev) != hipSuccess || hipDeviceGetAttribute(&cus, hipDeviceAttributeMultiprocessorCount, dev) != hipSuccess) { grid = -1; return; }
        if (hipFuncSetAttribute((const void*)mk_fwd, hipFuncAttributeMaxDynamicSharedMemorySize, LDS_BYTES) != hipSuccess) { fprintf(stderr, "kernel_launch: hipFuncSetAttribute failed\n"); grid = -1; return; }
        if (hipOccupancyMaxActiveBlocksPerMultiprocessor(&per_cu, (const void*)mk_fwd, NWAVES * 64, LDS_BYTES) != hipSuccess || per_cu < 1) { fprintf(stderr, "kernel_launch: occupancy query says %d\n", per_cu); }
        (void)hipGetLastError();
        grid = cus;
        if (grid != 256) { fprintf(stderr, "kernel_launch: built for 256 CUs, got %d\n", grid); grid = -1; return; }
    }
    if (grid < 0) return;
    (void)hipMemsetAsync((char*)d_ws + wsm::CTL, 0, wsm::CTL_BYTES, stream);
    Args a{};
    for (int i = 0; i < 31; ++i) a.in[i] = (const float*)d_in[i];
    a.out = (float*)d_out; a.ws = (unsigned char*)d_ws;
#ifndef MK_ONE_LAUNCH
#define MK_ONE_LAUNCH 0
#endif
    if (MK_ONE_LAUNCH) { a.ph_lo = 0; a.ph_hi = N_PHASES; hipLaunchKernelGGL(mk_fwd, dim3(grid), dim3(NWAVES * 64), LDS_BYTES, stream, a); }
    else for (int ph = 0; ph < N_PHASES; ++ph) { if (ph >= 9 && ph <= 11) continue;
        a.ph_lo = ph; a.ph_hi = ph + 1; hipLaunchKernelGGL(mk_fwd, dim3(grid), dim3(NWAVES * 64), LDS_BYTES, stream, a); }
}
```

```cpp
#include <hip/hip_runtime.h>
#include <stdint.h>
#include <stdio.h>
#ifndef MK_ONE_LAUNCH
#define MK_ONE_LAUNCH 1
#endif

#define LAS __attribute__((address_space(3)))
typedef unsigned short bf16_t;
typedef short bf16x8 __attribute__((ext_vector_type(8)));
typedef short s16x4 __attribute__((ext_vector_type(4)));
typedef float f32x2 __attribute__((ext_vector_type(2)));
typedef float f32x4 __attribute__((ext_vector_type(4)));
typedef float f32x16 __attribute__((ext_vector_type(16)));
typedef unsigned u32x2 __attribute__((ext_vector_type(2)));
typedef unsigned u32x4 __attribute__((ext_vector_type(4)));
typedef int i32x4 __attribute__((ext_vector_type(4)));
typedef int i32x8 __attribute__((ext_vector_type(8)));
#ifndef MK_FP8
#define MK_FP8 1
#endif

constexpr int NB = 2, SEQ = 4096, NT = 8192, DM = 2048, NIN = 10752, DFF = 5632, DFE = 7168, NEXP = 8, PLED = 256;
constexpr int C_K = 1024, C_V = 1280, C_U = 1536, C_ZU = 2560, C_ZV = 3584, C_G = 4608;
constexpr float EPS = 1e-6f;
constexpr int CAPROWS = 72 * 256;

__device__ __forceinline__ unsigned cvt_pk_bf16(float lo, float hi) { unsigned r; asm volatile("v_cvt_pk_bf16_f32 %0, %1, %2" : "=v"(r) : "v"(lo), "v"(hi)); return r; }
__device__ __forceinline__ float bf_lo(unsigned w) { return __uint_as_float(w << 16); }
__device__ __forceinline__ float bf_hi(unsigned w) { return __uint_as_float(w & 0xffff0000u); }
__device__ __forceinline__ float bf2f(bf16_t b) { return __uint_as_float((unsigned)b << 16); }
__device__ __forceinline__ bf16_t f2bf(float f) { return (bf16_t)(cvt_pk_bf16(f, 0.f) & 0xffffu); }
__device__ __forceinline__ float sigm(float x) { return __builtin_amdgcn_rcpf(1.f + __builtin_amdgcn_exp2f(-1.4426950408889634f * x)); }
__device__ __forceinline__ float gelu_t(float x) { const float u = 0.7978845608028654f * (x + 0.044715f * x * x * x); return x * sigm(2.f * u); }
__device__ __forceinline__ float wave_sum(float v) {
#pragma unroll
    for (int o = 1; o < 64; o <<= 1) v += __shfl_xor(v, o);
    return v;
}
__device__ __forceinline__ unsigned pk4_fp8(float a, float b, float c, float d) { int w = 0; w = __builtin_amdgcn_cvt_pk_fp8_f32(a, b, w, false); w = __builtin_amdgcn_cvt_pk_fp8_f32(c, d, w, true); return (unsigned)w; }
#define LDS_WAIT() asm volatile("s_waitcnt lgkmcnt(0)" ::: "memory")
#define VM_WAIT() asm volatile("s_waitcnt vmcnt(0)" ::: "memory")

namespace pg8 {
#ifndef MK_WGM
#define MK_WGM 8
#endif
constexpr int BM = 256, BK = 64, HALF = 128, HTB = HALF * BK * 2, STAGE_BYTES = 8 * HTB, NXCD = 8, WGM = MK_WGM;
__host__ __device__ __forceinline__ int lds_byte(int r, int c) { const int st = (r >> 4) * 2 + (c >> 5), rr = r & 15, cc = c & 31, ob = rr * 64 + cc * 2; return st * 1024 + (ob ^ (((ob >> 9) & 1) << 5)); }
__host__ __device__ __forceinline__ void stage_rc(int b, int& R, int& C) { const int st = b / 1024, sb = b % 1024, swz = sb ^ (((sb >> 9) & 1) << 5); R = (st >> 1) * 16 + swz / 64; C = (st & 1) * 32 + (swz % 64) / 2; }
__host__ __device__ __forceinline__ int perm32(int rho) { const int n = rho >> 4, i = rho & 15; return 8 * (i >> 2) + 4 * n + (i & 3); }

struct Unit { const char* A; const char* B; int pm, pn, z; };

__device__ __forceinline__ void tile_of(int wgid, int nM, int nN, int& pm, int& pn, const int WGM = pg8::WGM) {
    const int nwg = nM * nN; { const int q = nwg / NXCD, r = nwg % NXCD, xcd = wgid % NXCD, off = wgid / NXCD; wgid = (xcd < r ? xcd * (q + 1) : r * (q + 1) + (xcd - r) * q) + off; }
    const int nig = WGM * nN, gid = wgid / nig, fm = gid * WGM, gsz = (nM - fm) < WGM ? (nM - fm) : WGM;
    pm = fm + ((wgid % nig) % gsz); pn = (wgid % nig) / gsz;
}
struct SchedGrid {
    int nM, nN, G, c, z; const char* A0; const char* B0; size_t tstep; int wgm = WGM;
    __device__ __forceinline__ bool next(int i, Unit& u) const {
        const long Lx = (long)i * G + c; if (Lx >= (long)nM * nN) return false;
        tile_of((int)Lx, nM, nN, u.pm, u.pn, wgm); u.A = A0 + (size_t)u.pm * tstep; u.B = B0 + (size_t)u.pn * tstep; u.z = z; return true;
    }
};

#ifndef MK_SP2
#define MK_SP2 true
#endif
#ifndef MK_ALIGN
#define MK_ALIGN true
#endif
template <class Epi, class Sched, bool ALIGN_EPI = MK_ALIGN, bool SP2 = MK_SP2>
__device__ __forceinline__ void gemm_phase(LAS unsigned char* lds, const int RBc  , const Sched& S, const Epi& E, const int ntc = 0  ) {
    const int tid = threadIdx.x, wid = __builtin_amdgcn_readfirstlane(tid >> 6), lane = tid & 63, wr = wid >> 2, wc = wid & 3, fr = lane & 15, fq = lane >> 4;
    int RB = RBc; asm volatile("" : "+s"(RB));
    const int nt = ntc ? ntc : RB / 128;
    unsigned voffA[2], voffB[2];
#pragma unroll
    for (int i = 0; i < 2; ++i) { int R, C; stage_rc(tid * 16 + i * 8192, R, C); const int Rb = Epi::PERM ? ((R & ~31) + perm32(R & 31)) : R;
        voffA[i] = (unsigned)(R * RB + C * 2); voffB[i] = (unsigned)(Rb * RB + C * 2); }
    const size_t kstep = (size_t)(BK * 2);
    const size_t hstep = (size_t)HALF * RB;
    const unsigned ldsw = (unsigned)wid * 1024u;
    const int aoff = lds_byte(wr * 64 + fr, fq * 8), boff = lds_byte(wc * 32 + fr, fq * 8);
#define PG8_SA(b, h) (((b) * 2 + (h)) * HTB)
#define PG8_SB(b, h) ((4 + (b) * 2 + (h)) * HTB)
#define PG8_STAGE(bufoff, gbase, voff) do { _Pragma("unroll") for (int _i = 0; _i < 2; ++_i) \
        __builtin_amdgcn_global_load_lds((const unsigned*)((const char*)(gbase) + (voff)[_i]), (LAS unsigned*)(lds + (bufoff) + ldsw + _i * 8192), 16, 0, 0); } while (0)
#define PG8_LD8(addr) __builtin_shufflevector(*(const LAS i32x4*)(addr), *(const LAS i32x4*)((addr) + 1024), 0, 1, 2, 3, 4, 5, 6, 7)
#define PG8_LDA(dst, b, h) do { _Pragma("unroll") for (int m = 0; m < 4; ++m) dst[m] = PG8_LD8(lds + PG8_SA(b, h) + aoff + m * 2048); } while (0)
#define PG8_LDB(dst, b, h) do { _Pragma("unroll") for (int n = 0; n < 2; ++n) dst[n] = PG8_LD8(lds + PG8_SB(b, h) + boff + n * 2048); } while (0)
#define PG8_H0(x) __builtin_bit_cast(bf16x8, __builtin_shufflevector(x, x, 0, 1, 2, 3))
#define PG8_H1(x) __builtin_bit_cast(bf16x8, __builtin_shufflevector(x, x, 4, 5, 6, 7))
#define PG8_MMA(ai, bj, At, Bt) do { __builtin_amdgcn_s_setprio(1); _Pragma("unroll") for (int m = 0; m < 4; ++m) _Pragma("unroll") for (int n = 0; n < 2; ++n) { \
        if constexpr (Epi::F8) asm volatile("v_mfma_f32_16x16x128_f8f6f4 %0, %1, %2, %0" : "+v"(acc[ai][bj][m][n]) : "v"(Bt[n]), "v"(At[m])); \
        else { acc[ai][bj][m][n] = __builtin_amdgcn_mfma_f32_16x16x32_bf16(PG8_H0(Bt[n]), PG8_H0(At[m]), acc[ai][bj][m][n], 0, 0, 0); \
               acc[ai][bj][m][n] = __builtin_amdgcn_mfma_f32_16x16x32_bf16(PG8_H1(Bt[n]), PG8_H1(At[m]), acc[ai][bj][m][n], 0, 0, 0); } } \
        if constexpr (Epi::F8) asm volatile("s_nop 7" ::: "memory");     \
        __builtin_amdgcn_s_setprio(0); } while (0)
#define PG8_WAIT_V(n) asm volatile("s_waitcnt vmcnt(" #n ")" ::: "memory")
#define PG8_WAIT_L(n) asm volatile("s_waitcnt lgkmcnt(" #n ")" ::: "memory")
#define PG8_BAR __builtin_amdgcn_s_barrier()
#define PG8_SCHED __builtin_amdgcn_sched_barrier(0)
    Unit cur, nxt; int ui = 0;
    if (!S.next(0, cur)) return;
    f32x4 acc[2][2][4][2];
#pragma unroll
    for (int a = 0; a < 2; ++a)
#pragma unroll
        for (int b = 0; b < 2; ++b)
#pragma unroll
            for (int m = 0; m < 4; ++m)
#pragma unroll
                for (int n = 0; n < 2; ++n) acc[a][b][m][n] = (f32x4){0.f, 0.f, 0.f, 0.f};
    i32x8 At[4], B0[2], B1[2];
    const char* cA = cur.A; const char* cB = cur.B;
    if constexpr (SP2) {
        PG8_STAGE(PG8_SB(0, 0), cB, voffB); PG8_STAGE(PG8_SB(0, 1), cB + hstep, voffB); PG8_STAGE(PG8_SA(0, 0), cA, voffA); PG8_STAGE(PG8_SA(0, 1), cA + hstep, voffA);
        if (wr == 1) PG8_BAR;
        PG8_WAIT_V(2); PG8_BAR;
        PG8_STAGE(PG8_SB(1, 0), cB + kstep, voffB); PG8_STAGE(PG8_SA(1, 0), cA + kstep, voffA); PG8_STAGE(PG8_SB(1, 1), cB + hstep + kstep, voffB);
        PG8_WAIT_V(6); PG8_BAR;
    } else {
        PG8_STAGE(PG8_SB(0, 0), cB, voffB); PG8_STAGE(PG8_SA(0, 0), cA, voffA); PG8_STAGE(PG8_SB(0, 1), cB + hstep, voffB); PG8_STAGE(PG8_SA(0, 1), cA + hstep, voffA);
        if (wr == 1) PG8_BAR;
        PG8_WAIT_V(4); PG8_BAR;
        PG8_STAGE(PG8_SB(1, 0), cB + kstep, voffB); PG8_STAGE(PG8_SA(1, 0), cA + kstep, voffA); PG8_STAGE(PG8_SB(1, 1), cB + hstep + kstep, voffB);
        PG8_WAIT_V(6); PG8_BAR;
    }
    for (;;) {
        const bool has_next = S.next(ui + 1, nxt);
        const char* nA = has_next ? nxt.A : cA; const char* nB = has_next ? nxt.B : cB;
        for (int t = 0; t < nt; t += 2) {
            const bool last = (t == nt - 2);
            const char* a1 = cA + (size_t)(t + 1) * kstep;
            const char* a2 = last ? nA : cA + (size_t)(t + 2) * kstep; const char* b2 = last ? nB : cB + (size_t)(t + 2) * kstep;
            const char* a3 = a2 + kstep; const char* b3 = b2 + kstep;
            if constexpr (SP2) {
            PG8_LDB(B0, 0, 0); PG8_LDB(B1, 0, 1); PG8_SCHED; PG8_LDA(At, 0, 0); PG8_STAGE(PG8_SA(1, 1), a1 + hstep, voffA);
            PG8_WAIT_V(8); PG8_WAIT_L(0); PG8_BAR; PG8_MMA(0, 0, At, B0); PG8_MMA(0, 1, At, B1); PG8_BAR; PG8_SCHED;
            PG8_LDA(At, 0, 1); PG8_STAGE(PG8_SB(0, 0), b2, voffB); PG8_STAGE(PG8_SB(0, 1), b2 + hstep, voffB); PG8_STAGE(PG8_SA(0, 0), a2, voffA);
            PG8_WAIT_V(8); PG8_WAIT_L(0); PG8_BAR; PG8_MMA(1, 0, At, B0); PG8_MMA(1, 1, At, B1); PG8_BAR; PG8_SCHED;
            PG8_LDB(B0, 1, 0); PG8_LDB(B1, 1, 1); PG8_SCHED; PG8_LDA(At, 1, 0); PG8_STAGE(PG8_SA(0, 1), a2 + hstep, voffA);
            PG8_WAIT_V(8); PG8_WAIT_L(0); PG8_BAR; PG8_MMA(0, 0, At, B0); PG8_MMA(0, 1, At, B1); PG8_BAR; PG8_SCHED;
            PG8_LDA(At, 1, 1); PG8_STAGE(PG8_SB(1, 0), b3, voffB); PG8_STAGE(PG8_SB(1, 1), b3 + hstep, voffB); PG8_STAGE(PG8_SA(1, 0), a3, voffA);
            PG8_WAIT_V(8); PG8_WAIT_L(0); PG8_BAR; PG8_MMA(1, 0, At, B0); PG8_MMA(1, 1, At, B1); PG8_BAR; PG8_SCHED;
            } else {
            PG8_LDB(B0, 0, 0); PG8_SCHED; PG8_LDA(At, 0, 0); PG8_STAGE(PG8_SA(1, 1), a1 + hstep, voffA);
            PG8_WAIT_L(8); PG8_BAR; PG8_WAIT_L(0); PG8_MMA(0, 0, At, B0); PG8_BAR; PG8_SCHED;
            PG8_LDB(B1, 0, 1); PG8_STAGE(PG8_SB(0, 0), b2, voffB);
            PG8_BAR; PG8_WAIT_L(0); PG8_MMA(0, 1, At, B1); PG8_BAR;
            PG8_LDA(At, 0, 1); PG8_STAGE(PG8_SA(0, 0), a2, voffA);
            PG8_BAR; PG8_WAIT_L(0); PG8_MMA(1, 0, At, B0); PG8_BAR; PG8_SCHED;
            PG8_STAGE(PG8_SB(0, 1), b2 + hstep, voffB);
            PG8_WAIT_V(6); PG8_BAR; PG8_MMA(1, 1, At, B1); PG8_BAR;
            PG8_LDB(B0, 1, 0); PG8_SCHED; PG8_LDA(At, 1, 0); PG8_STAGE(PG8_SA(0, 1), a2 + hstep, voffA);
            PG8_WAIT_L(8); PG8_BAR; PG8_WAIT_L(0); PG8_MMA(0, 0, At, B0); PG8_BAR; PG8_SCHED;
            PG8_LDB(B1, 1, 1); PG8_STAGE(PG8_SB(1, 0), b3, voffB);
            PG8_BAR; PG8_WAIT_L(0); PG8_MMA(0, 1, At, B1); PG8_BAR;
            PG8_LDA(At, 1, 1); PG8_STAGE(PG8_SA(1, 0), a3, voffA);
            PG8_BAR; PG8_WAIT_L(0); PG8_MMA(1, 0, At, B0); PG8_BAR; PG8_SCHED;
            PG8_STAGE(PG8_SB(1, 1), b3 + hstep, voffB);
            PG8_WAIT_V(6); PG8_BAR; PG8_MMA(1, 1, At, B1); PG8_BAR;
            }
        }
        if constexpr (ALIGN_EPI) { if (wr == 0) PG8_BAR; }
        if constexpr (Epi::F8) asm volatile("s_nop 15\n\ts_nop 15" ::: "memory");
        bool keep = false;
        if constexpr (Epi::KEEP) keep = E(acc, cur, wr, wc, fr, fq); else E(acc, cur, wr, wc, fr, fq);
        if (!has_next) break;
        if (!keep) {
#pragma unroll
        for (int a = 0; a < 2; ++a)
#pragma unroll
            for (int b = 0; b < 2; ++b)
#pragma unroll
                for (int m = 0; m < 4; ++m)
#pragma unroll
                    for (int n = 0; n < 2; ++n) acc[a][b][m][n] = (f32x4){0.f, 0.f, 0.f, 0.f};
        }
        cur = nxt; cA = nA; cB = nB; ++ui;
        if constexpr (ALIGN_EPI) { if (wr == 1) PG8_BAR; }
    }
    PG8_WAIT_V(0);
    if constexpr (!ALIGN_EPI) { if (wr == 0) PG8_BAR; }
    PG8_BAR;
#undef PG8_SA
#undef PG8_SB
#undef PG8_STAGE
#undef PG8_LD8
#undef PG8_H0
#undef PG8_H1
#undef PG8_LDA
#undef PG8_LDB
#undef PG8_MMA
#undef PG8_WAIT_V
#undef PG8_WAIT_L
#undef PG8_BAR
#undef PG8_SCHED
}
}

namespace epi {
using pg8::Unit;
typedef const f32x4 (&AccT)[2][2][4][2];
__device__ __forceinline__ u32x4 pack8(f32x4 v0, f32x4 v1) { u32x4 w; w.x = cvt_pk_bf16(v0[0], v0[1]); w.y = cvt_pk_bf16(v0[2], v0[3]); w.z = cvt_pk_bf16(v1[0], v1[1]); w.w = cvt_pk_bf16(v1[2], v1[3]); return w; }
#ifndef MK_EPI_NT
#define MK_EPI_NT 0
#endif
template <class T> __device__ __forceinline__ void est(T* p, T v) { if constexpr (MK_EPI_NT != 0) __builtin_nontemporal_store(v, p); else *p = v; }
__device__ __forceinline__ void unpack8(u32x4 w, f32x4& v0, f32x4& v1) { v0 = (f32x4){bf_lo(w.x), bf_hi(w.x), bf_lo(w.y), bf_hi(w.y)}; v1 = (f32x4){bf_lo(w.z), bf_hi(w.z), bf_lo(w.w), bf_hi(w.w)}; }
__device__ __forceinline__ unsigned q8(float g) { return (unsigned)fminf(fmaxf(g * 255.f + 0.5f, 1.f), 255.f); }
__device__ __forceinline__ unsigned pk4_u8(f32x4 v) { return q8(v[0]) | (q8(v[1]) << 8) | (q8(v[2]) << 16) | (q8(v[3]) << 24); }
__device__ __forceinline__ void unpack8_u8(u32x2 w, f32x4& v0, f32x4& v1) {
    v0 = (f32x4){(float)((w.x >> 0) & 255u), (float)((w.x >> 8) & 255u), (float)((w.x >> 16) & 255u), (float)((w.x >> 24) & 255u)};
    v1 = (f32x4){(float)((w.y >> 0) & 255u), (float)((w.y >> 8) & 255u), (float)((w.y >> 16) & 255u), (float)((w.y >> 24) & 255u)}; }
__device__ __forceinline__ float sum8sq(f32x4 a, f32x4 b) { return (a[0] * a[0] + a[1] * a[1]) + (a[2] * a[2] + a[3] * a[3]) + (b[0] * b[0] + b[1] * b[1]) + (b[2] * b[2] + b[3] * b[3]); }
typedef unsigned long long ss_t;
__device__ __forceinline__ ss_t ss_fix(float sq) { return (ss_t)(sq * 16777216.f); }
__device__ __forceinline__ float ss_val(const ss_t* ss, int row) { return (float)ss[row] * (1.f / 16777216.f); }
__device__ __forceinline__ void row_atomic(ss_t* ss, int row, float sq, int fq) { sq += __shfl_xor(sq, 16); sq += __shfl_xor(sq, 32); if (fq == 0) atomicAdd(ss + row, ss_fix(sq)); }

struct EpiBf16 { static constexpr bool PERM = true, KEEP = false, F8 = false;
    bf16_t* O; int ldc;
    __device__ __forceinline__ void operator()(AccT acc, const Unit& u, int wr, int wc, int fr, int fq) const {
        const int row0 = u.pm * 256 + wr * 64 + fr, col0 = u.pn * 256 + wc * 32 + 8 * fq;
#pragma unroll
        for (int ai = 0; ai < 2; ++ai)
#pragma unroll
            for (int m = 0; m < 4; ++m) { bf16_t* rp = O + (size_t)(row0 + ai * 128 + m * 16) * ldc + col0;
#pragma unroll
                for (int bj = 0; bj < 2; ++bj) est((u32x4*)(rp + bj * 128), (u32x4)pack8(acc[ai][bj][m][0], acc[ai][bj][m][1])); }
    }
};
struct EpiInproj { static constexpr bool PERM = true, KEEP = false, F8 = false;
    bf16_t* O; const ss_t* ss; ss_t* ssv; unsigned char* G8;
    __device__ __forceinline__ void operator()(AccT acc, const Unit& u, int wr, int wc, int fr, int fq) const {
        const int type = u.pn < 10 ? 0 : (u.pn < 14 ? 1 : (u.pn < 18 ? 2 : 3));
        const int row0 = u.pm * 256 + wr * 64 + fr, col0 = u.pn * 256 + wc * 32 + 8 * fq;
#pragma unroll
        for (int ai = 0; ai < 2; ++ai)
#pragma unroll
            for (int m = 0; m < 4; ++m) { const int row = row0 + ai * 128 + m * 16; const float r = rsqrtf(ss_val(ss, row) * (1.0f / DM) + EPS); bf16_t* rp = O + (size_t)row * NIN + col0; float sq = 0.f;
#pragma unroll
                for (int bj = 0; bj < 2; ++bj) { f32x4 v0 = acc[ai][bj][m][0] * r, v1 = acc[ai][bj][m][1] * r;
                    if (type == 1 || type == 2) {
#pragma unroll
                        for (int j = 0; j < 4; ++j) { v0[j] = gelu_t(v0[j]); v1[j] = gelu_t(v1[j]); }
                        if (type == 2) sq += sum8sq(v0, v1); }
                    if (type == 3) {
#pragma unroll
                        for (int j = 0; j < 4; ++j) { v0[j] = sigm(v0[j]); v1[j] = sigm(v1[j]); }
                        est((u32x2*)(G8 + (size_t)row * (NIN - C_G) + (col0 - C_G) + bj * 128), (u32x2)(u32x2){pk4_u8(v0), pk4_u8(v1)}); }
                    else est((u32x4*)(rp + bj * 128), (u32x4)pack8(v0, v1)); }
                if (type == 2) row_atomic(ssv, row, sq, fq); }
    }
};
struct EpiGlu { static constexpr bool PERM = true, KEEP = false, F8 = false;
    const bf16_t* ssmy; bf16_t* ssmo;
    __device__ __forceinline__ void operator()(AccT acc, const Unit& u, int wr, int wc, int fr, int fq) const {
        const int row0 = u.pm * 256 + wr * 64 + fr, col0 = u.pn * 256 + wc * 32 + 8 * fq;
#pragma unroll
        for (int ai = 0; ai < 2; ++ai)
#pragma unroll
            for (int m = 0; m < 4; ++m) { const int row = row0 + ai * 128 + m * 16;
#pragma unroll
                for (int bj = 0; bj < 2; ++bj) { const int col = col0 + bj * 128; const f32x4 a0 = acc[ai][bj][m][0], a1 = acc[ai][bj][m][1];
                    f32x4 y0, y1; unpack8(*(const u32x4*)(ssmy + (size_t)row * 1024 + col), y0, y1);
#pragma unroll
                    for (int j = 0; j < 4; ++j) { y0[j] *= sigm(a0[j]); y1[j] *= sigm(a1[j]); }
                    est((u32x4*)(ssmo + (size_t)row * 1024 + col), (u32x4)pack8(y0, y1)); } }
    }
};
struct EpiMerge { static constexpr bool PERM = true, KEEP = true, F8 = false;
    const unsigned char* G8; bf16_t* mrgb;
    __device__ __forceinline__ bool operator()(f32x4 (&acc)[2][2][4][2], const Unit& u, int wr, int wc, int fr, int fq) const {
        const int row0 = u.pm * 256 + wr * 64 + fr, col0 = u.pn * 256 + wc * 32 + 8 * fq;
        const int gc = u.z == 0 ? 0 : (u.z == 1 ? 2 : 1), gn = u.z == 0 ? 2 : 1;
#pragma unroll
        for (int ai = 0; ai < 2; ++ai)
#pragma unroll
            for (int m = 0; m < 4; ++m) { const int row = row0 + ai * 128 + m * 16;
#pragma unroll
                for (int bj = 0; bj < 2; ++bj) { const int col = col0 + bj * 128; f32x4 g0, g1; unpack8_u8(*(const u32x2*)(G8 + (size_t)row * (NIN - C_G) + gc * DM + col), g0, g1);
                    if (u.z < 2) { f32x4 h0, h1; unpack8_u8(*(const u32x2*)(G8 + (size_t)row * (NIN - C_G) + gn * DM + col), h0, h1);
#pragma unroll
                        for (int j = 0; j < 4; ++j) { g0[j] *= __builtin_amdgcn_rcpf(h0[j]); g1[j] *= __builtin_amdgcn_rcpf(h1[j]); }
                        acc[ai][bj][m][0] *= g0; acc[ai][bj][m][1] *= g1;
                    } else est((u32x4*)(mrgb + (size_t)row * DM + col), (u32x4)pack8(acc[ai][bj][m][0] * (g0 * (1.f / 255.f)), acc[ai][bj][m][1] * (g1 * (1.f / 255.f)))); } }
        return u.z < 2;
    }
};
template <bool F8IN, bool F8OUT, bool RIN16> struct EpiResid { static constexpr bool PERM = true, KEEP = false, F8 = F8IN;
    const void* Xin; bf16_t* Xout; void* XB; ss_t* ss; float ascale; const float* gain;
    __device__ __forceinline__ void operator()(AccT acc, const Unit& u, int wr, int wc, int fr, int fq) const {
        const int row0 = u.pm * 256 + wr * 64 + fr, col0 = u.pn * 256 + wc * 32 + 8 * fq;
        f32x4 gv[2][2];
#pragma unroll
        for (int bj = 0; bj < 2; ++bj) { gv[bj][0] = *(const f32x4*)(gain + col0 + bj * 128); gv[bj][1] = *(const f32x4*)(gain + col0 + bj * 128 + 4); }
#pragma unroll
        for (int ai = 0; ai < 2; ++ai)
#pragma unroll
            for (int m = 0; m < 4; ++m) { const int row = row0 + ai * 128 + m * 16; float sq = 0.f;
#pragma unroll
                for (int bj = 0; bj < 2; ++bj) { const size_t o = (size_t)row * DM + col0 + bj * 128;
                    f32x4 r0, r1; if constexpr (RIN16) unpack8(*(const u32x4*)((const bf16_t*)Xin + o), r0, r1); else { r0 = *(const f32x4*)((const float*)Xin + o); r1 = *(const f32x4*)((const float*)Xin + o + 4); }
                    const f32x4 x0 = r0 + acc[ai][bj][m][0] * ascale, x1 = r1 + acc[ai][bj][m][1] * ascale;
                    est((u32x4*)(Xout + o), (u32x4)pack8(x0, x1));
                    const f32x4 y0 = x0 * gv[bj][0], y1 = x1 * gv[bj][1];
                    if constexpr (F8OUT) est((u32x2*)((unsigned char*)XB + o), (u32x2)(u32x2){pk4_fp8(y0[0], y0[1], y0[2], y0[3]), pk4_fp8(y1[0], y1[1], y1[2], y1[3])});
                    else est((u32x4*)((bf16_t*)XB + o), (u32x4)pack8(y0, y1));
                    sq += sum8sq(x0, x1); }
                row_atomic(ss, row, sq, fq); }
    }
};
template <bool F8_, bool F8OUT = F8_> struct EpiSwiglu { static constexpr bool PERM = false, KEEP = false, F8 = F8_;
    void* O; int ldo; const void* rs; int is_rstd; float ascale;
    __device__ __forceinline__ void operator()(AccT acc, const Unit& u, int wr, int wc, int fr, int fq) const {
        const int row0 = u.pm * 256 + wr * 64 + fr, col0 = u.pn * 128 + wc * 32 + 8 * fq;
#pragma unroll
        for (int ai = 0; ai < 2; ++ai)
#pragma unroll
            for (int m = 0; m < 4; ++m) { const int row = row0 + ai * 128 + m * 16; const float r = (is_rstd ? ((const float*)rs)[row] : rsqrtf(ss_val((const ss_t*)rs, row) * (1.0f / DM) + EPS)) * ascale;
                f32x4 o[2];
#pragma unroll
                for (int bj = 0; bj < 2; ++bj) { const f32x4 a = acc[ai][bj][m][0] * r, b = acc[ai][bj][m][1] * r;
#pragma unroll
                    for (int j = 0; j < 4; ++j) o[bj][j] = a[j] * sigm(a[j]) * b[j]; }
                if constexpr (F8OUT) est((u32x2*)((unsigned char*)O + (size_t)row * ldo + col0), (u32x2)(u32x2){pk4_fp8(o[0][0], o[0][1], o[0][2], o[0][3]), pk4_fp8(o[1][0], o[1][1], o[1][2], o[1][3])});
                else est((u32x4*)((bf16_t*)O + (size_t)row * ldo + col0), (u32x4)pack8(o[0], o[1])); }
    }
};
template <bool F8_, bool OUT32> struct EpiPle { static constexpr bool PERM = true, KEEP = false, F8 = F8_;
    const bf16_t* Xin; void* Xout; bf16_t* XB; const ss_t* ss_in; ss_t* ss_out; const bf16_t* pp; const float* gain; float ascale;
    __device__ __forceinline__ void operator()(AccT acc, const Unit& u, int wr, int wc, int fr, int fq) const {
        const int row0 = u.pm * 256 + wr * 64 + fr, col0 = u.pn * 256 + wc * 32 + 8 * fq;
#pragma unroll
        for (int ai = 0; ai < 2; ++ai)
#pragma unroll
            for (int m = 0; m < 4; ++m) { const int row = row0 + ai * 128 + m * 16; const float r = rsqrtf(ss_val(ss_in, row) * (1.0f / DM) + EPS) * ascale; float sq = 0.f;
#pragma unroll
                for (int bj = 0; bj < 2; ++bj) { const size_t o = (size_t)row * DM + col0 + bj * 128; f32x4 p0, p1; unpack8(*(const u32x4*)(pp + o), p0, p1);
                    f32x4 x0, x1; unpack8(*(const u32x4*)(Xin + o), x0, x1); const f32x4 a0 = acc[ai][bj][m][0] * r, a1 = acc[ai][bj][m][1] * r;
#pragma unroll
                    for (int j = 0; j < 4; ++j) { x0[j] += sigm(a0[j]) * p0[j]; x1[j] += sigm(a1[j]) * p1[j]; }
                    if constexpr (OUT32) { est((f32x4*)((float*)Xout + o), (f32x4)x0); est((f32x4*)((float*)Xout + o + 4), (f32x4)x1); } else est((u32x4*)((bf16_t*)Xout + o), (u32x4)pack8(x0, x1));
                    if (XB) *(u32x4*)(XB + o) = pack8(x0 * *(const f32x4*)(gain + col0 + bj * 128), x1 * *(const f32x4*)(gain + col0 + bj * 128 + 4)); sq += sum8sq(x0, x1); }
                if (ss_out) row_atomic(ss_out, row, sq, fq); }
    }
};
template <bool F8_> struct EpiMoe2 { static constexpr bool PERM = true, KEEP = false, F8 = F8_;
    bf16_t* YB; const float* row_gate; float ascale; bf16_t* YBX;
    __device__ __forceinline__ void operator()(AccT acc, const Unit& u, int wr, int wc, int fr, int fq) const {
        const int row0 = u.pm * 256 + wr * 64 + fr, col0 = u.pn * 256 + wc * 32 + 8 * fq;
#pragma unroll
        for (int ai = 0; ai < 2; ++ai)
#pragma unroll
            for (int m = 0; m < 4; ++m) { const int row = row0 + ai * 128 + m * 16; const float g = row_gate[row] * ascale; bf16_t* rp = (u.z == 0 ? YB + (size_t)row * DM : YBX + ((size_t)(u.z - 1) * 2048 + (row - 16384)) * DM) + col0;
#pragma unroll
                for (int bj = 0; bj < 2; ++bj) est((u32x4*)(rp + bj * 128), (u32x4)pack8(acc[ai][bj][m][0] * g, acc[ai][bj][m][1] * g)); }
    }
};
}

namespace attn {
constexpr int D = 128, NW = 8, QBLK = 32, KVBLK = 64;
constexpr float SCALE = 0.088388347648318440f;
constexpr float THR = 8.f;
constexpr int LDQ = 1024, LDK = 256, LDV = 256, LDO = 1024;
constexpr size_t SHM_V = KVBLK * D * 2, SHM_K = KVBLK * D * 2, SHM_ATTN = 2 * SHM_V + 2 * SHM_K + NW * 64 * 4;
#define KSWZ(row, colB) ((row) * 256 + ((colB) ^ (((row) & 7) << 4)))
#define SBAR() __builtin_amdgcn_sched_barrier(0)
__device__ __forceinline__ int crow(int r, int hi) { return (r & 3) + 8 * (r >> 2) + 4 * hi; }
__device__ __forceinline__ void partialSM(f32x16& p0, f32x16& p1, float& m_reg, float& mn, float& alpha) {
  constexpr float C = SCALE * 1.4426950408889634f;
  float pmax = p0[0]; for (int r = 1; r < 16; ++r) pmax = fmaxf(pmax, p0[r]); for (int r = 0; r < 16; ++r) pmax = fmaxf(pmax, p1[r]);
  { auto rr = __builtin_amdgcn_permlane32_swap(__float_as_uint(pmax), __float_as_uint(pmax), false, false);
    pmax = fmaxf(__uint_as_float(rr[0]), __uint_as_float(rr[1])); }
  if (__builtin_expect(__all(pmax - m_reg <= THR / SCALE), 1)) { mn = m_reg; alpha = 1.f; }
  else { mn = fmaxf(m_reg, pmax); alpha = __builtin_amdgcn_exp2f((m_reg - mn) * C); m_reg = mn; }
  float mnC = -mn * C;
  for (int r = 0; r < 16; ++r) p0[r] = fmaf(p0[r], C, mnC); for (int r = 0; r < 16; ++r) p1[r] = fmaf(p1[r], C, mnC);
  for (int r = 0; r < 16; ++r) p0[r] = __builtin_amdgcn_exp2f(p0[r]);
}
__device__ __forceinline__ void finishSM(f32x16& p0, f32x16& p1, float alpha, float& l_reg, bf16x8& pa0, bf16x8& pa1, bf16x8& pa2, bf16x8& pa3) {
  for (int r = 0; r < 16; ++r) p1[r] = __builtin_amdgcn_exp2f(p1[r]);
  float ps = 0; for (int r = 0; r < 16; ++r) ps += p0[r]; for (int r = 0; r < 16; ++r) ps += p1[r];
  { auto rr = __builtin_amdgcn_permlane32_swap(__float_as_uint(ps), __float_as_uint(ps), false, false);
    ps = __uint_as_float(rr[0]) + __uint_as_float(rr[1]); }
  l_reg = l_reg * alpha + ps;
#define PK4(P, BASE, OUT) do { unsigned a0 = cvt_pk_bf16(P[BASE + 0], P[BASE + 1]), a1 = cvt_pk_bf16(P[BASE + 2], P[BASE + 3]);   \
    unsigned b0 = cvt_pk_bf16(P[BASE + 4], P[BASE + 5]), b1 = cvt_pk_bf16(P[BASE + 6], P[BASE + 7]);                              \
    auto r0 = __builtin_amdgcn_permlane32_swap(a0, b0, false, false); auto r1 = __builtin_amdgcn_permlane32_swap(a1, b1, false, false); \
    u32x4 w = {r0[0], r1[0], r0[1], r1[1]}; OUT = *reinterpret_cast<bf16x8*>(&w); } while (0)
  PK4(p0, 0, pa0); PK4(p0, 8, pa1); PK4(p1, 0, pa2); PK4(p1, 8, pa3);
#undef PK4
}
__device__ __forceinline__ void qkt(f32x16& p0, f32x16& p1, const bf16_t* Ks, const bf16x8* qr, int r32, int hi) {
  p0 = f32x16{}; p1 = f32x16{};
  for (int d0 = 0; d0 < 8; ++d0) { int cb = (d0 * 16 + hi * 8) * 2;
    bf16x8 b0 = *reinterpret_cast<const bf16x8*>((const char*)Ks + KSWZ(r32, cb));
    bf16x8 b1 = *reinterpret_cast<const bf16x8*>((const char*)Ks + KSWZ(32 + r32, cb));
    p0 = __builtin_amdgcn_mfma_f32_32x32x16_bf16(b0, qr[d0], p0, 0, 0, 0);
    p1 = __builtin_amdgcn_mfma_f32_32x32x16_bf16(b1, qr[d0], p1, 0, 0, 0); }
}
__device__ __forceinline__ int v_st(int k, int c) { const int kk = (k & ~0xC) | ((k & 4) << 1) | ((k & 8) >> 1); return ((kk >> 3) * 4 + (c >> 5)) * 512 + ((kk & 7) * 32 + (c & 31)) * 2; }
__device__ __forceinline__ int v_rd_base(int lane) { return ((lane & 3) << 3) | (((lane >> 2) & 3) << 6) | (((lane >> 4) & 1) << 5) | (((lane >> 5) & 1) << 8); }
constexpr int v_rd_off(int d0, int ks, int half) { return d0 * 512 + ks * 4096 + half * 2048; }
template <int OFF> __device__ __forceinline__ s16x4 tr_read(int vb) {
  s16x4 r; asm volatile("ds_read_b64_tr_b16 %0, %1 offset:%2" : "=&v"(r) : "v"(vb), "i"(OFF) : "memory"); return r;
}
template <int D0> __device__ __forceinline__ void pv_one(f32x16& od, int vb, bf16x8 pa0, bf16x8 pa1, bf16x8 pa2, bf16x8 pa3) {
  const s16x4 l0 = tr_read<v_rd_off(D0, 0, 0)>(vb), h0 = tr_read<v_rd_off(D0, 0, 1)>(vb), l1 = tr_read<v_rd_off(D0, 1, 0)>(vb), h1 = tr_read<v_rd_off(D0, 1, 1)>(vb);
  const s16x4 l2 = tr_read<v_rd_off(D0, 2, 0)>(vb), h2 = tr_read<v_rd_off(D0, 2, 1)>(vb), l3 = tr_read<v_rd_off(D0, 3, 0)>(vb), h3 = tr_read<v_rd_off(D0, 3, 1)>(vb);
  asm volatile("s_waitcnt lgkmcnt(0)" ::: "memory"); SBAR();
#define PK(L, H) (bf16x8){L[0], L[1], L[2], L[3], H[0], H[1], H[2], H[3]}
  od = __builtin_amdgcn_mfma_f32_32x32x16_bf16(pa0, PK(l0, h0), od, 0, 0, 0);
  od = __builtin_amdgcn_mfma_f32_32x32x16_bf16(pa1, PK(l1, h1), od, 0, 0, 0);
  od = __builtin_amdgcn_mfma_f32_32x32x16_bf16(pa2, PK(l2, h2), od, 0, 0, 0);
  od = __builtin_amdgcn_mfma_f32_32x32x16_bf16(pa3, PK(l3, h3), od, 0, 0, 0);
#undef PK
}
__device__ __forceinline__ void pv_d0(f32x16* o, int vb, bf16x8 pa0, bf16x8 pa1, bf16x8 pa2, bf16x8 pa3) {
  pv_one<0>(o[0], vb, pa0, pa1, pa2, pa3); pv_one<1>(o[1], vb, pa0, pa1, pa2, pa3); pv_one<2>(o[2], vb, pa0, pa1, pa2, pa3); pv_one<3>(o[3], vb, pa0, pa1, pa2, pa3);
}
__device__ __forceinline__ void attn_dense_body(const bf16_t* __restrict__ Qb, const bf16_t* __restrict__ Kh, const bf16_t* __restrict__ Vh, bf16_t* __restrict__ Ob, int seq, char* lds) {
  constexpr int SDEPTH = 2;
  const int tid = threadIdx.x, wid = tid >> 6, lane = tid & 63, r32 = lane & 31, hi = lane >> 5;
  bf16_t* V_lds = (bf16_t*)lds; bf16_t* K_lds = (bf16_t*)(lds + 2 * SHM_V);
  float* ws = (float*)(lds + 2 * SHM_V + 2 * SHM_K) + wid * 64; float* li_l = ws; float* al_l = ws + 32;
  float m_reg = -1e30f, l_reg = 0; f32x16 o[4] = {}; bf16x8 qr[8];
  const bf16_t* Qw = Qb + (long)(wid * QBLK + r32) * LDQ + hi * 8;
#pragma unroll
  for (int d0 = 0; d0 < 8; ++d0) qr[d0] = *reinterpret_cast<const bf16x8*>(Qw + d0 * 16);
  const int sr = tid >> 4, sc = (tid & 15) * 8, vst0 = v_st(sr, sc), vst1 = v_st(32 + sr, sc);
  const int vb0 = (int)(uintptr_t)V_lds + v_rd_base(lane);
  struct { bf16x8 vs0, vs1, ks0, ks1; } sr_[SDEPTH];
#define SLOAD(i, k0) do { sr_[i].vs0 = *reinterpret_cast<const bf16x8*>(&Vh[(long)((k0) + sr) * LDV + sc]); sr_[i].vs1 = *reinterpret_cast<const bf16x8*>(&Vh[(long)((k0) + 32 + sr) * LDV + sc]); \
    sr_[i].ks0 = *reinterpret_cast<const bf16x8*>(&Kh[(long)((k0) + sr) * LDK + sc]); sr_[i].ks1 = *reinterpret_cast<const bf16x8*>(&Kh[(long)((k0) + 32 + sr) * LDK + sc]); } while (0)
#define SWRITE(b, i) do { *(bf16x8*)((char*)V_lds + (b) * SHM_V + vst0) = sr_[i].vs0;          \
    *(bf16x8*)((char*)V_lds + (b) * SHM_V + vst1) = sr_[i].vs1; int kc = sc * 2;               \
    *(bf16x8*)((char*)K_lds + (b) * SHM_K + KSWZ(sr, kc)) = sr_[i].ks0;                       \
    *(bf16x8*)((char*)K_lds + (b) * SHM_K + KSWZ(32 + sr, kc)) = sr_[i].ks1; } while (0)
#define SWAIT() do { asm volatile("s_waitcnt vmcnt(4)" ::: "memory"); } while (0)
#define RESC(a) do { if (__any((a) < 1.f)) { if (hi == 0) al_l[r32] = (a); asm volatile("s_waitcnt lgkmcnt(0)" ::: "memory"); \
    for (int d = 0; d < 4; ++d) for (int r = 0; r < 16; ++r) o[d][r] *= al_l[crow(r, hi)]; } } while (0)
  f32x16 pA0, pA1, pB0, pB1; float mnA, mnB, alA, alB; bf16x8 pa0, pa1, pa2, pa3; const int NTL = seq / KVBLK;
  constexpr int SE = 0, SO = SDEPTH - 1;
  SLOAD(SE, 0); asm volatile("s_waitcnt vmcnt(0)" ::: "memory"); SWRITE(0, SE); __syncthreads();
  qkt(pA0, pA1, K_lds, qr, r32, hi); partialSM(pA0, pA1, m_reg, mnA, alA);
  SLOAD(SO, KVBLK); if (2 < NTL) SLOAD(SE, 2 * KVBLK);
  SWAIT(); SWRITE(1, SO); __syncthreads();
  for (int j = 1; j + 1 < NTL; j += 2) {
    SBAR(); qkt(pB0, pB1, (bf16_t*)((char*)K_lds + SHM_K), qr, r32, hi);
    finishSM(pA0, pA1, alA, l_reg, pa0, pa1, pa2, pa3); SBAR();
    SLOAD(SO, (j + SDEPTH) * KVBLK); SBAR();
    pv_d0(o, vb0, pa0, pa1, pa2, pa3); partialSM(pB0, pB1, m_reg, mnB, alB);
    __syncthreads(); SWAIT(); SWRITE(0, SE);
    RESC(alB); __syncthreads();
    SBAR(); qkt(pA0, pA1, K_lds, qr, r32, hi);
    finishSM(pB0, pB1, alB, l_reg, pa0, pa1, pa2, pa3); SBAR();
    if (j + 3 < NTL) SLOAD(SE, (j + 1 + SDEPTH) * KVBLK); SBAR();
    pv_d0(o, vb0 + (int)SHM_V, pa0, pa1, pa2, pa3); partialSM(pA0, pA1, m_reg, mnA, alA);
    __syncthreads(); SWAIT(); SWRITE(1, SO);
    RESC(alA); __syncthreads();
  }
  SBAR(); qkt(pB0, pB1, (bf16_t*)((char*)K_lds + SHM_K), qr, r32, hi);
  finishSM(pA0, pA1, alA, l_reg, pa0, pa1, pa2, pa3); SBAR();
  pv_d0(o, vb0, pa0, pa1, pa2, pa3); partialSM(pB0, pB1, m_reg, mnB, alB);
  __syncthreads(); RESC(alB);
  finishSM(pB0, pB1, alB, l_reg, pa0, pa1, pa2, pa3); SBAR();
  pv_d0(o, vb0 + (int)SHM_V, pa0, pa1, pa2, pa3);
  if (hi == 0) li_l[r32] = l_reg; asm volatile("s_waitcnt lgkmcnt(0)" ::: "memory");
  float rli[16];
#pragma unroll
  for (int r = 0; r < 16; ++r) rli[r] = __builtin_amdgcn_rcpf(li_l[crow(r, hi)]);
  bf16_t* Ow = Ob + (long)(wid * QBLK) * LDO;
#pragma unroll
  for (int r = 0; r < 16; ++r) { int orow = crow(r, hi);
    for (int d0 = 0; d0 < 4; ++d0) Ow[(long)orow * LDO + d0 * 32 + r32] = f2bf(o[d0][r] * rli[r]); }
  __syncthreads();
#undef SLOAD
#undef SWRITE
#undef SWAIT
#undef RESC
}
}

namespace wsm {
constexpr size_t KiB = 1024, MiB = 1u << 20;
constexpr size_t CTL = 0, CTL_BYTES = 1 * MiB;
constexpr int CW_BAR = 0, CW_SS = 4096;
constexpr size_t LAMB = 1 * MiB, LAMT = LAMB + 128 * KiB;
constexpr size_t BBAR = 2 * MiB;
constexpr size_t CTT = 3 * MiB;
constexpr size_t WSB = 4 * MiB;
constexpr size_t ROUTE = 5 * MiB;
constexpr size_t R_IDX = ROUTE, R_GATE = ROUTE + 64 * KiB, R_TOKDEST = ROUTE + 128 * KiB, R_ROWTOK = ROUTE + 192 * KiB, R_ROWGATE = ROUTE + 320 * KiB, R_ROWRSTD = ROUTE + 448 * KiB,
                 R_HIST = ROUTE + 576 * KiB, R_TILES = ROUTE + 600 * KiB;
constexpr size_t ESTATE = 6 * MiB;
constexpr size_t W0 = 10 * MiB;
constexpr size_t SZ_WIN = (size_t)NIN * DM * 2, SZ_GLU = (size_t)1024 * 1024 * 2, SZ_WBR = (size_t)3 * DM * 1024 * 2, SZ_WOUT = (size_t)DM * DM * 2, SZ_PLEG = (size_t)DM * DM * 2, SZ_PLEP = (size_t)DM * PLED * 2;
constexpr size_t O_WIN = 0, O_GLU = O_WIN + SZ_WIN, O_WBR = O_GLU + SZ_GLU, O_WOUT = O_WBR + SZ_WBR, O_PLEG = O_WOUT + SZ_WOUT, O_PLEP = O_PLEG + SZ_PLEG, WL = O_PLEP + SZ_PLEP;
constexpr size_t FFN1 = W0 + 2 * WL, SZ_FFN1 = (size_t)2 * DFF * DM * 2, FFN2 = FFN1 + SZ_FFN1, SZ_FFN2 = (size_t)DM * DFF * 2;
constexpr size_t EXP1 = FFN2 + SZ_FFN2, SZ_EXP1 = (size_t)2 * DFE * DM * 2  , EXP2 = EXP1 + NEXP * SZ_EXP1, SZ_EXP2 = (size_t)DM * DFE * 2  ;
constexpr size_t ACT0 = (EXP2 + NEXP * SZ_EXP2 + 255) & ~(size_t)255;
constexpr size_t XF = ACT0, XBA = XF + (size_t)NT * DM * 4, XBB = XBA + (size_t)NT * DM * 2, PB = XBB + (size_t)NT * DM * 2, PP = PB + (size_t)2 * NT * PLED * 2, UNI = PP + (size_t)NT * DM * 2;
constexpr size_t PROJ = UNI, QN = PROJ + (size_t)NT * NIN * 2, KN = QN + (size_t)NT * 1024 * 2, VN = KN + (size_t)NT * 256 * 2, ATT = VN + (size_t)NT * 256 * 2,
                 SSMY = ATT + (size_t)NT * 1024 * 2, SSMO = SSMY + (size_t)NT * 1024 * 2, MLPO = SSMO + (size_t)NT * 1024 * 2, MRGF = MLPO + (size_t)NT * 1024 * 2, MRGB = MRGF + (size_t)NT * DM * 4,
                 MIX_END = MRGB + (size_t)NT * DM * 2;
constexpr size_t ACTD = UNI;
constexpr size_t XG = UNI, ACTM = XG + (size_t)CAPROWS * DM * 2, YB = ACTM + (size_t)CAPROWS * DFE * 2, YBX = YB + (size_t)CAPROWS * DM * 2, MOE_END = YBX + (size_t)3 * 2048 * DM * 2;
constexpr size_t END = (MIX_END > MOE_END ? MIX_END : MOE_END);
static_assert(MRGB >= ACTD + (size_t)NT * DFF * 2 || true, "");
}

#define XB_TMO      128
#define XB_XCNT(j)  (256  + 64 * (j))
#define XB_XSUB(j)  (1280 + 64 * (j))
#define XB_XGEN(j)  (2304 + 64 * (j))
#define XB_TOP      3328
#define XB_TOPGEN   3392
#define XCD_BAR_WORDS 3456
#define XB_SPIN_CAP (1u << 18)
#ifndef MK_EARLY_INV
#define MK_EARLY_INV 1
#endif
__device__ __forceinline__ unsigned xb_ld(unsigned* p)              { return __hip_atomic_load(p, __ATOMIC_RELAXED, __HIP_MEMORY_SCOPE_AGENT); }
__device__ __forceinline__ unsigned xb_add(unsigned* p, unsigned v) { return __hip_atomic_fetch_add(p, v, __ATOMIC_RELAXED, __HIP_MEMORY_SCOPE_AGENT); }
__device__ __forceinline__ unsigned xb_xcc_id() { return (unsigned)__builtin_amdgcn_s_getreg((3 << 11) | 20) & 0xFu; }
#define XB_SPIN(cond, bar) do { unsigned _sp = 0; while (cond) { __builtin_amdgcn_s_sleep(1); \
    if ((++_sp & 255u) == 0u) { if (xb_ld(&(bar)[XB_TMO])) break; if (_sp > XB_SPIN_CAP) { atomicAdd(&(bar)[XB_TMO], 1u); break; } } } } while (0)
struct XcdBarrier { unsigned* bar; unsigned x; volatile LAS unsigned* st; };
__device__ __forceinline__ XcdBarrier xcd_barrier_post(unsigned* bar, volatile LAS unsigned* st) {
    XcdBarrier b; b.bar = bar; b.x = xb_xcc_id(); b.st = st;
    if (threadIdx.x == 0) (void)xb_add(&bar[XB_XCNT(b.x)], 1u);
    return b;
}
__device__ __forceinline__ void xcd_barrier_complete(unsigned* bar, unsigned x, unsigned& nloc, unsigned& nx) {
    const unsigned G = gridDim.x * gridDim.y * gridDim.z;
    unsigned sum, cnt, mine, sp = 0u;
    for (;;) {
        sum = 0u; cnt = 0u; mine = 0u;
#pragma unroll
        for (unsigned j = 0; j < 16; ++j) { const unsigned c = xb_ld(&bar[XB_XCNT(j)]); sum += c; cnt += (c > 0u) ? 1u : 0u; mine = (j == x) ? c : mine; }
        if (sum == G) break;
        __builtin_amdgcn_s_sleep(1);
        if ((++sp & 255u) == 0u) { if (xb_ld(&bar[XB_TMO])) break; if (sp > XB_SPIN_CAP) { atomicAdd(&bar[XB_TMO], 1u); break; } }
    }
    nloc = mine > 0u ? mine : 1u; nx = cnt > 0u ? cnt : 1u;
}
__device__ __forceinline__ void xcd_barrier(const XcdBarrier& b) {
    asm volatile("s_waitcnt vmcnt(0)" ::: "memory");
    __syncthreads();
    if (threadIdx.x == 0) {
        unsigned* bar = b.bar;
        __builtin_amdgcn_s_waitcnt(0);
        unsigned nloc = b.st[0], nx = b.st[1];
        if (nloc == 0u) { xcd_barrier_complete(bar, b.x, nloc, nx); b.st[0] = nloc; b.st[1] = nx; }
        const unsigned old = xb_add(&bar[XB_XSUB(b.x)], 1u);
        const unsigned gen = old / nloc;
        if (old + 1u == (gen + 1u) * nloc) {
            __builtin_amdgcn_fence(__ATOMIC_RELEASE, "agent");
            asm volatile("s_waitcnt vmcnt(0)" ::: "memory");
            const unsigned og = xb_add(&bar[XB_TOP], 1u);
            const unsigned tg = og / nx;
#if MK_EARLY_INV
            __builtin_amdgcn_fence(__ATOMIC_ACQUIRE, "agent");
            if (og + 1u == (tg + 1u) * nx) xb_add(&bar[XB_TOPGEN], 1u);
            else XB_SPIN(xb_ld(&bar[XB_TOPGEN]) == tg, bar);
#else
            if (og + 1u == (tg + 1u) * nx) xb_add(&bar[XB_TOPGEN], 1u);
            else XB_SPIN(xb_ld(&bar[XB_TOPGEN]) == tg, bar);
            __builtin_amdgcn_fence(__ATOMIC_ACQUIRE, "agent");
#endif
            xb_add(&bar[XB_XGEN(b.x)], 1u);
            asm volatile("s_waitcnt vmcnt(0)" ::: "memory");
        } else {
#if MK_EARLY_INV
            __builtin_amdgcn_fence(__ATOMIC_ACQUIRE, "agent");
            XB_SPIN(xb_ld(&bar[XB_XGEN(b.x)]) == gen, bar);
            asm volatile("s_waitcnt vmcnt(0)" ::: "memory");
#else
            XB_SPIN(xb_ld(&bar[XB_XGEN(b.x)]) == gen, bar);
            __builtin_amdgcn_fence(__ATOMIC_ACQUIRE, "agent");
            asm volatile("s_waitcnt vmcnt(0)" ::: "memory");
#endif
        }
    }
    __syncthreads();
}

namespace thin {
constexpr int NW = 8;
__device__ __forceinline__ int swi_row(int a, int s) { const int pn = a >> 7, al = a & 127, wc = al >> 5, fq = (al >> 3) & 3, bj = (al >> 2) & 1, j = al & 3; return 256 * pn + 128 * bj + 32 * wc + 16 * s + 4 * fq + j; }
#ifndef MK_LDPOL
#define MK_LDPOL(p) __builtin_nontemporal_load(p)
#endif
struct ConvRegs { f32x4 v[16]; };
struct ConvDec { const float* src; unsigned char* dst; int k0, n0; };
template <bool F8>
__device__ __forceinline__ void conv_load(ConvRegs& R, const ConvDec& d, int ldn, int lane) {
    const int kp = lane >> 4, nq = lane & 15;
    const unsigned loff = (unsigned)(((F8 ? 4 : 2) * kp * ldn + 4 * nq) * 4);
    const char* base = (const char*)(d.src + (size_t)d.k0 * ldn + d.n0);
#pragma unroll
    for (int i = 0; i < 16; ++i) { const int ru = F8 ? (16 * (i >> 2) + (i & 3)) : (8 * (i >> 1) + (i & 1));
        const char* rb = base + (size_t)ru * ldn * 4; asm volatile("" : "+s"(rb));
        R.v[i] = MK_LDPOL((const f32x4*)(rb + loff)); }
}
template <int MAP, bool F8, bool NTS = true>
__device__ __forceinline__ void conv_store(const ConvRegs& R, const ConvDec& d, int K, float wscale, int s, LAS unsigned char* scr, int lane) {
    const int kp = lane >> 4, nq = lane & 15; const int k0 = d.k0, n0 = d.n0;
    constexpr int EBY = F8 ? 1 : 2;
    if constexpr (!F8) {
#pragma unroll
        for (int i = 0; i < 8; ++i) { const int kl = 8 * i + 2 * kp;
#pragma unroll
            for (int j = 0; j < 4; ++j) *(LAS unsigned*)(scr + (4 * nq + j) * 144 + (((4 * i + kp) ^ (4 * (nq >> 1))) << 2)) = cvt_pk_bf16(R.v[2 * i][j], R.v[2 * i + 1][j]); }
    } else {
#pragma unroll
        for (int i = 0; i < 4; ++i) { const int kl = 16 * i + 4 * kp;
#pragma unroll
            for (int j = 0; j < 4; ++j) *(LAS unsigned*)(scr + (4 * nq + j) * 80 + (((4 * i + kp) ^ (4 * ((nq >> 1) & 3))) << 2)) = pk4_fp8(R.v[4 * i][j] * wscale, R.v[4 * i + 1][j] * wscale, R.v[4 * i + 2][j] * wscale, R.v[4 * i + 3][j] * wscale); }
    }
    LDS_WAIT();
    constexpr int NR = F8 ? 4 : 8, LSH = F8 ? 2 : 3, NSTEP = F8 ? 16 : 8, LROW = F8 ? 80 : 144;
    const int nl = lane >> LSH, c = lane & ((1 << LSH) - 1);
    const unsigned lrow = (unsigned)(MAP == 0 ? nl : swi_row(nl, 0));
    const unsigned soff = lrow * (unsigned)(K * EBY) + 16u * c;
    const LAS unsigned char* lsrc = scr + nl * LROW;
#pragma unroll
    for (int r = 0; r < NR; ++r) { const int key = F8 ? (((nl >> 3) + 2 * r) & 3) : r;
        const u32x4 o = *(const LAS u32x4*)(lsrc + r * NSTEP * LROW + 16 * (c ^ key));
        const int urow = MAP == 0 ? (n0 + NSTEP * r) : swi_row(n0 + NSTEP * r, s);
        if constexpr (NTS) __builtin_nontemporal_store(o, (u32x4*)(d.dst + ((size_t)urow * K + k0) * EBY + soff)); else *(u32x4*)(d.dst + ((size_t)urow * K + k0) * EBY + soff) = o;
        if (r & 1) asm volatile("" ::: "memory"); }
    LDS_WAIT();
}
template <int MAP, bool F8, bool NTS = true>
__device__ __forceinline__ void conv_group(const float* src, size_t sstr, int count, int K, int N, void* dst, size_t dstr_bytes, float wscale, int s, LAS unsigned char* scr, int gw, int ngw, int lane, int flo = 0, int fhi = 64) {
    const int nb = N / 64, ipm = (K / 64) * nb, i0 = (int)((long)count * ipm * flo / 64), total = (int)((long)count * ipm * fhi / 64);
    auto dec = [&](int it) { const int sub = it / ipm, r = it - sub * ipm, kb = r / nb, nbi = r - kb * nb;
        return ConvDec{src + (size_t)sub * sstr, (unsigned char*)dst + (size_t)sub * dstr_bytes, kb * 64, nbi * 64}; };
    int it = i0 + gw; if (it >= total) return;
    ConvRegs RA, RB, RC; ConvDec dA = dec(it), dB = dA, dC = dA; conv_load<F8>(RA, dA, N, lane);
    { const int itb = it + ngw; if (itb < total) { dB = dec(itb); conv_load<F8>(RB, dB, N, lane); } }
    for (;;) {
        { const int n2 = it + 2 * ngw; if (n2 < total) { dC = dec(n2); conv_load<F8>(RC, dC, N, lane); } }
        conv_store<MAP, F8, NTS>(RA, dA, K, wscale, s, scr, lane); it += ngw; if (it >= total) break;
        { const int n2 = it + 2 * ngw; if (n2 < total) { dA = dec(n2); conv_load<F8>(RA, dA, N, lane); } }
        conv_store<MAP, F8, NTS>(RB, dB, K, wscale, s, scr, lane); it += ngw; if (it >= total) break;
        { const int n2 = it + 2 * ngw; if (n2 < total) { dB = dec(n2); conv_load<F8>(RB, dB, N, lane); } }
        conv_store<MAP, F8, NTS>(RC, dC, K, wscale, s, scr, lane); it += ngw; if (it >= total) break;
    }
}
struct CoopRegs { f32x4 v[8]; };
__device__ __forceinline__ void coop_load(CoopRegs& R, const float* src, int ldn, int k0, int n0, int wv, int lane) {
    const int kp = lane >> 4, nq = lane & 15; const unsigned loff = (unsigned)((4 * kp * ldn + 4 * nq) * 4);
    const char* base = (const char*)(src + (size_t)(k0 + 32 * wv) * ldn + n0);
#pragma unroll
    for (int i = 0; i < 8; ++i) { const char* rb = base + (size_t)(16 * (i >> 2) + (i & 3)) * ldn * 4; asm volatile("" : "+s"(rb)); R.v[i] = MK_LDPOL((const f32x4*)(rb + loff)); }
}
template <int MAP>
__device__ __forceinline__ void coop_group(const float* src, size_t sstr, int count, int K, int N, unsigned char* dst, size_t dstr_bytes, float wscale, int s, LAS unsigned char* tl  , int cwg, int ncwg, int flo, int fhi) {
    const int tid = threadIdx.x, lane = tid & 63, wv = __builtin_amdgcn_readfirstlane(tid >> 6), kp = lane >> 4, nq = lane & 15;
    const int nb = N / 64, ipm = (K / 256) * nb, i0 = (int)((long)count * ipm * flo / 64), total = (int)((long)count * ipm * fhi / 64);
    int it = i0 + cwg; if (it >= total) return;
    CoopRegs RA, RB; int p = 0;
#define COOP_DEC(it_, srcp, dstp, k0_, n0_) const int sub_ = (it_) / ipm, r_ = (it_) - sub_ * ipm, kb_ = r_ / nb; const float* srcp = src + (size_t)sub_ * sstr; unsigned char* dstp = dst + (size_t)sub_ * dstr_bytes; const int k0_ = kb_ * 256, n0_ = (r_ - kb_ * nb) * 64
#define COOP_STORE(R, it_) do { COOP_DEC(it_, sp_, dp_, k0, n0); (void)sp_; LAS unsigned char* T = tl + p * 17408; \
        _Pragma("unroll") for (int i = 0; i < 2; ++i) _Pragma("unroll") for (int j = 0; j < 4; ++j) \
            *(LAS unsigned*)(T + (4 * nq + j) * 272 + (((8 * wv + 4 * i + kp) ^ (4 * (nq >> 1))) << 2)) = pk4_fp8(R.v[4 * i][j] * wscale, R.v[4 * i + 1][j] * wscale, R.v[4 * i + 2][j] * wscale, R.v[4 * i + 3][j] * wscale); \
        __syncthreads(); \
        const int nl = tid >> 4, ch = tid & 15; const unsigned lrow = (unsigned)(MAP == 0 ? nl : swi_row(nl, 0)); const unsigned soff = lrow * (unsigned)K + 16u * ch; \
        _Pragma("unroll") for (int r = 0; r < 2; ++r) { const int n = nl + 32 * r; const u32x4 o = *(const LAS u32x4*)(T + n * 272 + 16 * (ch ^ (n >> 3))); \
            const int urow = MAP == 0 ? (n0 + 32 * r) : swi_row(n0 + 32 * r, s); \
            __builtin_nontemporal_store(o, (u32x4*)(dp_ + (size_t)urow * K + k0 + soff)); } \
        p ^= 1; } while (0)
    { COOP_DEC(it, sp, dp, k0, n0); (void)dp; coop_load(RA, sp, N, k0, n0, wv, lane); }
    for (;;) {
        const int it1 = it + ncwg; const bool h1 = it1 < total; if (h1) { COOP_DEC(it1, sp, dp, k0, n0); (void)dp; coop_load(RB, sp, N, k0, n0, wv, lane); }
        COOP_STORE(RA, it);
        if (!h1) break;
        const int it2 = it1 + ncwg; const bool h2 = it2 < total; if (h2) { COOP_DEC(it2, sp, dp, k0, n0); (void)dp; coop_load(RA, sp, N, k0, n0, wv, lane); }
        COOP_STORE(RB, it1);
        if (!h2) break;
        it = it2;
    }
    __syncthreads();
#undef COOP_DEC
#undef COOP_STORE
}
}

namespace thin {
__device__ __forceinline__ void ssm_tables(int it, const float* lre, const float* lim, const float* ldt, const float* bre, const float* bim, const float* cre, const float* cim,
                                           float* lamb, float* lamt, bf16_t* bbar, bf16_t* ctt, int lane) {
    const int p = lane;
    const float lr = lre[it * 64 + p], li = lim[it * 64 + p], dt = __expf(ldt[it]);
    const float er = __expf(lr * dt); float sn, cs; sincosf(li * dt, &sn, &cs); const float ar = er * cs, ai = er * sn;
    const float nr = ar - 1.f, ni = ai, den = lr * lr + li * li; const float fr = (nr * lr + ni * li) / den, fi = (ni * lr - nr * li) / den;
    lamb[(it * 64 + p) * 2] = ar; lamb[(it * 64 + p) * 2 + 1] = ai;
    float tr = ar, ti = ai;
#pragma unroll
    for (int q = 0; q < 7; ++q) { const float nr2 = tr * tr - ti * ti, ni2 = 2.f * tr * ti; tr = nr2; ti = ni2; }
    lamt[(it * 64 + p) * 2] = tr; lamt[(it * 64 + p) * 2 + 1] = ti;
    bf16_t* bR = bbar + ((size_t)(it * 2 + 0) * 64 + p) * 16; bf16_t* bI = bbar + ((size_t)(it * 2 + 1) * 64 + p) * 16;
#pragma unroll
    for (int c = 0; c < 16; ++c) { const float xr = bre[(it * 64 + p) * 16 + c], xi = bim[(it * 64 + p) * 16 + c]; bR[c] = f2bf(fr * xr - fi * xi); bI[c] = f2bf(fr * xi + fi * xr); }
#pragma unroll
    for (int c = 0; c < 16; ++c) { ctt[((size_t)it * 16 + c) * 128 + 2 * p] = f2bf(cre[(it * 16 + c) * 64 + p]); ctt[((size_t)it * 16 + c) * 128 + 2 * p + 1] = f2bf(-cim[(it * 16 + c) * 64 + p]); }
}

struct BuFrags { bf16x8 r0, r1, i0, i1; };
__device__ __forceinline__ BuFrags load_bufrags(const bf16_t* bbar_dg  , int lane) {
    const int st = lane & 31, h = lane >> 5; BuFrags f;
    f.r0 = *(const bf16x8*)(bbar_dg + (size_t)(st) * 16 + 8 * h); f.r1 = *(const bf16x8*)(bbar_dg + (size_t)(32 + st) * 16 + 8 * h);
    f.i0 = *(const bf16x8*)(bbar_dg + (size_t)(64 + st) * 16 + 8 * h); f.i1 = *(const bf16x8*)(bbar_dg + (size_t)(96 + st) * 16 + 8 * h);
    return f;
}
__device__ __forceinline__ bf16x8 bu_load(const bf16_t* __restrict__ proj, int tok0, int g, int lane) { return *(const bf16x8*)(proj + (size_t)(tok0 + (lane & 31)) * NIN + C_U + g * 16 + 8 * (lane >> 5)); }
__device__ __forceinline__ void bu_block(const bf16x8 ua, const BuFrags& f, float (&BR)[32], float (&BI)[32]) {
    const f32x16 z = {};
    const f32x16 R0 = __builtin_amdgcn_mfma_f32_32x32x16_bf16(ua, f.r0, z, 0, 0, 0), R1 = __builtin_amdgcn_mfma_f32_32x32x16_bf16(ua, f.r1, z, 0, 0, 0);
    const f32x16 I0 = __builtin_amdgcn_mfma_f32_32x32x16_bf16(ua, f.i0, z, 0, 0, 0), I1 = __builtin_amdgcn_mfma_f32_32x32x16_bf16(ua, f.i1, z, 0, 0, 0);
#pragma unroll
    for (int r = 0; r < 16; ++r) {
        auto s = __builtin_amdgcn_permlane32_swap(__float_as_uint(R0[r]), __float_as_uint(R1[r]), false, false);
        BR[8 * (r >> 2) + (r & 3)] = __uint_as_float(s[0]); BR[8 * (r >> 2) + 4 + (r & 3)] = __uint_as_float(s[1]);
        auto q = __builtin_amdgcn_permlane32_swap(__float_as_uint(I0[r]), __float_as_uint(I1[r]), false, false);
        BI[8 * (r >> 2) + (r & 3)] = __uint_as_float(q[0]); BI[8 * (r >> 2) + 4 + (r & 3)] = __uint_as_float(q[1]);
    }
}
template <int DIR>
__device__ __forceinline__ void ssm_pass1_item(const bf16_t* __restrict__ proj, const float* __restrict__ lamb_l, const bf16_t* __restrict__ bbar_l, float* __restrict__ est, int b, int g, int n, int lane) {
    const int dg = DIR * 64 + g; const float ar = lamb_l[(dg * 64 + lane) * 2], ai = lamb_l[(dg * 64 + lane) * 2 + 1];
    const BuFrags f = load_bufrags(bbar_l + (size_t)dg * 2 * 64 * 16, lane);
    float sr = 0.f, si = 0.f;
    bf16x8 ua[4];
#pragma unroll
    for (int s = 0; s < 4; ++s) ua[s] = bu_load(proj, b * SEQ + n * 128 + (DIR ? 3 - s : s) * 32, g, lane);
#pragma unroll
    for (int s = 0; s < 4; ++s) { float BR[32], BI[32];
        bu_block(ua[s], f, BR, BI);
#pragma unroll
        for (int tt = 0; tt < 32; ++tt) { const int t = DIR ? 31 - tt : tt; const float nsr = fmaf(ar, sr, fmaf(-ai, si, BR[t])), nsi = fmaf(ar, si, fmaf(ai, sr, BI[t])); sr = nsr; si = nsi; } }
    float* e = est + ((((size_t)(DIR * 2 + b) * 64 + g) * 32 + n) * 64 + lane) * 2; *(f32x2*)e = (f32x2){sr, si};
}
template <int DIR>
__device__ __forceinline__ void ssm_pass2_dir(const bf16_t* __restrict__ proj, const float* __restrict__ lamb_l, const float* __restrict__ lamt_l, const bf16_t* __restrict__ bbar_l, const bf16_t* __restrict__ ctt_l,
                                              const float* __restrict__ est, int b, int g, int n, int lane, LAS unsigned char* sl, f32x4 (&yacc)[8]) {
    const int dg = DIR * 64 + g; const float ar = lamb_l[(dg * 64 + lane) * 2], ai = lamb_l[(dg * 64 + lane) * 2 + 1], tr = lamt_l[(dg * 64 + lane) * 2], ti = lamt_l[(dg * 64 + lane) * 2 + 1];
    float sr = 0.f, si = 0.f;
    { const float* e = est + ((((size_t)(DIR * 2 + b) * 64 + g) * 32) * 64 + lane) * 2; f32x2 ev[32];
#pragma unroll
      for (int m = 0; m < 32; ++m) ev[m] = *(const f32x2*)(e + (size_t)m * 128);
#pragma unroll
      for (int mm = 0; mm < 32; ++mm) { const int m = DIR ? 31 - mm : mm; const bool use = DIR ? (m > n) : (m < n);
          const float nsr = fmaf(tr, sr, fmaf(-ti, si, ev[m].x)), nsi = fmaf(tr, si, fmaf(ti, sr, ev[m].y)); sr = use ? nsr : sr; si = use ? nsi : si; } }
    const BuFrags f = load_bufrags(bbar_l + (size_t)dg * 2 * 64 * 16, lane);
    bf16x8 cb[4];
#pragma unroll
    for (int ks = 0; ks < 4; ++ks) cb[ks] = *(const bf16x8*)(ctt_l + ((size_t)dg * 16 + (lane & 15)) * 128 + 32 * ks + 8 * (lane >> 4));
    bf16x8 ua[4];
#pragma unroll
    for (int s = 0; s < 4; ++s) ua[s] = bu_load(proj, b * SEQ + n * 128 + (DIR ? 3 - s : s) * 32, g, lane);
#pragma unroll
    for (int s = 0; s < 4; ++s) { const int sb = DIR ? 3 - s : s; float BR[32], BI[32];
        bu_block(ua[s], f, BR, BI);
#pragma unroll
        for (int tt = 0; tt < 32; ++tt) { const int t = DIR ? 31 - tt : tt; const float nsr = fmaf(ar, sr, fmaf(-ai, si, BR[t])), nsi = fmaf(ar, si, fmaf(ai, sr, BI[t])); sr = nsr; si = nsi;
            *(LAS unsigned*)(sl + (t * 136 + 2 * lane) * 2) = cvt_pk_bf16(sr, si); }
        LDS_WAIT();
#pragma unroll
        for (int rb = 0; rb < 2; ++rb)
#pragma unroll
            for (int ks = 0; ks < 4; ++ks) { const bf16x8 a = *(const LAS bf16x8*)(sl + ((16 * rb + (lane & 15)) * 136 + 32 * ks + 8 * (lane >> 4)) * 2);
                yacc[2 * sb + rb] = __builtin_amdgcn_mfma_f32_16x16x32_bf16(a, cb[ks], yacc[2 * sb + rb], 0, 0, 0); }
        LDS_WAIT(); }
}
__device__ __forceinline__ void ssm_pass2_item(const bf16_t* __restrict__ proj, const float* lamb_l, const float* lamt_l, const bf16_t* bbar_l, const bf16_t* ctt_l, const float* est, const float* __restrict__ dskip,
                                               bf16_t* __restrict__ ssmy, int b, int g, int n, int lane, LAS unsigned char* sl) {
    f32x4 yacc[8];
#pragma unroll
    for (int i = 0; i < 8; ++i) yacc[i] = (f32x4){0.f, 0.f, 0.f, 0.f};
    ssm_pass2_dir<0>(proj, lamb_l, lamt_l, bbar_l, ctt_l, est, b, g, n, lane, sl, yacc);
    ssm_pass2_dir<1>(proj, lamb_l, lamt_l, bbar_l, ctt_l, est, b, g, n, lane, sl, yacc);
    const int c = lane & 15, ch = g * 16 + c; const float dk = dskip[ch];
#pragma unroll
    for (int blk = 0; blk < 8; ++blk)
#pragma unroll
        for (int r = 0; r < 4; ++r) { const int tok = b * SEQ + n * 128 + 16 * blk + 4 * (lane >> 4) + r;
            const float y = yacc[blk][r] + dk * bf2f(proj[(size_t)tok * NIN + C_U + ch]); ssmy[(size_t)tok * 1024 + ch] = f2bf(gelu_t(y)); }
}

__device__ __forceinline__ void rope_token(const bf16_t* __restrict__ proj, const float* __restrict__ qg, const float* __restrict__ kg, bf16_t* __restrict__ QN, bf16_t* __restrict__ KN, bf16_t* __restrict__ VN, int tok, int lane) {
    const int a = lane >> 5, f = lane & 31, i1 = a * 64 + f, i2 = i1 + 32; const int t = tok & (SEQ - 1);
    const float pos = a == 0 ? (float)((t >> 6) - 32) : (float)((t & 63) - 32);
    const float inv = exp2f(-(float)f * (13.287712379549449f / 32.f)); float sn, cs; sincosf(pos * inv, &sn, &cs);
    const bf16_t* src = proj + (size_t)tok * NIN;
#pragma unroll
    for (int hh = 0; hh < 10; ++hh) { const bf16_t* s = src + hh * 128; float x1 = bf2f(s[i1]), x2 = bf2f(s[i2]);
        const float ss = wave_sum(x1 * x1 + x2 * x2), rs = rsqrtf(ss * (1.f / 128.f) + EPS); const float* gn = hh < 8 ? qg : kg;
        x1 *= rs * gn[i1]; x2 *= rs * gn[i2];
        bf16_t* d = hh < 8 ? QN + (size_t)tok * 1024 + hh * 128 : KN + (size_t)tok * 256 + (hh - 8) * 128;
        d[i1] = f2bf(x1 * cs - x2 * sn); d[i2] = f2bf(x2 * cs + x1 * sn); }
    *(u32x2*)(VN + (size_t)tok * 256 + lane * 4) = *(const u32x2*)(src + C_V + lane * 4);
}

__device__ __forceinline__ void gmlp_item(const bf16_t* __restrict__ proj, const epi::ss_t* __restrict__ ssv, const float* __restrict__ vgain, const bf16_t* __restrict__ wsb_l, const float* __restrict__ bs_l,
                                          bf16_t* __restrict__ mlpo, int cn, int g, LAS unsigned char* lds) {
    const int tid = threadIdx.x, lane = tid & 63, wid = tid >> 6, tok0 = cn * 128;
    { const int p = tid >> 2, cb = (tid & 3) * 32; const float rs = rsqrtf(epi::ss_val(ssv, tok0 + p) * (1.f / 1024.f) + EPS);
#pragma unroll
      for (int cc = 0; cc < 4; ++cc) { const int c0 = cb + cc * 8; f32x4 v0, v1; epi::unpack8(*(const u32x4*)(proj + (size_t)(tok0 + p) * NIN + C_ZV + g * 128 + c0), v0, v1);
          const f32x4 g0 = *(const f32x4*)(vgain + g * 128 + c0), g1 = *(const f32x4*)(vgain + g * 128 + c0 + 4);
#pragma unroll
          for (int i = 0; i < 4; ++i) { *(LAS bf16_t*)(lds + ((c0 + i) * 136 + p) * 2) = f2bf(v0[i] * rs * g0[i]); *(LAS bf16_t*)(lds + ((c0 + 4 + i) * 136 + p) * 2) = f2bf(v1[i] * rs * g1[i]); } } }
    __syncthreads();
    const int qb = wid >> 1, ch = wid & 1, r32 = lane & 31, hi = lane >> 5;
    f32x16 a0 = {}, a1 = {};
#pragma unroll
    for (int ks = 0; ks < 8; ++ks) { const bf16x8 af = *(const bf16x8*)(wsb_l + ((size_t)g * 128 + 32 * qb + r32) * 128 + 16 * ks + 8 * hi);
        const bf16x8 b0 = *(const LAS bf16x8*)(lds + ((64 * ch + r32) * 136 + 16 * ks + 8 * hi) * 2), b1 = *(const LAS bf16x8*)(lds + ((64 * ch + 32 + r32) * 136 + 16 * ks + 8 * hi) * 2);
        a0 = __builtin_amdgcn_mfma_f32_32x32x16_bf16(af, b0, a0, 0, 0, 0); a1 = __builtin_amdgcn_mfma_f32_32x32x16_bf16(af, b1, a1, 0, 0, 0); }
#pragma unroll
    for (int r = 0; r < 16; ++r) { const int q = 32 * qb + (r & 3) + 8 * (r >> 2) + 4 * hi, tok = tok0 + q; const float bq = bs_l[g * 128 + q];
        const int c0 = g * 128 + 64 * ch + r32;
        mlpo[(size_t)tok * 1024 + c0] = f2bf(bf2f(proj[(size_t)tok * NIN + C_ZU + c0]) * (a0[r] + bq));
        mlpo[(size_t)tok * 1024 + c0 + 32] = f2bf(bf2f(proj[(size_t)tok * NIN + C_ZU + c0 + 32]) * (a1[r] + bq)); }
    __syncthreads();
}
}

struct SchedMerge {
    int G, c; const char *wsb, *wbr;
    __device__ __forceinline__ bool next(int i, pg8::Unit& u) const {
        const int Lx = i * G + c; if (Lx >= 768) return false;
        constexpr size_t ts = (size_t)256 * 1024 * 2;
        const int z = Lx >> 8; pg8::tile_of(Lx & 255, 32, 8, u.pm, u.pn); u.z = z;
        const size_t ao = z == 0 ? wsm::ATT : (z == 1 ? wsm::MLPO : wsm::SSMO), bo = (z == 0 ? (size_t)0 : (z == 1 ? (size_t)2 : (size_t)1)) * ((size_t)DM * 1024 * 2);
        u.A = wsb + ao + (size_t)u.pm * ts; u.B = wbr + bo + (size_t)u.pn * ts;
        return true;
    }
};
struct SchedMoe {
    int G, c, nN; const int* tiles; const char* A0; const char* B0; size_t tsA, tsB, estride;
    __device__ __forceinline__ bool next(int i, pg8::Unit& u) const {
        const int T = tiles[0]; const long Lx = (long)i * G + c; if (Lx >= (long)T * nN) return false;
        pg8::tile_of((int)Lx, T, nN, u.pm, u.pn); const int e = tiles[1 + u.pm]; u.z = e;
        u.A = A0 + (size_t)u.pm * tsA; u.B = B0 + (size_t)e * estride + (size_t)u.pn * tsB; return true;
    }
};

struct Args { const float* in[31]; float* out; unsigned char* ws; int ph_lo, ph_hi; };
#ifndef MK_WGM_IN
#define MK_WGM_IN 4
#endif
#ifndef MK_F8D2
#define MK_F8D2 1
#endif
constexpr bool F8D = (MK_FP8 >= 2), F8M = (MK_FP8 >= 1);
constexpr bool F8D2 = F8D || (MK_F8D2 != 0);
constexpr bool F8P = false;
constexpr float WS1 = 32.f, WS2 = 64.f;
struct SchedMoe2Main {
    int G, c; const int* tiles; const char* A0; const char* B0; size_t tsA, tsB, estride;
    __device__ __forceinline__ bool next(int i, pg8::Unit& u) const {
        const int Lx = i * G + c; if (Lx >= 512) return false;
        pg8::tile_of(Lx, 64, 8, u.pm, u.pn); const int e = tiles[1 + u.pm]; u.z = 0;
        u.A = A0 + (size_t)u.pm * tsA; u.B = B0 + (size_t)e * estride + (size_t)u.pn * tsB; return true;
    }
};
struct SchedMoe2Tail {
    int G, c; const int* tiles; const char* A0; const char* B0; size_t tsA, tsB, estride, kqbytes;
    __device__ __forceinline__ bool next(int i, pg8::Unit& u) const {
        const int ntl = tiles[0] - 64, q = i * G + c; if (q >= ntl * 32) return false;
        int tt; pg8::tile_of(q >> 2, ntl, 8, tt, u.pn); u.pm = 64 + tt; u.z = q & 3; const int e = tiles[1 + u.pm];
        u.A = A0 + (size_t)u.pm * tsA + (size_t)u.z * kqbytes; u.B = B0 + (size_t)e * estride + (size_t)u.pn * tsB + (size_t)u.z * kqbytes; return true;
    }
};
#ifndef MK_NCONV
#define MK_NCONV 88
#endif
constexpr int NCONV = MK_NCONV, NCOMP = 256 - NCONV;
#ifndef MK_NCONVF
#define MK_NCONVF 0
#endif
constexpr int NCONVF = MK_NCONVF, NCOMPF = 256 - NCONVF;
#ifndef MK_CWG
#define MK_CWG 0
#endif
#ifndef MK_CWA
#define MK_CWA (16 * 64 + 3)
#endif
#ifndef MK_CWB
#define MK_CWB (MK_CWA + MK_CWG)
#endif
#ifndef MK_CWP
#define MK_CWP 0
#endif
constexpr int CXB = 15 * 64;
constexpr int CW0_LO = 0, CW0_HI = 64, CW0X_LO = CXB, CW0X_HI = CXB + MK_CWP;
constexpr int CW1_LO = 64, CW1_HI = CXB, CW1B_LO = CW0X_HI, CW1B_HI = MK_CWA;
constexpr int CWG0_LO = MK_CWA, CWG0_HI = MK_CWA + MK_CWG;
constexpr int CWF_LO = MK_CWA + MK_CWG, CWF_HI = MK_CWB;
constexpr int CW2_LO = MK_CWB, CW2_HI = 18 * 64 - MK_CWG;
constexpr int CWG1_LO = 18 * 64 - MK_CWG, CWG1_HI = 18 * 64;
namespace thin {
template <int PLO, int PHI, bool NTS = true>
__device__ __forceinline__ void conv_jobs(const Args& a, unsigned char* ws, LAS unsigned char* scr, int cgw, int cngw, int lane) {
#define CJ(j) if constexpr (PLO < 64 * (j) + 64 && 64 * (j) < PHI)
#define CF(j) , (PLO > 64 * (j) ? PLO - 64 * (j) : 0), (PHI < 64 * (j) + 64 ? PHI - 64 * (j) : 64)
    { unsigned char* wl = ws + wsm::W0;
        { CJ(0) conv_group<0, false, NTS>(a.in[3], 0, 1, DM, NIN, wl + wsm::O_WIN, 0, 1.f, 0, scr, cgw, cngw, lane CF(0));
                      CJ(1) conv_group<0, false, NTS>(a.in[30], 0, 1, PLED, DM, wl + wsm::O_PLEP, 0, 1.f, 0, scr, cgw, cngw, lane CF(1));
                      CJ(2) conv_group<0, false, NTS>(a.in[14], 0, 1, 1024, 1024, wl + wsm::O_GLU, 0, 1.f, 0, scr, cgw, cngw, lane CF(2));
                      CJ(3) conv_group<0, false, NTS>(a.in[18], (size_t)1024 * DM, 3, 1024, DM, wl + wsm::O_WBR, (size_t)DM * 1024 * 2, 1.f, 0, scr, cgw, cngw, lane CF(3));
                      CJ(4) conv_group<0, false, NTS>(a.in[19], 0, 1, DM, DM, wl + wsm::O_WOUT, 0, 1.f, 0, scr, cgw, cngw, lane CF(4));
                      CJ(5) conv_group<1, F8D, NTS>(a.in[21], 0, 1, DM, DFF, ws + wsm::FFN1, 0, F8D ? WS1 : 1.f, 0, scr, cgw, cngw, lane CF(5));
                      CJ(6) conv_group<1, F8D, NTS>(a.in[22], 0, 1, DM, DFF, ws + wsm::FFN1, 0, F8D ? WS1 : 1.f, 1, scr, cgw, cngw, lane CF(6));
                      CJ(7) conv_group<0, F8D2, NTS>(a.in[23], 0, 1, DFF, DM, ws + wsm::FFN2, 0, F8D2 ? WS2 : 1.f, 0, scr, cgw, cngw, lane CF(7));
                      CJ(8) conv_group<0, false, NTS>(a.in[29], 0, 1, DM, DM, wl + wsm::O_PLEG, 0, 1.f, 0, scr, cgw, cngw, lane CF(8)); }
    }
    { unsigned char* wl = ws + wsm::W0 + wsm::WL;
        { CJ(9) conv_group<0, false, NTS>(a.in[3] + (size_t)DM * NIN, 0, 1, DM, NIN, wl + wsm::O_WIN, 0, 1.f, 0, scr, cgw, cngw, lane CF(9));
               CJ(10) conv_group<0, false, NTS>(a.in[30] + (size_t)PLED * DM, 0, 1, PLED, DM, wl + wsm::O_PLEP, 0, 1.f, 0, scr, cgw, cngw, lane CF(10));
               CJ(11) conv_group<0, false, NTS>(a.in[14] + (size_t)1024 * 1024, 0, 1, 1024, 1024, wl + wsm::O_GLU, 0, 1.f, 0, scr, cgw, cngw, lane CF(11));
               CJ(12) conv_group<0, false, NTS>(a.in[18] + (size_t)3 * 1024 * DM, (size_t)1024 * DM, 3, 1024, DM, wl + wsm::O_WBR, (size_t)DM * 1024 * 2, 1.f, 0, scr, cgw, cngw, lane CF(12));
               CJ(13) conv_group<0, false, NTS>(a.in[19] + (size_t)DM * DM, 0, 1, DM, DM, wl + wsm::O_WOUT, 0, 1.f, 0, scr, cgw, cngw, lane CF(13));
               CJ(14) conv_group<0, F8P, NTS>(a.in[29] + (size_t)DM * DM, 0, 1, DM, DM, wl + wsm::O_PLEG, 0, F8P ? WS1 : 1.f, 0, scr, cgw, cngw, lane CF(14)); } }
#ifndef MK_COOP
#define MK_COOP 0
#endif
    if constexpr (F8M && MK_COOP) {
        LAS unsigned char* tl = scr - (cgw & 7) * 9216 + 81920; const int cwg = cgw >> 3, ncwg = cngw >> 3;
        CJ(15) coop_group<0>(a.in[27], (size_t)DFE * DM, NEXP, DFE, DM, ws + wsm::EXP2, wsm::SZ_EXP2, WS2, 0, tl, cwg, ncwg CF(15));
        CJ(16) coop_group<1>(a.in[25], (size_t)DM * DFE, NEXP, DM, DFE, ws + wsm::EXP1, wsm::SZ_EXP1, WS1, 0, tl, cwg, ncwg CF(16));
        CJ(17) coop_group<1>(a.in[26], (size_t)DM * DFE, NEXP, DM, DFE, ws + wsm::EXP1, wsm::SZ_EXP1, WS1, 1, tl, cwg, ncwg CF(17));
    } else {
    CJ(15) conv_group<0, F8M, NTS>(a.in[27], (size_t)DFE * DM, NEXP, DFE, DM, ws + wsm::EXP2, wsm::SZ_EXP2, F8M ? WS2 : 1.f, 0, scr, cgw, cngw, lane CF(15));
    CJ(16) conv_group<1, F8M, NTS>(a.in[25], (size_t)DM * DFE, NEXP, DM, DFE, ws + wsm::EXP1, wsm::SZ_EXP1, F8M ? WS1 : 1.f, 0, scr, cgw, cngw, lane CF(16));
    CJ(17) conv_group<1, F8M, NTS>(a.in[26], (size_t)DM * DFE, NEXP, DM, DFE, ws + wsm::EXP1, wsm::SZ_EXP1, F8M ? WS1 : 1.f, 1, scr, cgw, cngw, lane CF(17));
    }
#undef CJ
#undef CF
}
}

constexpr int NWAVES = 8, RING_BYTES = 131072, MISC_OFF = RING_BYTES, LDS_BYTES = 147456;
constexpr int N_PHASES = 25;

__global__ void __launch_bounds__(NWAVES * 64, 2) mk_fwd(Args a) {
    extern __shared__ __attribute__((aligned(16))) unsigned char lds_raw[];
    LAS unsigned char* lds = (LAS unsigned char*)lds_raw;
    volatile LAS unsigned* MISC = (volatile LAS unsigned*)(lds + MISC_OFF);
    const int tid = threadIdx.x, lane = tid & 63, wave = __builtin_amdgcn_readfirstlane(tid >> 6);
    const int G = gridDim.x, bx = blockIdx.x;
    const int gw = bx * NWAVES + wave, ngw = G * NWAVES;
    unsigned char* ws = a.ws; unsigned* ctl = (unsigned*)(ws + wsm::CTL);
    for (int u = tid; u < 64; u += NWAVES * 64) MISC[u] = 0u;
    __syncthreads();
    const int lo = a.ph_lo, hi = a.ph_hi;
    XcdBarrier bar; bar.bar = ctl + wsm::CW_BAR; bar.x = 0; bar.st = MISC + 8;
    if (hi - lo > 1) bar = xcd_barrier_post(ctl + wsm::CW_BAR, MISC + 8);
#ifndef MK_SUB
#define MK_SUB 0xffu
#endif
#ifndef MK_MASK
#define MK_MASK 0xffffffffu
#endif
#define PHASE_BEGIN(id, ty) if (((MK_MASK >> (ty)) & 1u) && lo <= (id) && (id) < hi) { constexpr bool dum = false; (void)dum; if ((id) > lo) xcd_barrier(bar);
#define PHASE_BEGIN_D(id, ty) if (((MK_MASK >> (ty)) & 1u) && lo <= (id) && (id) < hi) { constexpr bool dum = true; (void)dum; if ((id) > lo) xcd_barrier(bar);
#define PHASE_BEGIN_R(id, ty) if (((MK_MASK >> (ty)) & 1u) && lo <= (id) && (id) < hi) { constexpr bool dum = false; (void)dum; xcd_barrier(bar);
#define PHASE_END }
    epi::ss_t* ssbase = (epi::ss_t*)(ctl + wsm::CW_SS);
    bf16_t* XR = (bf16_t*)(ws + wsm::XF); bf16_t* XBA = (bf16_t*)(ws + wsm::XBA); bf16_t* XBB = (bf16_t*)(ws + wsm::XBB); bf16_t* PB = (bf16_t*)(ws + wsm::PB); bf16_t* PP = (bf16_t*)(ws + wsm::PP);
    bf16_t* PROJ = (bf16_t*)(ws + wsm::PROJ); bf16_t* QN = (bf16_t*)(ws + wsm::QN); bf16_t* KN = (bf16_t*)(ws + wsm::KN); bf16_t* VN = (bf16_t*)(ws + wsm::VN); bf16_t* ATT = (bf16_t*)(ws + wsm::ATT);
    bf16_t* SSMY = (bf16_t*)(ws + wsm::SSMY); bf16_t* SSMO = (bf16_t*)(ws + wsm::SSMO); bf16_t* MLPO = (bf16_t*)(ws + wsm::MLPO); float* MRGF = (float*)(ws + wsm::MRGF); bf16_t* MRGB = (bf16_t*)(ws + wsm::MRGB);
    float* EST = (float*)(ws + wsm::ESTATE);

    PHASE_BEGIN(0, 0)
    {
        LAS unsigned char* scr = lds + wave * 9216;
        const int cgw = gw, cngw = ngw; {
        thin::conv_jobs<CW0_LO, CW0_HI, false>(a, ws, scr, cgw, cngw, lane); thin::conv_jobs<CW0X_LO, CW0X_HI>(a, ws, scr, cgw, cngw, lane);
        }
        for (int row = gw; row < NT; row += ngw) { const float* xr = a.in[0] + (size_t)row * DM; float sq = 0.f;
#pragma unroll
            for (int j = 0; j < 4; ++j) { const f32x4 v0 = *(const f32x4*)(xr + (lane + 64 * j) * 8), v1 = *(const f32x4*)(xr + (lane + 64 * j) * 8 + 4);
                const f32x4 g0 = *(const f32x4*)(a.in[2] + (lane + 64 * j) * 8), g1 = *(const f32x4*)(a.in[2] + (lane + 64 * j) * 8 + 4);
                *(u32x4*)(XBA + (size_t)row * DM + (lane + 64 * j) * 8) = epi::pack8(v0 * g0, v1 * g1); sq += epi::sum8sq(v0, v1); }
            sq = wave_sum(sq); if (lane == 0) ssbase[7 * NT + row] = epi::ss_fix(sq); }
        for (size_t i = (size_t)gw * 64 + lane; i < (size_t)2 * NT * PLED / 8; i += (size_t)ngw * 64) { const f32x4 v0 = *(const f32x4*)(a.in[1] + i * 8), v1 = *(const f32x4*)(a.in[1] + i * 8 + 4); *(u32x4*)(PB + i * 8) = epi::pack8(v0, v1); }
        for (size_t i = (size_t)gw * 64 + lane; i < (size_t)2 * 8 * 128 * 128 / 8; i += (size_t)ngw * 64) { const f32x4 v0 = *(const f32x4*)(a.in[16] + i * 8), v1 = *(const f32x4*)(a.in[16] + i * 8 + 4); *(u32x4*)((bf16_t*)(ws + wsm::WSB) + i * 8) = epi::pack8(v0, v1); }
#ifdef MK_XBAR
        for (int q = 0; q < MK_XBAR; ++q) xcd_barrier(bar);
#endif
        for (int it = gw; it < 256; it += ngw) thin::ssm_tables(it, a.in[6], a.in[7], a.in[8], a.in[9], a.in[10], a.in[11], a.in[12], (float*)(ws + wsm::LAMB), (float*)(ws + wsm::LAMT), (bf16_t*)(ws + wsm::BBAR), (bf16_t*)(ws + wsm::CTT), lane);
        __syncthreads();
    }
    PHASE_END

    { constexpr int l = 0;
        const int pb = 1 + 12 * l;
        constexpr bool FF8 = (l == 0) ? F8D : F8M;
        constexpr int EB = FF8 ? 1 : 2;
        unsigned char* wl = ws + wsm::W0 + (size_t)l * wsm::WL;
        bf16_t* xin = l ? XBB : XBA; bf16_t* x1b = l ? XBA : XBB; bf16_t* x2b = l ? XBB : XBA;
        epi::ss_t* ssv = ssbase + l * NT; epi::ss_t* ssx1 = ssbase + (2 + l) * NT; epi::ss_t* ssx2 = ssbase + (4 + l) * NT; epi::ss_t* ssx3 = ssbase + 6 * NT; const epi::ss_t* ssin = l ? ssx3 : ssbase + 7 * NT;
        const float* lamb_l = (const float*)(ws + wsm::LAMB) + (size_t)l * 16384; const float* lamt_l = (const float*)(ws + wsm::LAMT) + (size_t)l * 16384;
        const bf16_t* bbar_l = (const bf16_t*)(ws + wsm::BBAR) + (size_t)l * 262144; const bf16_t* ctt_l = (const bf16_t*)(ws + wsm::CTT) + (size_t)l * 262144;
        const bf16_t* wsb_l = (const bf16_t*)(ws + wsm::WSB) + (size_t)l * 131072;

        PHASE_BEGIN(pb + 0, 1)
        { if (bx < NCOMP) { pg8::SchedGrid S{NT / 256, NIN / 256, NCOMP, bx, 0, (const char*)xin, (const char*)(wl + wsm::O_WIN), (size_t)256 * DM * 2, MK_WGM_IN};
              epi::EpiInproj E{PROJ, ssin, dum ? ssbase + 8 * NT : ssv, (unsigned char*)MRGF};
              pg8::gemm_phase(lds, DM * 2, S, E); }
          else if (!dum) { LAS unsigned char* scr = lds + wave * 9216; const int cgw = (bx - NCOMP) * NWAVES + wave, cngw = NCONV * NWAVES;
              if constexpr (l == 0) { thin::conv_jobs<CW1_LO, CW1_HI>(a, ws, scr, cgw, cngw, lane); thin::conv_jobs<CW1B_LO, CW1B_HI>(a, ws, scr, cgw, cngw, lane); }
              else thin::conv_jobs<CW2_LO, CW2_HI>(a, ws, scr, cgw, cngw, lane); } }
        PHASE_END

        PHASE_BEGIN(pb + 1, 2)
        { for (int tok = gw; tok < NT; tok += ngw) thin::rope_token(PROJ, a.in[4] + l * 128, a.in[5] + l * 128, QN, KN, VN, tok, lane);
          for (int it = gw; it < 2 * 2 * 64 * 32; it += ngw) { const int n = it & 31, g = (it >> 5) & 63, b = (it >> 11) & 1, d = it >> 12;
              if (d == 0) thin::ssm_pass1_item<0>(PROJ, lamb_l, bbar_l, EST, b, g, n, lane); else thin::ssm_pass1_item<1>(PROJ, lamb_l, bbar_l, EST, b, g, n, lane); } }
        PHASE_END

        PHASE_BEGIN(pb + 2, 3)
        { LAS unsigned char* sl = lds + wave * 8704;
          for (int it = gw; it < 2 * 64 * 32; it += ngw) { const int n = it & 31, g = (it >> 5) & 63, b = it >> 11;
              thin::ssm_pass2_item(PROJ, lamb_l, lamt_l, bbar_l, ctt_l, EST, a.in[13] + l * 1024, SSMY, b, g, n, lane, sl); }
          __syncthreads();
          for (int it = bx; it < 512; it += G) thin::gmlp_item(PROJ, ssv, a.in[15] + l * 1024, wsb_l, a.in[17] + l * 1024, MLPO, it >> 3, it & 7, lds); }
        PHASE_END

        PHASE_BEGIN(pb + 3, 4)
        { for (int it = bx; it < 256; it += G) {
              int combo, idx; if (G == 256) { const int xcd = it & 7, slot = it >> 3; combo = xcd >> 1; idx = (xcd & 1) * 32 + slot; } else { combo = it >> 6; idx = it & 63; }
              const int b = combo >> 1, kvh = combo & 1, h = kvh * 4 + (idx >> 4), qb = idx & 15;
              const size_t qo = ((size_t)(b * SEQ + qb * 256)) * 1024 + h * 128, ko = ((size_t)b * SEQ) * 256 + kvh * 128;
              attn::attn_dense_body(QN + qo, KN + ko, VN + ko, ATT + qo, SEQ, (char*)lds_raw); }
          if (bx < 128) { pg8::SchedGrid S{NT / 256, 1024 / 256, G, bx, 0, (const char*)SSMY, (const char*)(wl + wsm::O_GLU), (size_t)256 * 1024 * 2};
            epi::EpiGlu E{SSMY, SSMO};
            pg8::gemm_phase(lds, 1024 * 2, S, E); }
          else { pg8::SchedGrid S{NT / 256, DM / 256, 128, bx - 128, 0, (const char*)(PB + (size_t)l * NT * PLED), (const char*)(wl + wsm::O_PLEP), (size_t)256 * PLED * 2};
            epi::EpiBf16 E{PP, DM};
            pg8::gemm_phase(lds, PLED * 2, S, E); } }
        PHASE_END

        PHASE_BEGIN(pb + 4, 5)
        { SchedMerge S{G, bx, (const char*)ws, (const char*)(wl + wsm::O_WBR)};
          epi::EpiMerge E{(const unsigned char*)MRGF, MRGB};
          pg8::gemm_phase(lds, 1024 * 2, S, E); }
        PHASE_END

        PHASE_BEGIN(pb + 5, 6)
        { pg8::SchedGrid S{NT / 256, DM / 256, G, bx, 0, (const char*)MRGB, (const char*)(wl + wsm::O_WOUT), (size_t)256 * DM * 2};
          epi::EpiResid<false, FF8, (l != 0)> E{l == 0 ? (const void*)a.in[0] : (const void*)XR, dum ? (bf16_t*)MRGF : XR, dum ? (void*)SSMY : (void*)x1b, dum ? ssbase + 8 * NT : ssx1, 1.f, a.in[20] + l * DM};
          pg8::gemm_phase(lds, DM * 2, S, E); }
        PHASE_END

        if (l == 0) {
            PHASE_BEGIN(pb + 6, 7)
            { if (bx < NCOMPF) { pg8::SchedGrid S{NT / 256, 2 * DFF / 256, NCOMPF, bx, 0, (const char*)x1b, (const char*)(ws + wsm::FFN1), (size_t)256 * DM * EB};
                  epi::EpiSwiglu<FF8, F8D2> E{ws + wsm::ACTD, DFF, ssx1, 0, FF8 ? 1.f / WS1 : 1.f};
                  pg8::gemm_phase(lds, DM * EB, S, E); }
              else if (!dum) { LAS unsigned char* scr = lds + wave * 9216; thin::conv_jobs<CWF_LO, CWF_HI>(a, ws, scr, (bx - NCOMPF) * NWAVES + wave, NCONVF * NWAVES, lane); } }
            PHASE_END
            PHASE_BEGIN(pb + 7, 8)
            { constexpr int EB2 = F8D2 ? 1 : 2;
              pg8::SchedGrid S{NT / 256, DM / 256, G, bx, 0, (const char*)(ws + wsm::ACTD), (const char*)(ws + wsm::FFN2), (size_t)256 * DFF * EB2};
              epi::EpiResid<F8D2, false, true> E{XR, dum ? (bf16_t*)MRGF : XR, dum ? (void*)SSMY : (void*)x2b, dum ? ssbase + 8 * NT : ssx2, F8D2 ? 1.f / WS2 : 1.f, a.in[28] + l * DM};
              pg8::gemm_phase(lds, DFF * EB2, S, E); }
            PHASE_END
        } else {
            int* ridx = (int*)(ws + wsm::R_IDX); float* rgate = (float*)(ws + wsm::R_GATE); int* tokdest = (int*)(ws + wsm::R_TOKDEST); int* rowtok = (int*)(ws + wsm::R_ROWTOK);
            float* rowgate = (float*)(ws + wsm::R_ROWGATE); float* rowrstd = (float*)(ws + wsm::R_ROWRSTD); int* hist = (int*)(ws + wsm::R_HIST); int* tiles = (int*)(ws + wsm::R_TILES);
            bf16_t* XG = (bf16_t*)(ws + wsm::XG); bf16_t* ACTM = (bf16_t*)(ws + wsm::ACTM); bf16_t* YB = (bf16_t*)(ws + wsm::YB);
            PHASE_BEGIN(pb + 6, 9)
            { volatile LAS int* lh = (volatile LAS int*)lds;
              if (tid < 8) lh[tid] = 0;
              const float* gn = a.in[20] + DM; const float* wr = a.in[24];
              LAS f32x4* wg = (LAS f32x4*)(lds + 1024);
              { const int ln = tid & 63, jw = tid >> 6; const f32x4 gv = *(const f32x4*)(gn + 4 * ln + 256 * jw);
#pragma unroll
                for (int i = 0; i < 4; ++i) { const float* wp = wr + (size_t)(4 * ln + 256 * jw + i) * 8; wg[((jw * 4 + i) * 2 + 0) * 64 + ln] = *(const f32x4*)wp * gv[i]; wg[((jw * 4 + i) * 2 + 1) * 64 + ln] = *(const f32x4*)(wp + 4) * gv[i]; } }
              __syncthreads();
              float acc[4][8];
#pragma unroll
              for (int i = 0; i < 4; ++i)
#pragma unroll
                  for (int e = 0; e < 8; ++e) acc[i][e] = 0.f;
              const int tokb = bx * 32 + wave * 4;
#pragma unroll 2
              for (int j = 0; j < 8; ++j) { f32x4 xv[4];
#pragma unroll
                  for (int i = 0; i < 4; ++i) { const u32x2 xr = *(const u32x2*)(XR + (size_t)(tokb + i) * DM + 4 * lane + 256 * j); xv[i] = (f32x4){__uint_as_float(xr[0] << 16), __uint_as_float(xr[0] & 0xffff0000u), __uint_as_float(xr[1] << 16), __uint_as_float(xr[1] & 0xffff0000u)}; }
#pragma unroll
                  for (int jj = 0; jj < 4; ++jj) { const f32x4 w0 = wg[((j * 4 + jj) * 2 + 0) * 64 + lane], w1 = wg[((j * 4 + jj) * 2 + 1) * 64 + lane];
#pragma unroll
                      for (int i = 0; i < 4; ++i) { const float h = xv[i][jj];
                          acc[i][0] = fmaf(h, w0[0], acc[i][0]); acc[i][1] = fmaf(h, w0[1], acc[i][1]); acc[i][2] = fmaf(h, w0[2], acc[i][2]); acc[i][3] = fmaf(h, w0[3], acc[i][3]);
                          acc[i][4] = fmaf(h, w1[0], acc[i][4]); acc[i][5] = fmaf(h, w1[1], acc[i][5]); acc[i][6] = fmaf(h, w1[2], acc[i][6]); acc[i][7] = fmaf(h, w1[3], acc[i][7]); } } }
#pragma unroll
              for (int i = 0; i < 4; ++i) { const int tok = tokb + i; const float r = rsqrtf(epi::ss_val(ssx1, tok) * (1.f / DM) + EPS); float lg[8];
#pragma unroll
                  for (int e = 0; e < 8; ++e) lg[e] = wave_sum(acc[i][e]) * r;
                  if (lane == 0) { int i0 = 0; float v0 = lg[0];
#pragma unroll
                      for (int e = 1; e < 8; ++e) if (lg[e] > v0) { v0 = lg[e]; i0 = e; }
                      int i1 = -1; float v1 = -3.0e38f;
#pragma unroll
                      for (int e = 0; e < 8; ++e) if (e != i0 && lg[e] > v1) { v1 = lg[e]; i1 = e; }
                      const float e1 = __expf(v1 - v0), g0 = 1.f / (1.f + e1);
                      ridx[tok * 2] = i0; ridx[tok * 2 + 1] = i1; rgate[tok * 2] = g0; rgate[tok * 2 + 1] = e1 * g0;
                      __hip_atomic_fetch_add((LAS int*)lds + i0, 1, __ATOMIC_RELAXED, __HIP_MEMORY_SCOPE_WORKGROUP); __hip_atomic_fetch_add((LAS int*)lds + i1, 1, __ATOMIC_RELAXED, __HIP_MEMORY_SCOPE_WORKGROUP); } }
              __syncthreads();
              if (tid < 8) hist[bx * 8 + tid] = lh[tid];
              __syncthreads(); }
            PHASE_END
            PHASE_BEGIN(pb + 7, 10)
            { volatile LAS int* li = (volatile LAS int*)lds;
              { const int e = wave; int tot = 0, pr = 0;
#pragma unroll
                for (int j = 0; j < 4; ++j) { const int w = lane + 64 * j; const int v = hist[w * 8 + e]; tot += v; pr += (w < bx) ? v : 0; }
#pragma unroll
                for (int o = 1; o < 64; o <<= 1) { tot += __shfl_xor(tot, o); pr += __shfl_xor(pr, o); }
                if (lane == 0) { li[e] = tot; li[8 + e] = pr; } }
              __syncthreads();
              if (tid == 0) { int off = 0; for (int e = 0; e < 8; ++e) { li[16 + e] = off; off += ((li[e] + 255) >> 8) * 256; } li[24] = off >> 8; }
              __syncthreads();
              if (wave == 0) { const int tok = bx * 32 + (lane >> 1), k = lane & 1, e = ridx[tok * 2 + k]; int rank = 0;
#pragma unroll
                  for (int q = 0; q < 8; ++q) { const unsigned long long m = __ballot(e == q); if (e == q) rank = __popcll(m & ((1ull << lane) - 1ull)); }
                  const int dest = li[16 + e] + li[8 + e] + rank;
                  tokdest[tok * 2 + k] = dest; rowtok[dest] = tok; rowgate[dest] = rgate[tok * 2 + k]; rowrstd[dest] = rsqrtf(epi::ss_val(ssx1, tok) * (1.f / DM) + EPS); li[32 + lane] = dest; }
              if (bx == 0) {
                  if (tid < 8) { const int e = tid, nt = (li[e] + 255) >> 8, t0 = li[16 + e] >> 8; for (int t = 0; t < nt; ++t) tiles[1 + t0 + t] = e; if (e == 0) tiles[0] = li[24]; }
                  for (int e = 0; e < 8; ++e) { const int r0 = li[16 + e] + li[e], r1 = li[16 + e] + (((li[e] + 255) >> 8) << 8);
                      for (int r = r0 + tid; r < r1; r += NWAVES * 64) { rowtok[r] = -1; rowgate[r] = 0.f; rowrstd[r] = 0.f; } } }
              __syncthreads();
#pragma unroll
              for (int q = 0; q < 8; ++q) { const int i = wave * 8 + q, tok = bx * 32 + (i >> 1), dest = li[32 + i];
                  const u32x4* s = (const u32x4*)((const unsigned char*)x1b + (size_t)tok * DM * EB); u32x4* d = (u32x4*)((unsigned char*)XG + (size_t)dest * DM * EB);
#pragma unroll
                  for (int jj = 0; jj < 2 * EB; ++jj) d[lane + 64 * jj] = s[lane + 64 * jj]; }
              __syncthreads(); }
            PHASE_END
            PHASE_BEGIN(pb + 8, 11)
            { SchedMoe S{G, bx, 2 * DFE / 256, tiles, (const char*)XG, (const char*)(ws + wsm::EXP1), (size_t)256 * DM * EB, (size_t)256 * DM * EB, wsm::SZ_EXP1};
              epi::EpiSwiglu<FF8> E{ACTM, DFE, rowrstd, 1, FF8 ? 1.f / WS1 : 1.f};
              pg8::gemm_phase(lds, DM * EB, S, E); }
            PHASE_END
            PHASE_BEGIN(pb + 9, 12)
            { epi::EpiMoe2<FF8> E{YB, rowgate, FF8 ? 1.f / WS2 : 1.f, (bf16_t*)(ws + wsm::YBX)};
              { SchedMoe2Main S{G, bx, tiles, (const char*)ACTM, (const char*)(ws + wsm::EXP2), (size_t)256 * DFE * EB, (size_t)256 * DFE * EB, wsm::SZ_EXP2};
                pg8::gemm_phase(lds, DFE * EB, S, E); }
              { SchedMoe2Tail S{G, bx, tiles, (const char*)ACTM, (const char*)(ws + wsm::EXP2), (size_t)256 * DFE * EB, (size_t)256 * DFE * EB, wsm::SZ_EXP2, (size_t)DFE * EB / 4};
                pg8::gemm_phase(lds, DFE * EB, S, E, DFE * EB / 128 / 4); } }
            PHASE_END
            PHASE_BEGIN(pb + 10, 13)
            { for (int tok = gw; tok < NT; tok += ngw) { const int d0 = tokdest[tok * 2], d1 = tokdest[tok * 2 + 1]; float sq = 0.f;
#pragma unroll
                  for (int j = 0; j < 4; ++j) { const size_t o = (size_t)tok * DM + (lane + 64 * j) * 8; f32x4 x0, x1, p0, p1, q0, q1; epi::unpack8(*(const u32x4*)(XR + o), x0, x1);
                      epi::unpack8(*(const u32x4*)(YB + (size_t)d0 * DM + (lane + 64 * j) * 8), p0, p1); epi::unpack8(*(const u32x4*)(YB + (size_t)d1 * DM + (lane + 64 * j) * 8), q0, q1);
                      x0 += p0 + q0; x1 += p1 + q1;
#pragma unroll
                      for (int dd = 0; dd < 2; ++dd) { const int d = dd ? d1 : d0; if (d >= 16384) {
#pragma unroll
                          for (int s = 0; s < 3; ++s) { epi::unpack8(*(const u32x4*)((const bf16_t*)(ws + wsm::YBX) + ((size_t)s * 2048 + (d - 16384)) * DM + (lane + 64 * j) * 8), p0, p1); x0 += p0; x1 += p1; } } } *(u32x4*)(XR + o) = epi::pack8(x0, x1);
                      const float* gp = a.in[28] + DM + (lane + 64 * j) * 8; const f32x4 y0 = x0 * *(const f32x4*)gp, y1 = x1 * *(const f32x4*)(gp + 4);
                      if constexpr (F8P) *(u32x2*)((unsigned char*)x2b + o) = (u32x2){pk4_fp8(y0[0], y0[1], y0[2], y0[3]), pk4_fp8(y1[0], y1[1], y1[2], y1[3])}; else *(u32x4*)(x2b + o) = epi::pack8(y0, y1);
                      sq += epi::sum8sq(x0, x1); }
                  sq = wave_sum(sq); if (lane == 0) ssx2[tok] = epi::ss_fix(sq); } }
            PHASE_END
        }

        PHASE_BEGIN(pb + 11, 14)
        { constexpr bool PF8 = (l == 1) && F8P; constexpr int PEB = PF8 ? 1 : 2;
          pg8::SchedGrid S{NT / 256, DM / 256, G, bx, 0, (const char*)x2b, (const char*)(wl + wsm::O_PLEG), (size_t)256 * DM * PEB};
          epi::EpiPle<PF8, (l == 1)> E{XR, dum ? (void*)MRGF : (l ? (void*)a.out : (void*)XR), dum ? SSMY : (l ? nullptr : XBB), ssx2, dum ? ssbase + 8 * NT : (l ? nullptr : ssx3), PP, a.in[2] + DM, PF8 ? 1.f / WS1 : 1.f};
          pg8::gemm_phase(lds, DM * PEB, S, E); }
        PHASE_END

    }
    { constexpr int l = 1;
        const int pb = 1 + 12 * l;
        constexpr bool FF8 = (l == 0) ? F8D : F8M;
        constexpr int EB = FF8 ? 1 : 2;
        unsigned char* wl = ws + wsm::W0 + (size_t)l * wsm::WL;
        bf16_t* xin = l ? XBB : XBA; bf16_t* x1b = l ? XBA : XBB; bf16_t* x2b = l ? XBB : XBA;
        epi::ss_t* ssv = ssbase + l * NT; epi::ss_t* ssx1 = ssbase + (2 + l) * NT; epi::ss_t* ssx2 = ssbase + (4 + l) * NT; epi::ss_t* ssx3 = ssbase + 6 * NT; const epi::ss_t* ssin = l ? ssx3 : ssbase + 7 * NT;
        const float* lamb_l = (const float*)(ws + wsm::LAMB) + (size_t)l * 16384; const float* lamt_l = (const float*)(ws + wsm::LAMT) + (size_t)l * 16384;
        const bf16_t* bbar_l = (const bf16_t*)(ws + wsm::BBAR) + (size_t)l * 262144; const bf16_t* ctt_l = (const bf16_t*)(ws + wsm::CTT) + (size_t)l * 262144;
        const bf16_t* wsb_l = (const bf16_t*)(ws + wsm::WSB) + (size_t)l * 131072;

        PHASE_BEGIN(pb + 0, 1)
        { if (bx < NCOMP) { pg8::SchedGrid S{NT / 256, NIN / 256, NCOMP, bx, 0, (const char*)xin, (const char*)(wl + wsm::O_WIN), (size_t)256 * DM * 2, MK_WGM_IN};
              epi::EpiInproj E{PROJ, ssin, dum ? ssbase + 8 * NT : ssv, (unsigned char*)MRGF};
              pg8::gemm_phase(lds, DM * 2, S, E); }
          else if (!dum) { LAS unsigned char* scr = lds + wave * 9216; const int cgw = (bx - NCOMP) * NWAVES + wave, cngw = NCONV * NWAVES;
              if constexpr (l == 0) { thin::conv_jobs<CW1_LO, CW1_HI>(a, ws, scr, cgw, cngw, lane); thin::conv_jobs<CW1B_LO, CW1B_HI>(a, ws, scr, cgw, cngw, lane); }
              else thin::conv_jobs<CW2_LO, CW2_HI>(a, ws, scr, cgw, cngw, lane); } }
        PHASE_END

        PHASE_BEGIN(pb + 1, 2)
        { for (int tok = gw; tok < NT; tok += ngw) thin::rope_token(PROJ, a.in[4] + l * 128, a.in[5] + l * 128, QN, KN, VN, tok, lane);
          for (int it = gw; it < 2 * 2 * 64 * 32; it += ngw) { const int n = it & 31, g = (it >> 5) & 63, b = (it >> 11) & 1, d = it >> 12;
              if (d == 0) thin::ssm_pass1_item<0>(PROJ, lamb_l, bbar_l, EST, b, g, n, lane); else thin::ssm_pass1_item<1>(PROJ, lamb_l, bbar_l, EST, b, g, n, lane); } }
        PHASE_END

        PHASE_BEGIN(pb + 2, 3)
        { LAS unsigned char* sl = lds + wave * 8704;
          for (int it = gw; it < 2 * 64 * 32; it += ngw) { const int n = it & 31, g = (it >> 5) & 63, b = it >> 11;
              thin::ssm_pass2_item(PROJ, lamb_l, lamt_l, bbar_l, ctt_l, EST, a.in[13] + l * 1024, SSMY, b, g, n, lane, sl); }
          __syncthreads();
          for (int it = bx; it < 512; it += G) thin::gmlp_item(PROJ, ssv, a.in[15] + l * 1024, wsb_l, a.in[17] + l * 1024, MLPO, it >> 3, it & 7, lds); }
        PHASE_END

        PHASE_BEGIN(pb + 3, 4)
        { for (int it = bx; it < 256; it += G) {
              int combo, idx; if (G == 256) { const int xcd = it & 7, slot = it >> 3; combo = xcd >> 1; idx = (xcd & 1) * 32 + slot; } else { combo = it >> 6; idx = it & 63; }
              const int b = combo >> 1, kvh = combo & 1, h = kvh * 4 + (idx >> 4), qb = idx & 15;
              const size_t qo = ((size_t)(b * SEQ + qb * 256)) * 1024 + h * 128, ko = ((size_t)b * SEQ) * 256 + kvh * 128;
              attn::attn_dense_body(QN + qo, KN + ko, VN + ko, ATT + qo, SEQ, (char*)lds_raw); }
          if (bx < 128) { pg8::SchedGrid S{NT / 256, 1024 / 256, G, bx, 0, (const char*)SSMY, (const char*)(wl + wsm::O_GLU), (size_t)256 * 1024 * 2};
            epi::EpiGlu E{SSMY, SSMO};
            pg8::gemm_phase(lds, 1024 * 2, S, E); }
          else { pg8::SchedGrid S{NT / 256, DM / 256, 128, bx - 128, 0, (const char*)(PB + (size_t)l * NT * PLED), (const char*)(wl + wsm::O_PLEP), (size_t)256 * PLED * 2};
            epi::EpiBf16 E{PP, DM};
            pg8::gemm_phase(lds, PLED * 2, S, E); } }
        PHASE_END

        PHASE_BEGIN(pb + 4, 5)
        { SchedMerge S{G, bx, (const char*)ws, (const char*)(wl + wsm::O_WBR)};
          epi::EpiMerge E{(const unsigned char*)MRGF, MRGB};
          pg8::gemm_phase(lds, 1024 * 2, S, E); }
        PHASE_END

        PHASE_BEGIN(pb + 5, 6)
        { pg8::SchedGrid S{NT / 256, DM / 256, G, bx, 0, (const char*)MRGB, (const char*)(wl + wsm::O_WOUT), (size_t)256 * DM * 2};
          epi::EpiResid<false, FF8, (l != 0)> E{l == 0 ? (const void*)a.in[0] : (const void*)XR, dum ? (bf16_t*)MRGF : XR, dum ? (void*)SSMY : (void*)x1b, dum ? ssbase + 8 * NT : ssx1, 1.f, a.in[20] + l * DM};
          pg8::gemm_phase(lds, DM * 2, S, E); }
        PHASE_END

        if (l == 0) {
            PHASE_BEGIN(pb + 6, 7)
            { if (bx < NCOMPF) { pg8::SchedGrid S{NT / 256, 2 * DFF / 256, NCOMPF, bx, 0, (const char*)x1b, (const char*)(ws + wsm::FFN1), (size_t)256 * DM * EB};
                  epi::EpiSwiglu<FF8, F8D2> E{ws + wsm::ACTD, DFF, ssx1, 0, FF8 ? 1.f / WS1 : 1.f};
                  pg8::gemm_phase(lds, DM * EB, S, E); }
              else if (!dum) { LAS unsigned char* scr = lds + wave * 9216; thin::conv_jobs<CWF_LO, CWF_HI>(a, ws, scr, (bx - NCOMPF) * NWAVES + wave, NCONVF * NWAVES, lane); } }
            PHASE_END
            PHASE_BEGIN(pb + 7, 8)
            { constexpr int EB2 = F8D2 ? 1 : 2;
              pg8::SchedGrid S{NT / 256, DM / 256, G, bx, 0, (const char*)(ws + wsm::ACTD), (const char*)(ws + wsm::FFN2), (size_t)256 * DFF * EB2};
              epi::EpiResid<F8D2, false, true> E{XR, dum ? (bf16_t*)MRGF : XR, dum ? (void*)SSMY : (void*)x2b, dum ? ssbase + 8 * NT : ssx2, F8D2 ? 1.f / WS2 : 1.f, a.in[28] + l * DM};
              pg8::gemm_phase(lds, DFF * EB2, S, E); }
            PHASE_END
        } else {
            int* ridx = (int*)(ws + wsm::R_IDX); float* rgate = (float*)(ws + wsm::R_GATE); int* tokdest = (int*)(ws + wsm::R_TOKDEST); int* rowtok = (int*)(ws + wsm::R_ROWTOK);
            float* rowgate = (float*)(ws + wsm::R_ROWGATE); float* rowrstd = (float*)(ws + wsm::R_ROWRSTD); int* hist = (int*)(ws + wsm::R_HIST); int* tiles = (int*)(ws + wsm::R_TILES);
            bf16_t* XG = (bf16_t*)(ws + wsm::XG); bf16_t* ACTM = (bf16_t*)(ws + wsm::ACTM); bf16_t* YB = (bf16_t*)(ws + wsm::YB);
            PHASE_BEGIN(pb + 6, 9)
            { volatile LAS int* lh = (volatile LAS int*)lds;
              if (tid < 8) lh[tid] = 0;
              const float* gn = a.in[20] + DM; const float* wr = a.in[24];
              LAS f32x4* wg = (LAS f32x4*)(lds + 1024);
              { const int ln = tid & 63, jw = tid >> 6; const f32x4 gv = *(const f32x4*)(gn + 4 * ln + 256 * jw);
#pragma unroll
                for (int i = 0; i < 4; ++i) { const float* wp = wr + (size_t)(4 * ln + 256 * jw + i) * 8; wg[((jw * 4 + i) * 2 + 0) * 64 + ln] = *(const f32x4*)wp * gv[i]; wg[((jw * 4 + i) * 2 + 1) * 64 + ln] = *(const f32x4*)(wp + 4) * gv[i]; } }
              __syncthreads();
              float acc[4][8];
#pragma unroll
              for (int i = 0; i < 4; ++i)
#pragma unroll
                  for (int e = 0; e < 8; ++e) acc[i][e] = 0.f;
              const int tokb = bx * 32 + wave * 4;
#pragma unroll 2
              for (int j = 0; j < 8; ++j) { f32x4 xv[4];
#pragma unroll
                  for (int i = 0; i < 4; ++i) { const u32x2 xr = *(const u32x2*)(XR + (size_t)(tokb + i) * DM + 4 * lane + 256 * j); xv[i] = (f32x4){__uint_as_float(xr[0] << 16), __uint_as_float(xr[0] & 0xffff0000u), __uint_as_float(xr[1] << 16), __uint_as_float(xr[1] & 0xffff0000u)}; }
#pragma unroll
                  for (int jj = 0; jj < 4; ++jj) { const f32x4 w0 = wg[((j * 4 + jj) * 2 + 0) * 64 + lane], w1 = wg[((j * 4 + jj) * 2 + 1) * 64 + lane];
#pragma unroll
                      for (int i = 0; i < 4; ++i) { const float h = xv[i][jj];
                          acc[i][0] = fmaf(h, w0[0], acc[i][0]); acc[i][1] = fmaf(h, w0[1], acc[i][1]); acc[i][2] = fmaf(h, w0[2], acc[i][2]); acc[i][3] = fmaf(h, w0[3], acc[i][3]);
                          acc[i][4] = fmaf(h, w1[0], acc[i][4]); acc[i][5] = fmaf(h, w1[1], acc[i][5]); acc[i][6] = fmaf(h, w1[2], acc[i][6]); acc[i][7] = fmaf(h, w1[3], acc[i][7]); } } }
#pragma unroll
              for (int i = 0; i < 4; ++i) { const int tok = tokb + i; const float r = rsqrtf(epi::ss_val(ssx1, tok) * (1.f / DM) + EPS); float lg[8];
#pragma unroll
                  for (int e = 0; e < 8; ++e) lg[e] = wave_sum(acc[i][e]) * r;
                  if (lane == 0) { int i0 = 0; float v0 = lg[0];
#pragma unroll
                      for (int e = 1; e < 8; ++e) if (lg[e] > v0) { v0 = lg[e]; i0 = e; }
                      int i1 = -1; float v1 = -3.0e38f;
#pragma unroll
                      for (int e = 0; e < 8; ++e) if (e != i0 && lg[e] > v1) { v1 = lg[e]; i1 = e; }
                      const float e1 = __expf(v1 - v0), g0 = 1.f / (1.f + e1);
                      ridx[tok * 2] = i0; ridx[tok * 2 + 1] = i1; rgate[tok * 2] = g0; rgate[tok * 2 + 1] = e1 * g0;
                      __hip_atomic_fetch_add((LAS int*)lds + i0, 1, __ATOMIC_RELAXED, __HIP_MEMORY_SCOPE_WORKGROUP); __hip_atomic_fetch_add((LAS int*)lds + i1, 1, __ATOMIC_RELAXED, __HIP_MEMORY_SCOPE_WORKGROUP); } }
              __syncthreads();
              if (tid < 8) hist[bx * 8 + tid] = lh[tid];
              __syncthreads(); }
            PHASE_END
            PHASE_BEGIN(pb + 7, 10)
            { volatile LAS int* li = (volatile LAS int*)lds;
              { const int e = wave; int tot = 0, pr = 0;
#pragma unroll
                for (int j = 0; j < 4; ++j) { const int w = lane + 64 * j; const int v = hist[w * 8 + e]; tot += v; pr += (w < bx) ? v : 0; }
#pragma unroll
                for (int o = 1; o < 64; o <<= 1) { tot += __shfl_xor(tot, o); pr += __shfl_xor(pr, o); }
                if (lane == 0) { li[e] = tot; li[8 + e] = pr; } }
              __syncthreads();
              if (tid == 0) { int off = 0; for (int e = 0; e < 8; ++e) { li[16 + e] = off; off += ((li[e] + 255) >> 8) * 256; } li[24] = off >> 8; }
              __syncthreads();
              if (wave == 0) { const int tok = bx * 32 + (lane >> 1), k = lane & 1, e = ridx[tok * 2 + k]; int rank = 0;
#pragma unroll
                  for (int q = 0; q < 8; ++q) { const unsigned long long m = __ballot(e == q); if (e == q) rank = __popcll(m & ((1ull << lane) - 1ull)); }
                  const int dest = li[16 + e] + li[8 + e] + rank;
                  tokdest[tok * 2 + k] = dest; rowtok[dest] = tok; rowgate[dest] = rgate[tok * 2 + k]; rowrstd[dest] = rsqrtf(epi::ss_val(ssx1, tok) * (1.f / DM) + EPS); li[32 + lane] = dest; }
              if (bx == 0) {
                  if (tid < 8) { const int e = tid, nt = (li[e] + 255) >> 8, t0 = li[16 + e] >> 8; for (int t = 0; t < nt; ++t) tiles[1 + t0 + t] = e; if (e == 0) tiles[0] = li[24]; }
                  for (int e = 0; e < 8; ++e) { const int r0 = li[16 + e] + li[e], r1 = li[16 + e] + (((li[e] + 255) >> 8) << 8);
                      for (int r = r0 + tid; r < r1; r += NWAVES * 64) { rowtok[r] = -1; rowgate[r] = 0.f; rowrstd[r] = 0.f; } } }
              __syncthreads();
#pragma unroll
              for (int q = 0; q < 8; ++q) { const int i = wave * 8 + q, tok = bx * 32 + (i >> 1), dest = li[32 + i];
                  const u32x4* s = (const u32x4*)((const unsigned char*)x1b + (size_t)tok * DM * EB); u32x4* d = (u32x4*)((unsigned char*)XG + (size_t)dest * DM * EB);
#pragma unroll
                  for (int jj = 0; jj < 2 * EB; ++jj) d[lane + 64 * jj] = s[lane + 64 * jj]; }
              __syncthreads(); }
            PHASE_END
            PHASE_BEGIN(pb + 8, 11)
            { SchedMoe S{G, bx, 2 * DFE / 256, tiles, (const char*)XG, (const char*)(ws + wsm::EXP1), (size_t)256 * DM * EB, (size_t)256 * DM * EB, wsm::SZ_EXP1};
              epi::EpiSwiglu<FF8> E{ACTM, DFE, rowrstd, 1, FF8 ? 1.f / WS1 : 1.f};
              pg8::gemm_phase(lds, DM * EB, S, E); }
            PHASE_END
            PHASE_BEGIN(pb + 9, 12)
            { epi::EpiMoe2<FF8> E{YB, rowgate, FF8 ? 1.f / WS2 : 1.f, (bf16_t*)(ws + wsm::YBX)};
              { SchedMoe2Main S{G, bx, tiles, (const char*)ACTM, (const char*)(ws + wsm::EXP2), (size_t)256 * DFE * EB, (size_t)256 * DFE * EB, wsm::SZ_EXP2};
                pg8::gemm_phase(lds, DFE * EB, S, E); }
              { SchedMoe2Tail S{G, bx, tiles, (const char*)ACTM, (const char*)(ws + wsm::EXP2), (size_t)256 * DFE * EB, (size_t)256 * DFE * EB, wsm::SZ_EXP2, (size_t)DFE * EB / 4};
                pg8::gemm_phase(lds, DFE * EB, S, E, DFE * EB / 128 / 4); } }
            PHASE_END
            PHASE_BEGIN(pb + 10, 13)
            { for (int tok = gw; tok < NT; tok += ngw) { const int d0 = tokdest[tok * 2], d1 = tokdest[tok * 2 + 1]; float sq = 0.f;
#pragma unroll
                  for (int j = 0; j < 4; ++j) { const size_t o = (size_t)tok * DM + (lane + 64 * j) * 8; f32x4 x0, x1, p0, p1, q0, q1; epi::unpack8(*(const u32x4*)(XR + o), x0, x1);
                      epi::unpack8(*(const u32x4*)(YB + (size_t)d0 * DM + (lane + 64 * j) * 8), p0, p1); epi::unpack8(*(const u32x4*)(YB + (size_t)d1 * DM + (lane + 64 * j) * 8), q0, q1);
                      x0 += p0 + q0; x1 += p1 + q1;
#pragma unroll
                      for (int dd = 0; dd < 2; ++dd) { const int d = dd ? d1 : d0; if (d >= 16384) {
#pragma unroll
                          for (int s = 0; s < 3; ++s) { epi::unpack8(*(const u32x4*)((const bf16_t*)(ws + wsm::YBX) + ((size_t)s * 2048 + (d - 16384)) * DM + (lane + 64 * j) * 8), p0, p1); x0 += p0; x1 += p1; } } } *(u32x4*)(XR + o) = epi::pack8(x0, x1);
                      const float* gp = a.in[28] + DM + (lane + 64 * j) * 8; const f32x4 y0 = x0 * *(const f32x4*)gp, y1 = x1 * *(const f32x4*)(gp + 4);
                      if constexpr (F8P) *(u32x2*)((unsigned char*)x2b + o) = (u32x2){pk4_fp8(y0[0], y0[1], y0[2], y0[3]), pk4_fp8(y1[0], y1[1], y1[2], y1[3])}; else *(u32x4*)(x2b + o) = epi::pack8(y0, y1);
                      sq += epi::sum8sq(x0, x1); }
                  sq = wave_sum(sq); if (lane == 0) ssx2[tok] = epi::ss_fix(sq); } }
            PHASE_END
        }

        PHASE_BEGIN(pb + 11, 14)
        { constexpr bool PF8 = (l == 1) && F8P; constexpr int PEB = PF8 ? 1 : 2;
          pg8::SchedGrid S{NT / 256, DM / 256, G, bx, 0, (const char*)x2b, (const char*)(wl + wsm::O_PLEG), (size_t)256 * DM * PEB};
          epi::EpiPle<PF8, (l == 1)> E{XR, dum ? (void*)MRGF : (l ? (void*)a.out : (void*)XR), dum ? SSMY : (l ? nullptr : XBB), ssx2, dum ? ssbase + 8 * NT : (l ? nullptr : ssx3), PP, a.in[2] + DM, PF8 ? 1.f / WS1 : 1.f};
          pg8::gemm_phase(lds, DM * PEB, S, E); }
        PHASE_END

    }
#undef PHASE_BEGIN
#undef PHASE_END
}

extern "C" void kernel_launch(void* const* d_in, const int* in_sizes, int n_in, void* d_out, int out_size, void* d_ws, size_t ws_size, hipStream_t stream) {
    static int grid = 0;
    if (grid == 0) {
        if (n_in != 31 || out_size != NT * DM || ws_size < wsm::END) { fprintf(stderr, "kernel_launch: shape/workspace mismatch (n_in %d out %d ws %zu need %zu)\n", n_in, out_size, ws_size, (size_t)wsm::END); grid = -1; return; }
        int dev = 0, cus = 0, per_cu = 0;
        if (hipGetDevice(&dev) != hipSuccess || hipDeviceGetAttribute(&cus, hipDeviceAttributeMultiprocessorCount, dev) != hipSuccess) { grid = -1; return; }
        if (hipFuncSetAttribute((const void*)mk_fwd, hipFuncAttributeMaxDynamicSharedMemorySize, LDS_BYTES) != hipSuccess) { fprintf(stderr, "kernel_launch: hipFuncSetAttribute failed\n"); grid = -1; return; }
        if (hipOccupancyMaxActiveBlocksPerMultiprocessor(&per_cu, (const void*)mk_fwd, NWAVES * 64, LDS_BYTES) != hipSuccess || per_cu < 1) { fprintf(stderr, "kernel_launch: occupancy query says %d\n", per_cu); }
        (void)hipGetLastError();
        grid = cus;
        if (grid != 256) { fprintf(stderr, "kernel_launch: built for 256 CUs, got %d\n", grid); grid = -1; return; }
    }
    if (grid < 0) return;
    (void)hipMemsetAsync((char*)d_ws + wsm::CTL, 0, wsm::CTL_BYTES, stream);
    Args a{};
    for (int i = 0; i < 31; ++i) a.in[i] = (const float*)d_in[i];
    a.out = (float*)d_out; a.ws = (unsigned char*)d_ws;
#ifndef MK_ONE_LAUNCH
#define MK_ONE_LAUNCH 0
#endif
    if (MK_ONE_LAUNCH) { a.ph_lo = 0; a.ph_hi = N_PHASES; hipLaunchKernelGGL(mk_fwd, dim3(grid), dim3(NWAVES * 64), LDS_BYTES, stream, a); }
    else for (int ph = 0; ph < N_PHASES; ++ph) { if (ph >= 9 && ph <= 11) continue;
        a.ph_lo = ph; a.ph_hi = ph + 1; hipLaunchKernelGGL(mk_fwd, dim3(grid), dim3(NWAVES * 64), LDS_BYTES, stream, a); }
}
```
